# Optimizing an MI355X kernel written in HIP

```python
import math
import jax, jax.numpy as jnp
from jax import lax
import numpy as np


D_MODEL = 4096
BATCH = 2
SEQ = 8192
DEPTH = 1

GRID_W = 64
CTX_LEN = 256
MIX_WIDTH = D_MODEL
LRU_WIDTH = MIX_WIDTH // 2
LRU_BLOCKS = 16
LRU_BLOCK_DIM = LRU_WIDTH // LRU_BLOCKS
LRU_C = 8.0
GDN_WIDTH = MIX_WIDTH - LRU_WIDTH
GDN_HEADS = 16
GDN_HEAD_DIM = GDN_WIDTH // GDN_HEADS
GDN_CHUNK = 64
CONV_W = 4
CONV_PAD_L = 2
CONV_PAD_R = 1
N_DIR = 2
D_FF = -(-(8 * D_MODEL) // (3 * 256)) * 256
N_MOD = 6
EPS = 1e-6
COL_LRU_X = 0
COL_LRU_GATE = COL_LRU_X + LRU_WIDTH
COL_QKV = COL_LRU_GATE + LRU_WIDTH
COL_Z = COL_QKV + 3 * GDN_WIDTH
COL_BETA = COL_Z + GDN_WIDTH
COL_ALPHA = COL_BETA + N_DIR * GDN_HEADS
N_IN = COL_ALPHA + N_DIR * GDN_HEADS

kernel_name = 'hybrid_rglru_gdn_dit_layer'


def _rmsnorm(x, g):
    xf = x.astype(jnp.float32)
    y = xf * lax.rsqrt(jnp.mean(xf * xf, axis=-1, keepdims=True) + EPS)
    return (y * g.astype(jnp.float32)).astype(x.dtype)


def _l2norm(x):
    xf = x.astype(jnp.float32)
    return xf * lax.rsqrt(jnp.sum(xf * xf, axis=-1, keepdims=True) + EPS)


def _modulate(h, shift, scale):
    return h * (1.0 + scale) + shift


def _cols(p, start, width):
    return p[..., start:start + width]


def _dwconv_centred(x, w):
    t = x.shape[1]
    xp = jnp.pad(x, ((0, 0), (CONV_PAD_L, CONV_PAD_R), (0, 0)))
    y = xp[:, 0:t] * w[0]
    for j in range(1, CONV_W):
        y = y + xp[:, j:j + t] * w[j]
    return y


def _raster_to_colmajor(t, rows):
    b, n = t.shape[:2]
    rest = t.shape[2:]
    return t.reshape((b, rows, GRID_W) + rest).swapaxes(1, 2).reshape((b, n) + rest)


def _colmajor_to_raster(t, rows):
    b, n = t.shape[:2]
    rest = t.shape[2:]
    return t.reshape((b, GRID_W, rows) + rest).swapaxes(1, 2).reshape((b, n) + rest)


def _flip(t, rev):
    return t[:, ::-1] if rev else t


def _lin_combine(e1, e2):
    a1, b1 = e1
    a2, b2 = e2
    return a1 * a2, a2 * b1 + b2


def _linear_scan(a, b, h0, rev):
    first = -1 if rev else 0
    if h0 is not None:
        b = b.at[:, first].add(a[:, first] * h0)
    _, h = lax.associative_scan(_lin_combine, (a, b), reverse=rev, axis=1)
    final = h[:, 0] if rev else h[:, -1]
    return h, final


def _rglru_coeffs(xc, w_a, b_a, w_x, b_x, lam):
    bsz, n, _ = xc.shape
    xb = xc.reshape(bsz, n, LRU_BLOCKS, LRU_BLOCK_DIM)
    r = jax.nn.sigmoid(jnp.einsum('btni,nij->btnj', xb, w_a).reshape(bsz, n, LRU_WIDTH) + b_a)
    i = jax.nn.sigmoid(jnp.einsum('btni,nij->btnj', xb, w_x).reshape(bsz, n, LRU_WIDTH) + b_x)
    log_a = -LRU_C * r * jax.nn.softplus(-lam)
    a = jnp.exp(log_a)
    return a, jnp.sqrt(-jnp.expm1(2.0 * log_a)) * (i * xc)


def _rglru_mixer(u_lat, gate_lat, u_ctx, gate_ctx, conv_w, conv_b, w_a, b_a, w_x, b_x, lam, norm_g, with_ctx):
    xl = (_dwconv_centred(u_lat, conv_w) + conv_b).astype(jnp.float32)
    xc = (_dwconv_centred(u_ctx, conv_w) + conv_b).astype(jnp.float32)
    h_lat, h_ctx = [], []
    for d in range(N_DIR):
        rev = d == 1
        a_c, b_c = _rglru_coeffs(xc, w_a[d], b_a[d], w_x[d], b_x[d], lam[d])
        hc, hc_final = _linear_scan(a_c, b_c, None, rev)
        a_l, b_l = _rglru_coeffs(xl, w_a[d], b_a[d], w_x[d], b_x[d], lam[d])
        hl, _ = _linear_scan(a_l, b_l, hc_final, rev)
        h_lat.append(hl)
        h_ctx.append(hc)
    y_lat = _rmsnorm(((h_lat[0] + h_lat[1]) * jax.nn.gelu(gate_lat.astype(jnp.float32))).astype(u_lat.dtype), norm_g)
    y_ctx = None
    if with_ctx:
        y_ctx = _rmsnorm(((h_ctx[0] + h_ctx[1]) * jax.nn.gelu(gate_ctx.astype(jnp.float32))).astype(u_ctx.dtype), norm_g)
    return y_lat, y_ctx


def _to_chunks(t):
    b, n, h = t.shape[:3]
    rest = t.shape[3:]
    t = t.reshape((b, n // GDN_CHUNK, GDN_CHUNK, h) + rest)
    return jnp.moveaxis(t, (1, 3), (0, 2))


def _gdn_chunked(q, k, v, g, beta, s0, need_out):
    bsz, n, h, dk = q.shape
    dv = v.shape[-1]
    q, k, v, g, beta = (_to_chunks(t.astype(jnp.float32)) for t in (q, k, v, g, beta))
    q = q * (dk ** -0.5)
    gcum = jnp.cumsum(g, axis=-1)
    idx = jnp.arange(GDN_CHUNK)
    lower = idx[:, None] >= idx[None, :]
    strict = idx[:, None] > idx[None, :]
    diff = gcum[..., :, None] - gcum[..., None, :]
    decay = jnp.where(lower, jnp.exp(jnp.where(lower, diff, 0.0)), 0.0)
    kb = k * beta[..., None]
    lmat = jnp.where(strict, jnp.einsum('nbhid,nbhjd->nbhij', kb, k) * decay, 0.0)
    amat = lmat + jnp.eye(GDN_CHUNK, dtype=jnp.float32)
    rhs = jnp.concatenate([v * beta[..., None], kb * jnp.exp(gcum)[..., None]], axis=-1)
    sol = lax.linalg.triangular_solve(amat, rhs, left_side=True, lower=True, unit_diagonal=True)
    u, w = sol[..., :dv], sol[..., dv:]
    k_tail = k * jnp.exp(gcum[..., -1:] - gcum)[..., None]
    g_last = jnp.exp(gcum[..., -1])
    if s0 is None:
        s0 = jnp.zeros((bsz, h, dk, dv), jnp.float32)
    if need_out:
        intra = jnp.where(lower, jnp.einsum('nbhid,nbhjd->nbhij', q, k) * decay, 0.0)
        xs = (w, u, k_tail, g_last, q * jnp.exp(gcum)[..., None], intra)
    else:
        xs = (w, u, k_tail, g_last)

    def step(s, xs_i):
        w_i, u_i, kt_i, gl_i = xs_i[:4]
        v_new = u_i - jnp.einsum('bhck,bhkv->bhcv', w_i, s)
        s_new = s * gl_i[..., None, None] + jnp.einsum('bhck,bhcv->bhkv', kt_i, v_new)
        if not need_out:
            return s_new, None
        qd_i, intra_i = xs_i[4:]
        o_i = jnp.einsum('bhck,bhkv->bhcv', qd_i, s) + jnp.einsum('bhij,bhjv->bhiv', intra_i, v_new)
        return s_new, o_i

    s_final, o = lax.scan(step, s0.astype(jnp.float32), xs)
    if need_out:
        o = jnp.moveaxis(o, (0, 2), (1, 3)).reshape(bsz, n, h, dv)
    return o, s_final


def _gdn_qkv(qkv, conv_w):
    bsz, n, _ = qkv.shape
    y = jax.nn.silu(_dwconv_centred(qkv, conv_w))
    q, k, v = jnp.split(y, 3, axis=-1)
    shp = (bsz, n, GDN_HEADS, GDN_HEAD_DIM)
    return _l2norm(q.reshape(shp)), _l2norm(k.reshape(shp)), v.reshape(shp)


def _gdn_gates(p_beta, p_alpha, a_log_d, dt_bias_d):
    beta = jax.nn.sigmoid(p_beta.astype(jnp.float32))
    g = -jnp.exp(a_log_d.astype(jnp.float32)) * jax.nn.softplus(p_alpha.astype(jnp.float32) + dt_bias_d)
    return beta, g


def _gated_headnorm(o, z, g):
    bsz, n = z.shape[:2]
    zf = z.reshape(bsz, n, GDN_HEADS, GDN_HEAD_DIM).astype(jnp.float32)
    y = _rmsnorm(o, g) * jax.nn.silu(zf)
    return y.reshape(bsz, n, GDN_WIDTH).astype(z.dtype)


def _gdn_mixer(qkv_lat, beta_lat, alpha_lat, z_lat, qkv_ctx, beta_ctx, alpha_ctx, z_ctx,
               conv_w, a_log, dt_bias, norm_g, rows, with_ctx):
    qkv_lat, beta_lat, alpha_lat = (_raster_to_colmajor(t, rows) for t in (qkv_lat, beta_lat, alpha_lat))
    lat = _gdn_qkv(qkv_lat, conv_w)
    cqkv = _gdn_qkv(qkv_ctx, conv_w)
    o_lat, o_ctx = [], []
    for d in range(N_DIR):
        rev = d == 1
        hs = slice(d * GDN_HEADS, (d + 1) * GDN_HEADS)
        b_c, g_c = _gdn_gates(beta_ctx[..., hs], alpha_ctx[..., hs], a_log[d], dt_bias[d])
        b_l, g_l = _gdn_gates(beta_lat[..., hs], alpha_lat[..., hs], a_log[d], dt_bias[d])
        oc, s_ctx = _gdn_chunked(*(_flip(t, rev) for t in cqkv + (g_c, b_c)), None, with_ctx)
        ol, _ = _gdn_chunked(*(_flip(t, rev) for t in lat + (g_l, b_l)), s_ctx, True)
        o_lat.append(_flip(ol, rev))
        if with_ctx:
            o_ctx.append(_flip(oc, rev))
    y_lat = _gated_headnorm(_colmajor_to_raster(o_lat[0] + o_lat[1], rows), z_lat, norm_g)
    y_ctx = _gated_headnorm(o_ctx[0] + o_ctx[1], z_ctx, norm_g) if with_ctx else None
    return y_lat, y_ctx


def _swiglu(h, wg, wu, wd):
    return (jax.nn.silu(h @ wg) * (h @ wu)) @ wd


def setup_inputs(seed: int = 0) -> dict:
    key = jax.random.key(seed)
    ks = jax.random.split(key, 32)
    L = DEPTH
    f32 = jnp.float32

    def nrm(k, shape, scale):
        return jax.random.normal(k, shape, f32) * scale

    def gain(k, shape):
        return 1.0 + 0.05 * jax.random.normal(k, shape, f32)

    u = jax.random.uniform(ks[17], (L, N_DIR, LRU_WIDTH), f32, minval=0.9, maxval=0.999)
    s = u ** (1.0 / LRU_C)
    lru_lambda = jnp.log(s) - jnp.log1p(-s)
    gdn_a_log = jnp.log(jax.random.uniform(ks[20], (L, N_DIR, GDN_HEADS), f32, minval=1.0, maxval=16.0))
    dt = jnp.exp(jax.random.uniform(ks[21], (L, N_DIR, GDN_HEADS), f32,
                                    minval=math.log(1e-3), maxval=math.log(1e-1)))
    gdn_dt_bias = dt + jnp.log(-jnp.expm1(-dt))
    return {
        'x': nrm(ks[0], (BATCH, SEQ, D_MODEL), 1.0),
        'c': nrm(ks[1], (BATCH, D_MODEL), 1.0),
        'ctx': nrm(ks[2], (BATCH, CTX_LEN, D_MODEL), 1.0),
        'c_ctx': nrm(ks[3], (D_MODEL,), 1.0),
        'w_ada': nrm(ks[4], (L, D_MODEL, N_MOD * D_MODEL), 0.5 * D_MODEL ** -0.5),
        'b_ada': nrm(ks[5], (L, N_MOD * D_MODEL), 0.01),
        'g_pre_mix': gain(ks[6], (L, D_MODEL)),
        'g_post_mix': gain(ks[7], (L, D_MODEL)),
        'g_pre_ffn': gain(ks[8], (L, D_MODEL)),
        'g_post_ffn': gain(ks[9], (L, D_MODEL)),
        'w_in': nrm(ks[10], (L, D_MODEL, N_IN), D_MODEL ** -0.5),
        'lru_conv_w': nrm(ks[11], (L, CONV_W, LRU_WIDTH), CONV_W ** -0.5),
        'lru_conv_b': nrm(ks[12], (L, LRU_WIDTH), 0.01),
        'lru_w_a': nrm(ks[13], (L, N_DIR, LRU_BLOCKS, LRU_BLOCK_DIM, LRU_BLOCK_DIM), LRU_BLOCK_DIM ** -0.5),
        'lru_b_a': nrm(ks[14], (L, N_DIR, LRU_WIDTH), 0.01),
        'lru_w_x': nrm(ks[15], (L, N_DIR, LRU_BLOCKS, LRU_BLOCK_DIM, LRU_BLOCK_DIM), LRU_BLOCK_DIM ** -0.5),
        'lru_b_x': nrm(ks[16], (L, N_DIR, LRU_WIDTH), 0.01),
        'lru_lambda': lru_lambda,
        'lru_norm_g': gain(ks[18], (L, LRU_WIDTH)),
        'gdn_conv_w': nrm(ks[19], (L, CONV_W, 3 * GDN_WIDTH), CONV_W ** -0.5),
        'gdn_a_log': gdn_a_log,
        'gdn_dt_bias': gdn_dt_bias,
        'gdn_norm_g': gain(ks[22], (L, GDN_HEAD_DIM)),
        'w_out': nrm(ks[23], (L, MIX_WIDTH, D_MODEL), MIX_WIDTH ** -0.5),
        'w_ffn_gate': nrm(ks[24], (L, D_MODEL, D_FF), D_MODEL ** -0.5),
        'w_ffn_up': nrm(ks[25], (L, D_MODEL, D_FF), D_MODEL ** -0.5),
        'w_ffn_down': nrm(ks[26], (L, D_FF, D_MODEL), D_FF ** -0.5),
    }


def reference(x, c, ctx, c_ctx, w_ada, b_ada, g_pre_mix, g_post_mix, g_pre_ffn, g_post_ffn, w_in,
              lru_conv_w, lru_conv_b, lru_w_a, lru_b_a, lru_w_x, lru_b_x, lru_lambda, lru_norm_g,
              gdn_conv_w, gdn_a_log, gdn_dt_bias, gdn_norm_g, w_out, w_ffn_gate, w_ffn_up, w_ffn_down):
    rows = x.shape[1] // GRID_W
    for l in range(DEPTH):
        with_ctx = l < DEPTH - 1
        shift_m, scale_m, gate_m, shift_f, scale_f, gate_f = jnp.split(
            (jax.nn.silu(c) @ w_ada[l] + b_ada[l])[:, None, :], N_MOD, axis=-1)
        mod_ctx = jnp.split((jax.nn.silu(c_ctx) @ w_ada[l] + b_ada[l])[None, None, :], N_MOD, axis=-1)

        h_lat = _modulate(_rmsnorm(x, g_pre_mix[l]), shift_m, scale_m)
        h_ctx = _modulate(_rmsnorm(ctx, g_pre_mix[l]), mod_ctx[0], mod_ctx[1])
        p_lat = h_lat @ w_in[l]
        p_ctx = h_ctx @ w_in[l]
        lru_lat, lru_ctx = _rglru_mixer(
            _cols(p_lat, COL_LRU_X, LRU_WIDTH), _cols(p_lat, COL_LRU_GATE, LRU_WIDTH),
            _cols(p_ctx, COL_LRU_X, LRU_WIDTH), _cols(p_ctx, COL_LRU_GATE, LRU_WIDTH),
            lru_conv_w[l], lru_conv_b[l], lru_w_a[l], lru_b_a[l], lru_w_x[l], lru_b_x[l],
            lru_lambda[l], lru_norm_g[l], with_ctx)
        gdn_lat, gdn_ctx = _gdn_mixer(
            _cols(p_lat, COL_QKV, 3 * GDN_WIDTH), _cols(p_lat, COL_BETA, N_DIR * GDN_HEADS),
            _cols(p_lat, COL_ALPHA, N_DIR * GDN_HEADS), _cols(p_lat, COL_Z, GDN_WIDTH),
            _cols(p_ctx, COL_QKV, 3 * GDN_WIDTH), _cols(p_ctx, COL_BETA, N_DIR * GDN_HEADS),
            _cols(p_ctx, COL_ALPHA, N_DIR * GDN_HEADS), _cols(p_ctx, COL_Z, GDN_WIDTH),
            gdn_conv_w[l], gdn_a_log[l], gdn_dt_bias[l], gdn_norm_g[l], rows, with_ctx)
        mix_lat = jnp.concatenate([lru_lat, gdn_lat], axis=-1)
        x = x + gate_m * _rmsnorm(mix_lat @ w_out[l], g_post_mix[l])

        h = _modulate(_rmsnorm(x, g_pre_ffn[l]), shift_f, scale_f)
        x = x + gate_f * _rmsnorm(_swiglu(h, w_ffn_gate[l], w_ffn_up[l], w_ffn_down[l]), g_post_ffn[l])

        if with_ctx:
            mix_ctx = jnp.concatenate([lru_ctx, gdn_ctx], axis=-1)
            ctx = ctx + mod_ctx[2] * _rmsnorm(mix_ctx @ w_out[l], g_post_mix[l])
            hc = _modulate(_rmsnorm(ctx, g_pre_ffn[l]), mod_ctx[3], mod_ctx[4])
            ctx = ctx + mod_ctx[5] * _rmsnorm(_swiglu(hc, w_ffn_gate[l], w_ffn_up[l], w_ffn_down[l]), g_post_ffn[l])
    return x
```

```cpp
#include <hip/hip_runtime.h>
#include <cstdio>
#include <cstdint>
namespace pg8 {
#define PG8_LAS __attribute__((address_space(3)))
typedef unsigned short bf16_t;
typedef short bf16x8 __attribute__((ext_vector_type(8)));
typedef float f32x4 __attribute__((ext_vector_type(4)));
typedef unsigned u32x4 __attribute__((ext_vector_type(4)));
constexpr int BM = 256, BK = 64, HALF = 128, HTB = HALF * BK * 2  , STAGE_BYTES = 8 * HTB, NXCD = 8, WGM = 8;

__host__ __device__ __forceinline__ int lds_byte(int r, int c) { const int st = (r >> 4) * 2 + (c >> 5), rr = r & 15, cc = c & 31, ob = rr * 64 + cc * 2; return st * 1024 + (ob ^ (((ob >> 9) & 1) << 5)); }
__host__ __device__ __forceinline__ void stage_rc(int b, int& R, int& C) { const int st = b / 1024, sb = b % 1024, swz = sb ^ (((sb >> 9) & 1) << 5); R = (st >> 1) * 16 + swz / 64; C = (st & 1) * 32 + (swz % 64) / 2; }
__host__ __device__ __forceinline__ int perm32(int rho) { const int n = rho >> 4, i = rho & 15; return 8 * (i >> 2) + 4 * n + (i & 3); }

struct Unit { int pm, pn; };
struct Gemm { const bf16_t* A; const bf16_t* Bt; int M, N, K; };

struct StaticOrder {
    int nM, nN, nwg, G, c;
    __host__ __device__ void init(int M, int N, int G_, int c_) { nM = M / BM; nN = N / BM; nwg = nM * nN; G = G_; c = c_; }
    __host__ __device__ bool next(int i, Unit& u) const {
        const long L = (long)i * G + c; if (L >= nwg) return false;
        int wgid = (int)L; { const int q = nwg / NXCD, r = nwg % NXCD, xcd = wgid % NXCD, off = wgid / NXCD; wgid = (xcd < r ? xcd * (q + 1) : r * (q + 1) + (xcd - r) * q) + off; }
        const int nig = WGM * nN, gid = wgid / nig, fm = gid * WGM, gsz = (nM - fm) < WGM ? (nM - fm) : WGM;
        u.pm = fm + ((wgid % nig) % gsz); u.pn = (wgid % nig) / gsz; return true;
    }
    __device__ __forceinline__ void a_ready(const Unit&) const {}
    __device__ __forceinline__ void done(const Unit&) const {}
};
__device__ __forceinline__ unsigned cvt_pk_bf16(float lo, float hi) { unsigned r; asm volatile("v_cvt_pk_bf16_f32 %0, %1, %2" : "=v"(r) : "v"(lo), "v"(hi)); return r; }
struct EpiF32 {
    static constexpr bool PERM = false, AFTER_DRAIN = false;
    float* C; int ldc;
    __device__ __forceinline__ void operator()(const f32x4 (&acc)[2][2][4][2], const Unit& u, int wr, int wc, int fr, int fq) const {
        const int row0 = u.pm * BM + wr * 64 + fr, col0 = u.pn * BM + wc * 32 + 4 * fq;
#pragma unroll
        for (int ai = 0; ai < 2; ++ai)
#pragma unroll
            for (int m = 0; m < 4; ++m) { float* rowp = C + (size_t)(row0 + ai * HALF + m * 16) * ldc + col0;
#pragma unroll
                for (int bj = 0; bj < 2; ++bj)
#pragma unroll
                    for (int n = 0; n < 2; ++n) *(f32x4*)(rowp + bj * HALF + n * 16) = acc[ai][bj][m][n]; }
    }
};
struct EpiProj {
    static constexpr bool PERM = true, AFTER_DRAIN = false;
    bf16_t *lx, *lg, *qkv, *z, *ba;
    __device__ __forceinline__ void operator()(const f32x4 (&acc)[2][2][4][2], const Unit& u, int wr, int wc, int fr, int fq) const {
        const int pn = u.pn; bf16_t* base; int ld, colt;
        if (pn < 8) { base = lx; ld = 2048; colt = pn * BM; }
        else if (pn < 16) { base = lg; ld = 2048; colt = (pn - 8) * BM; }
        else if (pn < 40) { base = qkv; ld = 6144; colt = (pn - 16) * BM; }
        else if (pn < 48) { base = z; ld = 2048; colt = (pn - 40) * BM; }
        else { base = ba; ld = 256; colt = 0; }
        const int row0 = u.pm * BM + wr * 64 + fr, col0 = colt + wc * 32 + 8 * fq;
#pragma unroll
        for (int ai = 0; ai < 2; ++ai)
#pragma unroll
            for (int m = 0; m < 4; ++m) { bf16_t* rowp = base + (size_t)(row0 + ai * HALF + m * 16) * ld + col0;
#pragma unroll
                for (int bj = 0; bj < 2; ++bj) { const f32x4 v0 = acc[ai][bj][m][0], v1 = acc[ai][bj][m][1];
                    u32x4 w; w.x = cvt_pk_bf16(v0[0], v0[1]); w.y = cvt_pk_bf16(v0[2], v0[3]); w.z = cvt_pk_bf16(v1[0], v1[1]); w.w = cvt_pk_bf16(v1[2], v1[3]);
                    *(u32x4*)(rowp + bj * HALF) = w; } }
    }
};
struct EpiSwiGLU {
    static constexpr bool PERM = true, AFTER_DRAIN = false;
    bf16_t* O; int ldc;
    __device__ __forceinline__ void operator()(const f32x4 (&acc)[2][2][4][2], const Unit& u, int wr, int wc, int fr, int fq) const {
        const int row0 = u.pm * BM + wr * 64 + fr, col0 = u.pn * HALF + wc * 32 + 8 * fq;
#pragma unroll
        for (int ai = 0; ai < 2; ++ai)
#pragma unroll
            for (int m = 0; m < 4; ++m) { bf16_t* rowp = O + (size_t)(row0 + ai * HALF + m * 16) * ldc + col0;
                float r[8];
#pragma unroll
                for (int n = 0; n < 2; ++n)
#pragma unroll
                    for (int j = 0; j < 4; ++j) { const float g = acc[ai][0][m][n][j], up = acc[ai][1][m][n][j]; r[4 * n + j] = g * __builtin_amdgcn_rcpf(1.0f + __expf(-g)) * up; }
                u32x4 w; w.x = cvt_pk_bf16(r[0], r[1]); w.y = cvt_pk_bf16(r[2], r[3]); w.z = cvt_pk_bf16(r[4], r[5]); w.w = cvt_pk_bf16(r[6], r[7]);
                *(u32x4*)rowp = w; }
    }
};

template <class Epi, class Sched, bool ALIGN_EPI = false, bool SP2 = false>
__device__ __forceinline__ void gemm_phase(PG8_LAS unsigned char* lds, const Gemm g, const Sched& S, const Epi& E) {
    const int tid = threadIdx.x, wid = __builtin_amdgcn_readfirstlane(tid >> 6), lane = tid & 63, wr = wid >> 2, wc = wid & 3, fr = lane & 15, fq = lane >> 4;
    const int K = g.K, nt = K / BK;
    unsigned voffA[2], voffB[2];
#pragma unroll
    for (int i = 0; i < 2; ++i) { int R, C; stage_rc(tid * 16 + i * 8192, R, C); const int Rb = Epi::PERM ? ((R & ~31) + perm32(R & 31)) : R;
        voffA[i] = (unsigned)(R * K + C) * 2u; voffB[i] = (unsigned)(Rb * K + C) * 2u; }
    const size_t kstep = (size_t)(BK * 2);
    const size_t hstep = (size_t)HALF * K * 2;
    const size_t tstep = 2 * hstep;
    const unsigned ldsw = (unsigned)wid * 1024u;
    const int aoff = lds_byte(wr * 64 + fr, fq * 8), boff = lds_byte(wc * 32 + fr, fq * 8);
#define PG8_SA(b, h) (((b) * 2 + (h)) * HTB)
#define PG8_SB(b, h) ((4 + (b) * 2 + (h)) * HTB)
#define PG8_STAGE(bufoff, gbase, voff) do { _Pragma("unroll") for (int _i = 0; _i < 2; ++_i) \
        __builtin_amdgcn_global_load_lds((const unsigned*)((const char*)(gbase) + (voff)[_i]), (PG8_LAS unsigned*)(lds + (bufoff) + ldsw + _i * 8192), 16, 0, 0); } while (0)
#define PG8_LDA(dst, b, h) do { _Pragma("unroll") for (int m = 0; m < 4; ++m) _Pragma("unroll") for (int k = 0; k < 2; ++k) dst[m][k] = *(const PG8_LAS bf16x8*)(lds + PG8_SA(b, h) + aoff + m * 2048 + k * 1024); } while (0)
#define PG8_LDB(dst, b, h) do { _Pragma("unroll") for (int n = 0; n < 2; ++n) _Pragma("unroll") for (int k = 0; k < 2; ++k) dst[n][k] = *(const PG8_LAS bf16x8*)(lds + PG8_SB(b, h) + boff + n * 2048 + k * 1024); } while (0)
#define PG8_MMA(ai, bj, At, Bt) do { __builtin_amdgcn_s_setprio(1); _Pragma("unroll") for (int m = 0; m < 4; ++m) _Pragma("unroll") for (int n = 0; n < 2; ++n) _Pragma("unroll") for (int k = 0; k < 2; ++k) \
        acc[ai][bj][m][n] = __builtin_amdgcn_mfma_f32_16x16x32_bf16(Bt[n][k], At[m][k], acc[ai][bj][m][n], 0, 0, 0); __builtin_amdgcn_s_setprio(0); } while (0)
#define PG8_WAIT_V(n) asm volatile("s_waitcnt vmcnt(" #n ")" ::: "memory")
#define PG8_WAIT_L(n) asm volatile("s_waitcnt lgkmcnt(" #n ")" ::: "memory")
#define PG8_BAR __builtin_amdgcn_s_barrier()
#define PG8_SCHED __builtin_amdgcn_sched_barrier(0)
    Unit cur, nxt; int ui = 0;
    if (!S.next(0, cur)) return;
    f32x4 acc[2][2][4][2];
#pragma unroll
    for (int a = 0; a < 2; ++a)
#pragma unroll
        for (int b = 0; b < 2; ++b)
#pragma unroll
            for (int m = 0; m < 4; ++m)
#pragma unroll
                for (int n = 0; n < 2; ++n) acc[a][b][m][n] = (f32x4){0.f, 0.f, 0.f, 0.f};
    bf16x8 At[4][2], B0[2][2], B1[2][2];
    const char* cA = (const char*)g.A + (size_t)cur.pm * tstep; const char* cB = (const char*)g.Bt + (size_t)cur.pn * tstep;
    S.a_ready(cur);
    if constexpr (SP2) {
        PG8_STAGE(PG8_SB(0, 0), cB, voffB); PG8_STAGE(PG8_SB(0, 1), cB + hstep, voffB); PG8_STAGE(PG8_SA(0, 0), cA, voffA); PG8_STAGE(PG8_SA(0, 1), cA + hstep, voffA);
        if (wr == 1) PG8_BAR;
        PG8_WAIT_V(2); PG8_BAR;
        PG8_STAGE(PG8_SB(1, 0), cB + kstep, voffB); PG8_STAGE(PG8_SA(1, 0), cA + kstep, voffA); PG8_STAGE(PG8_SB(1, 1), cB + hstep + kstep, voffB);
        PG8_WAIT_V(6); PG8_BAR;
    } else {
        PG8_STAGE(PG8_SB(0, 0), cB, voffB); PG8_STAGE(PG8_SA(0, 0), cA, voffA); PG8_STAGE(PG8_SB(0, 1), cB + hstep, voffB); PG8_STAGE(PG8_SA(0, 1), cA + hstep, voffA);
        if (wr == 1) PG8_BAR;
        PG8_WAIT_V(4); PG8_BAR;
        PG8_STAGE(PG8_SB(1, 0), cB + kstep, voffB); PG8_STAGE(PG8_SA(1, 0), cA + kstep, voffA); PG8_STAGE(PG8_SB(1, 1), cB + hstep + kstep, voffB);
        PG8_WAIT_V(6); PG8_BAR;
    }
    for (;;) {
        const bool has_next = S.next(ui + 1, nxt);
        const char* nA = has_next ? (const char*)g.A + (size_t)nxt.pm * tstep : cA; const char* nB = has_next ? (const char*)g.Bt + (size_t)nxt.pn * tstep : cB;
        for (int t = 0; t < nt; t += 2) {
            const bool last = (t == nt - 2);
            const char* a1 = cA + (size_t)(t + 1) * kstep;
            const char* a2 = last ? nA : cA + (size_t)(t + 2) * kstep; const char* b2 = last ? nB : cB + (size_t)(t + 2) * kstep;
            const char* a3 = a2 + kstep; const char* b3 = b2 + kstep;
            if (last && has_next) S.a_ready(nxt);
            if constexpr (SP2) {
            PG8_LDB(B0, 0, 0); PG8_LDB(B1, 0, 1); PG8_SCHED; PG8_LDA(At, 0, 0); PG8_STAGE(PG8_SA(1, 1), a1 + hstep, voffA);
            PG8_WAIT_V(8); PG8_WAIT_L(0); PG8_BAR; PG8_MMA(0, 0, At, B0); PG8_MMA(0, 1, At, B1); PG8_BAR; PG8_SCHED;
            PG8_LDA(At, 0, 1); PG8_STAGE(PG8_SB(0, 0), b2, voffB); PG8_STAGE(PG8_SB(0, 1), b2 + hstep, voffB); PG8_STAGE(PG8_SA(0, 0), a2, voffA);
            PG8_WAIT_V(8); PG8_WAIT_L(0); PG8_BAR; PG8_MMA(1, 0, At, B0); PG8_MMA(1, 1, At, B1); PG8_BAR; PG8_SCHED;
            PG8_LDB(B0, 1, 0); PG8_LDB(B1, 1, 1); PG8_SCHED; PG8_LDA(At, 1, 0); PG8_STAGE(PG8_SA(0, 1), a2 + hstep, voffA);
            PG8_WAIT_V(8); PG8_WAIT_L(0); PG8_BAR; PG8_MMA(0, 0, At, B0); PG8_MMA(0, 1, At, B1); PG8_BAR; PG8_SCHED;
            PG8_LDA(At, 1, 1); PG8_STAGE(PG8_SB(1, 0), b3, voffB); PG8_STAGE(PG8_SB(1, 1), b3 + hstep, voffB); PG8_STAGE(PG8_SA(1, 0), a3, voffA);
            PG8_WAIT_V(8); PG8_WAIT_L(0); PG8_BAR; PG8_MMA(1, 0, At, B0); PG8_MMA(1, 1, At, B1); PG8_BAR; PG8_SCHED;
            } else {
            PG8_LDB(B0, 0, 0); PG8_SCHED; PG8_LDA(At, 0, 0); PG8_STAGE(PG8_SA(1, 1), a1 + hstep, voffA);
            PG8_WAIT_L(8); PG8_BAR; PG8_WAIT_L(0); PG8_MMA(0, 0, At, B0); PG8_BAR; PG8_SCHED;
            PG8_LDB(B1, 0, 1); PG8_STAGE(PG8_SB(0, 0), b2, voffB);
            PG8_BAR; PG8_WAIT_L(0); PG8_MMA(0, 1, At, B1); PG8_BAR;
            PG8_LDA(At, 0, 1); PG8_STAGE(PG8_SA(0, 0), a2, voffA);
            PG8_BAR; PG8_WAIT_L(0); PG8_MMA(1, 0, At, B0); PG8_BAR; PG8_SCHED;
            PG8_STAGE(PG8_SB(0, 1), b2 + hstep, voffB);
            PG8_WAIT_V(6); PG8_BAR; PG8_MMA(1, 1, At, B1); PG8_BAR;
            PG8_LDB(B0, 1, 0); PG8_SCHED; PG8_LDA(At, 1, 0); PG8_STAGE(PG8_SA(0, 1), a2 + hstep, voffA);
            PG8_WAIT_L(8); PG8_BAR; PG8_WAIT_L(0); PG8_MMA(0, 0, At, B0); PG8_BAR; PG8_SCHED;
            PG8_LDB(B1, 1, 1); PG8_STAGE(PG8_SB(1, 0), b3, voffB);
            PG8_BAR; PG8_WAIT_L(0); PG8_MMA(0, 1, At, B1); PG8_BAR;
            PG8_LDA(At, 1, 1); PG8_STAGE(PG8_SA(1, 0), a3, voffA);
            PG8_BAR; PG8_WAIT_L(0); PG8_MMA(1, 0, At, B0); PG8_BAR; PG8_SCHED;
            PG8_STAGE(PG8_SB(1, 1), b3 + hstep, voffB);
            PG8_WAIT_V(6); PG8_BAR; PG8_MMA(1, 1, At, B1); PG8_BAR;
            }
        }
        if constexpr (ALIGN_EPI) { if (wr == 0) PG8_BAR; }
        if constexpr (!Epi::AFTER_DRAIN) { E(acc, cur, wr, wc, fr, fq); S.done(cur); }
        if (!has_next) break;
#pragma unroll
        for (int a = 0; a < 2; ++a)
#pragma unroll
            for (int b = 0; b < 2; ++b)
#pragma unroll
                for (int m = 0; m < 4; ++m)
#pragma unroll
                    for (int n = 0; n < 2; ++n) acc[a][b][m][n] = (f32x4){0.f, 0.f, 0.f, 0.f};
        cur = nxt; cA = nA; cB = nB; ++ui;
        if constexpr (ALIGN_EPI) { if (wr == 1) PG8_BAR; }
    }
    PG8_WAIT_V(0);
    if constexpr (!ALIGN_EPI) { if (wr == 0) PG8_BAR; }
    PG8_BAR;
    if constexpr (Epi::AFTER_DRAIN) { E.fused(acc, cur, wr, wc, fr, fq, lds, wid, lane); S.done(cur); }
#undef PG8_SA
#undef PG8_SB
#undef PG8_STAGE
#undef PG8_LDA
#undef PG8_LDB
#undef PG8_MMA
#undef PG8_WAIT_V
#undef PG8_WAIT_L
#undef PG8_BAR
#undef PG8_SCHED
}
}
constexpr int DM = 4096, NBATCH = 2, TL = 8192, TCX = 256, ML = NBATCH * TL, MC = NBATCH * TCX, MT = ML + MC;
constexpr int LW = 2048, GDW = 2048, NH = 16, HD = 128, DFF = 11008, NIN = 12352, NINP = 12544, NADA = 6 * DM;
constexpr int SEQ_S = TCX + TL;
constexpr int NCH = 132;
constexpr float EPS = 1e-6f;
enum { I_X = 0, I_C, I_CTX, I_CCTX, I_WADA, I_BADA, I_GPREMIX, I_GPOSTMIX, I_GPREFFN, I_GPOSTFFN, I_WIN, I_LCW, I_LCB, I_LWA, I_LBA, I_LWX, I_LBX, I_LLAM, I_LNG, I_GCW, I_GALOG, I_GDT, I_GNG, I_WOUT, I_WG, I_WU, I_WD, N_INPUTS };

constexpr size_t MiB = 1u << 20;
constexpr size_t WS_CTL = 0, CTL_ZERO_BYTES = 1 * MiB;
constexpr size_t WS_MODP = 1 * MiB, WS_MOD = 11 * MiB, WS_WL = 12 * MiB, WS_CAR = 14 * MiB, WS_HIN = 23 * MiB, WS_GB = 28 * MiB, WS_KQ = 33 * MiB, WS_SSQ = 35 * MiB;
constexpr size_t WS_WOUT = 44 * MiB, WS_WGU = 76 * MiB, WS_WDN = 248 * MiB;
constexpr size_t WS_R2 = 334 * MiB;
constexpr size_t WS_WIN = WS_R2, WS_H = WS_R2 + 98 * MiB;
constexpr size_t WS_QN = WS_R2, WS_KN = WS_R2 + 66 * MiB, WS_VN = WS_R2 + 132 * MiB;
constexpr size_t WS_H2 = WS_R2, WS_Y2 = WS_R2;
constexpr size_t WS_R3 = 590 * MiB;
constexpr size_t WS_LX = WS_R3, WS_LG = WS_R3 + 66 * MiB, WS_QKV = WS_R3 + 132 * MiB, WS_Z = WS_R3 + 330 * MiB, WS_BA = WS_R3 + 396 * MiB;
constexpr size_t WS_Y1 = WS_R3, WS_ACT = WS_R3;
constexpr size_t WS_MIX = 995 * MiB, WS_END = 1123 * MiB;
static_assert(WS_SSQ + (size_t)ML * 128 * 4 <= WS_WOUT && WS_WOUT + (size_t)DM * DM * 2 <= WS_WGU && WS_WGU + (size_t)2 * DFF * DM * 2 <= WS_WDN && WS_WDN + (size_t)DM * DFF * 2 <= WS_R2, "ws map 1");
static_assert(WS_WIN + (size_t)NINP * DM * 2 <= WS_H && WS_H + (size_t)MT * DM * 2 <= WS_R3 && WS_VN + (size_t)NBATCH * SEQ_S * 2048 * 2 <= WS_R3 && WS_Y2 + (size_t)ML * DM * 4 <= WS_R3, "ws map 2");
static_assert((size_t)MT * 2048 * 2 <= 66 * MiB && (size_t)MT * 6144 * 2 <= 198 * MiB && WS_BA + (size_t)MT * 256 * 2 <= WS_MIX && WS_ACT + (size_t)ML * DFF * 2 <= WS_MIX && WS_MIX + (size_t)ML * DM * 2 <= WS_END, "ws map 3");
constexpr int CW_BAR = 4096;

constexpr int LDS_BYTES = 147456;
constexpr int MISC_OFF = LDS_BYTES - 256;

#define GAS __attribute__((address_space(1)))
#define LAS __attribute__((address_space(3)))
typedef unsigned short bf16;
typedef unsigned u32x4 __attribute__((ext_vector_type(4)));
typedef unsigned u32x2 __attribute__((ext_vector_type(2)));
typedef float f32x4 __attribute__((ext_vector_type(4)));
typedef float f32x2 __attribute__((ext_vector_type(2)));
typedef short bf16x8 __attribute__((ext_vector_type(8)));
#define LDS_WAIT() asm volatile("s_waitcnt lgkmcnt(0)" ::: "memory")
#define WAVE_LDS_FENCE() do { asm volatile("s_waitcnt lgkmcnt(0)" ::: "memory"); __builtin_amdgcn_wave_barrier(); } while (0)
__device__ __forceinline__ unsigned f2bf(float f) { unsigned u = __builtin_bit_cast(unsigned, f); return (u + 0x7fffu + ((u >> 16) & 1u)) >> 16; }
__device__ __forceinline__ unsigned pk2(float lo, float hi) { return f2bf(lo) | (f2bf(hi) << 16); }
__device__ __forceinline__ float bf2f(unsigned h) { return __builtin_bit_cast(float, h << 16); }
__device__ __forceinline__ float bflo(unsigned w) { return __builtin_bit_cast(float, w << 16); }
__device__ __forceinline__ float bfhi(unsigned w) { return __builtin_bit_cast(float, w & 0xffff0000u); }
__device__ __forceinline__ float wave_sum(float v) {
#pragma unroll
    for (int o = 1; o < 64; o <<= 1) v += __shfl_xor(v, o);
    return v;
}
__device__ __forceinline__ float sigmoidf_(float x) { return __builtin_amdgcn_rcpf(1.0f + __expf(-x)); }
__device__ __forceinline__ float siluf_(float x) { return x * sigmoidf_(x); }
__device__ __forceinline__ float softplusf_(float x) { return x > 20.f ? x : log1pf(__expf(x)); }
__device__ __forceinline__ float gelu_tanhf_(float x) { const float u = 0.7978845608028654f * (x + 0.044715f * x * x * x); const float t = 1.0f - 2.0f * __builtin_amdgcn_rcpf(__expf(2.0f * u) + 1.0f); return 0.5f * x * (1.0f + t); }
__device__ __forceinline__ float rdlane(float x, int l) { return __builtin_bit_cast(float, __builtin_amdgcn_readlane(__builtin_bit_cast(int, x), l)); }

#define XB_TMO      128
#define XB_XCNT(j)  (256  + 64 * (j))
#define XB_XSUB(j)  (1280 + 64 * (j))
#define XB_XGEN(j)  (2304 + 64 * (j))
#define XB_TOP      3328
#define XB_TOPGEN   3392
#define XCD_BAR_WORDS 3456
#define XB_SPIN_CAP (1u << 22)
__device__ __forceinline__ unsigned xb_ld(unsigned* p)              { return __hip_atomic_load(p, __ATOMIC_RELAXED, __HIP_MEMORY_SCOPE_AGENT); }
__device__ __forceinline__ unsigned xb_add(unsigned* p, unsigned v) { return __hip_atomic_fetch_add(p, v, __ATOMIC_RELAXED, __HIP_MEMORY_SCOPE_AGENT); }
__device__ __forceinline__ unsigned xb_xcc_id() { return (unsigned)__builtin_amdgcn_s_getreg((3 << 11) | 20) & 0xFu; }
#define XB_SPIN(cond, bar) do { unsigned _sp = 0; while (cond) { __builtin_amdgcn_s_sleep(1); \
    if ((++_sp & 255u) == 0u) { if (xb_ld(&(bar)[XB_TMO])) break; if (_sp > XB_SPIN_CAP) { atomicAdd(&(bar)[XB_TMO], 1u); break; } } } } while (0)
struct XcdBarrier { unsigned* bar; unsigned x; volatile LAS unsigned* st; };
__device__ __forceinline__ XcdBarrier xcd_barrier_post(unsigned* bar, volatile LAS unsigned* st) {
    XcdBarrier b; b.bar = bar; b.x = xb_xcc_id(); b.st = st;
    if (threadIdx.x == 0) (void)xb_add(&bar[XB_XCNT(b.x)], 1u);
    return b;
}
__device__ __forceinline__ void xcd_barrier_complete(unsigned* bar, unsigned x, unsigned& nloc, unsigned& nx) {
    const unsigned G = gridDim.x * gridDim.y * gridDim.z;
    unsigned sum, cnt, mine, sp = 0u;
    for (;;) {
        sum = 0u; cnt = 0u; mine = 0u;
#pragma unroll
        for (unsigned j = 0; j < 16; ++j) { const unsigned c = xb_ld(&bar[XB_XCNT(j)]); sum += c; cnt += (c > 0u) ? 1u : 0u; mine = (j == x) ? c : mine; }
        if (sum == G) break;
        __builtin_amdgcn_s_sleep(1);
        if ((++sp & 255u) == 0u) { if (xb_ld(&bar[XB_TMO])) break; if (sp > XB_SPIN_CAP) { atomicAdd(&bar[XB_TMO], 1u); break; } }
    }
    nloc = mine > 0u ? mine : 1u; nx = cnt > 0u ? cnt : 1u;
}
__device__ __forceinline__ void xcd_barrier(const XcdBarrier& b) {
    asm volatile("s_waitcnt vmcnt(0)" ::: "memory");
    __syncthreads();
    if (threadIdx.x == 0) {
        unsigned* bar = b.bar;
        __builtin_amdgcn_s_waitcnt(0);
        unsigned nloc = b.st[0], nx = b.st[1];
        if (nloc == 0u) { xcd_barrier_complete(bar, b.x, nloc, nx); b.st[0] = nloc; b.st[1] = nx; }
        const unsigned old = xb_add(&bar[XB_XSUB(b.x)], 1u);
        const unsigned gen = old / nloc;
        if (old + 1u == (gen + 1u) * nloc) {
            __builtin_amdgcn_fence(__ATOMIC_RELEASE, "agent");
            asm volatile("s_waitcnt vmcnt(0)" ::: "memory");
            const unsigned og = xb_add(&bar[XB_TOP], 1u);
            const unsigned tg = og / nx;
            if (og + 1u == (tg + 1u) * nx) xb_add(&bar[XB_TOPGEN], 1u);
            else XB_SPIN(xb_ld(&bar[XB_TOPGEN]) == tg, bar);
            __builtin_amdgcn_fence(__ATOMIC_ACQUIRE, "agent");
            xb_add(&bar[XB_XGEN(b.x)], 1u);
            asm volatile("s_waitcnt vmcnt(0)" ::: "memory");
        } else {
            XB_SPIN(xb_ld(&bar[XB_XGEN(b.x)]) == gen, bar);
            __builtin_amdgcn_fence(__ATOMIC_ACQUIRE, "agent");
            asm volatile("s_waitcnt vmcnt(0)" ::: "memory");
        }
    }
    __syncthreads();
}

struct Args { const float* in[N_INPUTS]; float* out; unsigned char* ws; int ph_lo, ph_hi; };
struct Frame {
    LAS unsigned char* lds;
    int tid, lane, wave, vcu, G;
    const float* const* in;
    float* out; unsigned char* ws;
};
#define F_modp ((float*)(F.ws + WS_MODP))
#define F_mod ((float*)(F.ws + WS_MOD))
#define F_WL ((bf16*)(F.ws + WS_WL))
#define F_CAR ((f32x2*)(F.ws + WS_CAR))
#define F_HIN ((float*)(F.ws + WS_HIN))
#define F_GB ((f32x2*)(F.ws + WS_GB))
#define F_KQ ((float*)(F.ws + WS_KQ))
#define F_SSQ ((float*)(F.ws + WS_SSQ))
#define F_Wt_out ((bf16*)(F.ws + WS_WOUT))
#define F_Wt_gu ((bf16*)(F.ws + WS_WGU))
#define F_Wt_dn ((bf16*)(F.ws + WS_WDN))
#define F_Wt_in ((bf16*)(F.ws + WS_WIN))
#define F_H ((bf16*)(F.ws + WS_H))
#define F_QN ((bf16*)(F.ws + WS_QN))
#define F_KN ((bf16*)(F.ws + WS_KN))
#define F_VN ((bf16*)(F.ws + WS_VN))
#define F_H2 ((bf16*)(F.ws + WS_H2))
#define F_LX ((bf16*)(F.ws + WS_LX))
#define F_LG ((bf16*)(F.ws + WS_LG))
#define F_QKV ((bf16*)(F.ws + WS_QKV))
#define F_Z ((bf16*)(F.ws + WS_Z))
#define F_BA ((bf16*)(F.ws + WS_BA))
#define F_ACT ((bf16*)(F.ws + WS_ACT))
#define F_MIX ((bf16*)(F.ws + WS_MIX))
#define F_Y1 ((float*)(F.ws + WS_Y1))
#define F_Y2 ((float*)(F.ws + WS_Y2))
#define F_O (F.out)
__device__ __forceinline__ void transpose_item(const float* W, int N, bf16* WT, int Kp, int k0, int n0, int drow0, LAS float* scr, int lane) {
#pragma unroll 8
    for (int i = 0; i < 32; ++i) { const int kk = 2 * i + (lane >> 5); scr[kk * 33 + (lane & 31)] = W[(size_t)(k0 + kk) * N + n0 + (lane & 31)]; }
    LDS_WAIT(); asm volatile("" ::: "memory");
    const int c = lane & 7;
#pragma unroll
    for (int j = 0; j < 4; ++j) { const int n = (lane >> 3) + 8 * j; const LAS float* s = scr + (8 * c) * 33 + n;
        u32x4 o; o.x = pk2(s[0 * 33], s[1 * 33]); o.y = pk2(s[2 * 33], s[3 * 33]); o.z = pk2(s[4 * 33], s[5 * 33]); o.w = pk2(s[6 * 33], s[7 * 33]);
        *(u32x4*)(WT + (size_t)(drow0 + n) * Kp + k0 + 8 * c) = o; }
    LDS_WAIT(); asm volatile("" ::: "memory");
}

__device__ __forceinline__ void ph0_prologue(const Frame& F) {
    const int gw = F.vcu * 8 + F.wave, NGW = F.G * 8, lane = F.lane;
    {
        const float* W = F.in[I_WADA]; const float* c = F.in[I_C]; const float* cc = F.in[I_CCTX];
        for (int it = gw; it < 96 * 32; it += NGW) {
            const int cg = it % 96, kc = it / 96;
            float sv[3][2];
#pragma unroll
            for (int h = 0; h < 2; ++h) { const int k = kc * 128 + h * 64 + lane; sv[0][h] = siluf_(c[k]); sv[1][h] = siluf_(c[DM + k]); sv[2][h] = siluf_(cc[k]); }
            f32x4 a0 = {0.f, 0.f, 0.f, 0.f}, a1 = a0, a2 = a0;
            const f32x4* wp = (const f32x4*)(W + (size_t)kc * 128 * NADA + cg * 256) + lane;
#pragma unroll
            for (int h = 0; h < 2; ++h) {
#pragma unroll 8
                for (int kk = 0; kk < 64; ++kk) { const f32x4 w = wp[(size_t)(h * 64 + kk) * (NADA / 4)];
                    const float s0 = rdlane(sv[0][h], kk), s1 = rdlane(sv[1][h], kk), s2 = rdlane(sv[2][h], kk);
                    a0 += w * s0; a1 += w * s1; a2 += w * s2; } }
            float* mp = F_modp + (size_t)(kc * 3) * NADA + cg * 256;
            ((f32x4*)mp)[lane] = a0; ((f32x4*)(mp + NADA))[lane] = a1; ((f32x4*)(mp + 2 * NADA))[lane] = a2;
        }
    }
    {
        LAS float* scr = (LAS float*)(F.lds + F.wave * 16384);
        constexpr int IT_IN = 64 * (NIN / 32), IT_OUT = 64 * (DM / 32), IT_G = 64 * (DFF / 32), IT_D = (DFF / 64) * (DM / 32), IT_L = 64 * 8;
        constexpr int NITEMS = IT_IN + IT_OUT + 2 * IT_G + IT_D + IT_L;
        for (int it = gw; it < NITEMS; it += NGW) {
            int r = it;
            if (r < IT_IN) { const int kb = r / (NIN / 32), nb = r % (NIN / 32); transpose_item(F.in[I_WIN], NIN, F_Wt_in, DM, 64 * kb, 32 * nb, 32 * nb, scr, lane); continue; } r -= IT_IN;
            if (r < IT_OUT) { const int kb = r / (DM / 32), nb = r % (DM / 32); transpose_item(F.in[I_WOUT], DM, F_Wt_out, DM, 64 * kb, 32 * nb, 32 * nb, scr, lane); continue; } r -= IT_OUT;
            if (r < 2 * IT_G) { const int up = r >= IT_G; if (up) r -= IT_G; const int kb = r / (DFF / 32), nb = r % (DFF / 32), n0 = 32 * nb;
                transpose_item(F.in[up ? I_WU : I_WG], DFF, F_Wt_gu, DM, 64 * kb, n0, 256 * (n0 >> 7) + (n0 & 127) + (up ? 128 : 0), scr, lane); continue; } r -= 2 * IT_G;
            if (r < IT_D) { const int kb = r / (DM / 32), nb = r % (DM / 32); transpose_item(F.in[I_WD], DM, F_Wt_dn, DFF, 64 * kb, 32 * nb, 32 * nb, scr, lane); continue; } r -= IT_D;
            { const int mi = r >> 3, sub = r & 7, kb = sub >> 2, nb = sub & 3, d = mi >> 5, kind = (mi >> 4) & 1, n = mi & 15;
              transpose_item(F.in[kind ? I_LWX : I_LWA] + (size_t)(d * 16 + n) * 16384, 128, F_WL + (size_t)((d * 2 + kind) * 16 + n) * 16384, 128, 64 * kb, 32 * nb, 32 * nb, scr, lane); }
        }
    }
    {
        u32x4* p = (u32x4*)(F_Wt_in + (size_t)NIN * DM); const u32x4 z = {0u, 0u, 0u, 0u};
        for (int i = F.vcu * 512 + F.tid; i < (NINP - NIN) * DM / 8; i += F.G * 512) p[i] = z;
    }
}
__device__ __forceinline__ void ph1_modreduce(const Frame& F) {
    const float* ba = F.in[I_BADA];
    for (int i = F.vcu * 512 + F.tid; i < 3 * NADA; i += F.G * 512) { const int r = i / NADA, col = i - r * NADA; float s = ba[col];
#pragma unroll 8
        for (int kc = 0; kc < 32; ++kc) s += F_modp[(size_t)(kc * 3 + r) * NADA + col];
        F_mod[i] = s; }
}
__device__ __forceinline__ void ph2_hrows(const Frame& F) {
    const int gw = F.vcu * 8 + F.wave, NGW = F.G * 8, lane = F.lane;
    const f32x4* g4 = (const f32x4*)F.in[I_GPREMIX];
    for (int row = gw; row < MT; row += NGW) {
        const float* xr = row < ML ? F.in[I_X] + (size_t)row * DM : F.in[I_CTX] + (size_t)(row - ML) * DM;
        const int mr = row < ML ? row / TL : 2;
        const f32x4* sh4 = (const f32x4*)(F_mod + (size_t)mr * NADA); const f32x4* sc4 = sh4 + DM / 4;
        f32x4 v[16]; float ss = 0.f;
#pragma unroll
        for (int j = 0; j < 16; ++j) { v[j] = ((const f32x4*)xr)[lane + 64 * j]; ss += (v[j].x * v[j].x + v[j].y * v[j].y) + (v[j].z * v[j].z + v[j].w * v[j].w); }
        const float rs = rsqrtf(wave_sum(ss) * (1.0f / DM) + EPS);
        u32x2* o = (u32x2*)(F_H + (size_t)row * DM);
#pragma unroll
        for (int j = 0; j < 16; ++j) { const f32x4 g = g4[lane + 64 * j], sh = sh4[lane + 64 * j], sc = sc4[lane + 64 * j];
            const f32x4 y = (v[j] * rs * g) * (sc + 1.0f) + sh; u32x2 w; w.x = pk2(y.x, y.y); w.y = pk2(y.z, y.w); o[lane + 64 * j] = w; }
    }
}

template <int PASS>
__device__ __forceinline__ void lru_pass(const Frame& F) {
    LAS bf16* U = (LAS bf16*)(F.lds);
    LAS float* XC = (LAS float*)(F.lds + 17408);
    LAS bf16* XCB = (LAS bf16*)(F.lds + 17408 + 32768);
    LAS f32x2* SC = (LAS f32x2*)(F.lds + 17408 + 32768 + 17408 + F.wave * 8192);
    const int tid = F.tid, lane = F.lane, w = F.wave, fr = lane & 15, fq = lane >> 4;
    const int n = F.vcu & 15;
    const int cl = 16 * w + fr, cg = n * 128 + cl;
    float ba[2], bx[2], sp[2];
#pragma unroll
    for (int d = 0; d < 2; ++d) { ba[d] = F.in[I_LBA][d * LW + cg]; bx[d] = F.in[I_LBX][d * LW + cg]; sp[d] = softplusf_(-F.in[I_LLAM][d * LW + cg]); }
    const int cc = tid & 127, tg = tid >> 7;
    float cw[4];
#pragma unroll
    for (int j = 0; j < 4; ++j) cw[j] = F.in[I_LCW][j * LW + n * 128 + cc];
    const float cb = F.in[I_LCB][n * 128 + cc];
    for (int q = F.vcu >> 4; q < NBATCH * NCH; q += F.G >> 4) {
        const int b = q / NCH, cidx = q - b * NCH;
        if (PASS == 2 && cidx < 4) continue;
        const bool isctx = cidx < 4; const int t0 = isctx ? cidx * 64 : (cidx - 4) * 64, Tseq = isctx ? TCX : TL;
        const size_t rowbase = isctx ? (size_t)ML + (size_t)b * TCX : (size_t)b * TL;
        __syncthreads();
        for (int rr = tid >> 4; rr < 67; rr += 32) { const int t = t0 - 2 + rr; u32x4 v = {0u, 0u, 0u, 0u};
            if (t >= 0 && t < Tseq) v = *(const u32x4*)(F_LX + (rowbase + t) * LW + n * 128 + (tid & 15) * 8);
            *(LAS u32x4*)(U + rr * 128 + (tid & 15) * 8) = v; }
        u32x4 gt0 = {0u, 0u, 0u, 0u}, gt1 = gt0;
        if (PASS == 2) { gt0 = *(const u32x4*)(F_LG + (rowbase + t0 + (tid >> 4)) * LW + n * 128 + (tid & 15) * 8); gt1 = *(const u32x4*)(F_LG + (rowbase + t0 + 32 + (tid >> 4)) * LW + n * 128 + (tid & 15) * 8); }
        __syncthreads();
        { float x0 = bf2f(U[(tg * 16 + 0) * 128 + cc]), x1 = bf2f(U[(tg * 16 + 1) * 128 + cc]), x2 = bf2f(U[(tg * 16 + 2) * 128 + cc]);
#pragma unroll
          for (int i = 0; i < 16; ++i) { const int tt = tg * 16 + i; const float x3 = bf2f(U[(tt + 3) * 128 + cc]);
              const float y = cb + cw[0] * x0 + cw[1] * x1 + cw[2] * x2 + cw[3] * x3; XC[tt * 128 + cc] = y; XCB[tt * 136 + cc] = (bf16)f2bf(y); x0 = x1; x1 = x2; x2 = x3; } }
        __syncthreads();
        if (PASS == 2) { *(LAS u32x4*)(U + (tid >> 4) * 128 + (tid & 15) * 8) = gt0; *(LAS u32x4*)(U + (32 + (tid >> 4)) * 128 + (tid & 15) * 8) = gt1; }
        float hsum[4][4];
#pragma unroll
        for (int d = 0; d < 2; ++d) {
            bf16x8 bfr[2][4];
#pragma unroll
            for (int mat = 0; mat < 2; ++mat)
#pragma unroll
                for (int ks = 0; ks < 4; ++ks) bfr[mat][ks] = *(const bf16x8*)(F_WL + ((size_t)((2 * d + mat) * 16 + n) * 128 + cl) * 128 + 32 * ks + 8 * fq);
            f32x4 acc[2][4];
#pragma unroll
            for (int mat = 0; mat < 2; ++mat)
#pragma unroll
                for (int mt = 0; mt < 4; ++mt) acc[mat][mt] = (f32x4){0.f, 0.f, 0.f, 0.f};
#pragma unroll
            for (int mt = 0; mt < 4; ++mt)
#pragma unroll
                for (int ks = 0; ks < 4; ++ks) { const bf16x8 af = *(const LAS bf16x8*)(XCB + (16 * mt + fr) * 136 + 32 * ks + 8 * fq);
                    acc[0][mt] = __builtin_amdgcn_mfma_f32_16x16x32_bf16(af, bfr[0][ks], acc[0][mt], 0, 0, 0);
                    acc[1][mt] = __builtin_amdgcn_mfma_f32_16x16x32_bf16(af, bfr[1][ks], acc[1][mt], 0, 0, 0); }
#pragma unroll
            for (int mt = 0; mt < 4; ++mt)
#pragma unroll
                for (int rg = 0; rg < 4; ++rg) { const int tok = 16 * mt + 4 * fq + rg; const float xcv = XC[tok * 128 + cl];
                    const float r = sigmoidf_(acc[0][mt][rg] + ba[d]), ig = sigmoidf_(acc[1][mt][rg] + bx[d]);
                    const float la = -8.0f * r * sp[d]; const float a = __expf(la); const float x2 = 2.0f * la;
                    const float em = -x2 * (1.0f + x2 * (0.5f + x2 * (0.16666667f + x2 * (0.041666668f + x2 * (0.0083333338f + x2 * 0.0013888889f)))));
                    const float bb = sqrtf(em) * (ig * xcv);
                    SC[tok * 16 + fr] = (f32x2){a, bb}; }
            WAVE_LDS_FENCE();
            float P = 1.0f, h = 0.0f;
#pragma unroll
            for (int i = 0; i < 16; ++i) { const int tok = 16 * fq + (d == 0 ? i : 15 - i); const f32x2 ab = SC[tok * 16 + fr]; h = ab.x * h + ab.y; P *= ab.x; SC[tok * 16 + fr] = (f32x2){P, h}; }
            float As[4], Bs[4];
#pragma unroll
            for (int s = 0; s < 4; ++s) { As[s] = __shfl(P, s * 16 + fr); Bs[s] = __shfl(h, s * 16 + fr); }
            const size_t cidx_off = ((size_t)((d * 2 + b) * NCH + cidx)) * LW + cg;
            if (PASS == 1) {
                float At = 1.0f, Bt = 0.0f;
#pragma unroll
                for (int s = 0; s < 4; ++s) { const int sgi = d == 0 ? s : 3 - s; Bt = As[sgi] * Bt + Bs[sgi]; At *= As[sgi]; }
                if (fq == 0) F_CAR[cidx_off] = (f32x2){At, Bt};
            } else {
                float hin = F_HIN[cidx_off];
#pragma unroll
                for (int s = 0; s < 4; ++s) { const int sgi = d == 0 ? s : 3 - s; const bool before = d == 0 ? (sgi < fq) : (sgi > fq); if (before) hin = As[sgi] * hin + Bs[sgi]; }
#pragma unroll
                for (int i = 0; i < 16; ++i) { const int tok = 16 * fq + i; const f32x2 ph = SC[tok * 16 + fr]; SC[tok * 16 + fr] = (f32x2){ph.x, ph.y + ph.x * hin}; }
                WAVE_LDS_FENCE();
#pragma unroll
                for (int mt = 0; mt < 4; ++mt)
#pragma unroll
                    for (int rg = 0; rg < 4; ++rg) { const float hv = SC[(16 * mt + 4 * fq + rg) * 16 + fr].y; hsum[mt][rg] = d == 0 ? hv : hsum[mt][rg] + hv; }
            }
            WAVE_LDS_FENCE();
        }
        if (PASS == 2) {
            __syncthreads();
#pragma unroll
            for (int mt = 0; mt < 4; ++mt)
#pragma unroll
                for (int rg = 0; rg < 4; ++rg) { const int tok = 16 * mt + 4 * fq + rg;
                    const float y = hsum[mt][rg] * gelu_tanhf_(bf2f(U[tok * 128 + cl])); XCB[tok * 136 + cl] = (bf16)f2bf(y); }
            __syncthreads();
#pragma unroll
            for (int hh = 0; hh < 2; ++hh) { const int tok = hh * 32 + (tid >> 4); const u32x4 wv = *(const LAS u32x4*)(XCB + tok * 136 + (tid & 15) * 8);
                const size_t row = rowbase + t0 + tok; *(u32x4*)(F_MIX + row * DM + n * 128 + (tid & 15) * 8) = wv;
                float sq = (bflo(wv.x) * bflo(wv.x) + bfhi(wv.x) * bfhi(wv.x)) + (bflo(wv.y) * bflo(wv.y) + bfhi(wv.y) * bfhi(wv.y)) + (bflo(wv.z) * bflo(wv.z) + bfhi(wv.z) * bfhi(wv.z)) + (bflo(wv.w) * bflo(wv.w) + bfhi(wv.w) * bfhi(wv.w));
                sq += __shfl_xor(sq, 1); sq += __shfl_xor(sq, 2); sq += __shfl_xor(sq, 4); sq += __shfl_xor(sq, 8);
                if ((tid & 15) == 0) F_SSQ[row * 16 + n] = sq; }
        }
    }
}
__device__ __forceinline__ int gdn_row(int b, int s) {
    if (s < TCX) return ML + b * TCX + s;
    const int m = s - TCX; return b * TL + (m & 127) * 64 + (m >> 7);
}
__device__ __forceinline__ void gdn_pre(const Frame& F) {
    const int gw = F.vcu * 8 + F.wave, NGW = F.G * 8, lane = F.lane;
    const float* cw = F.in[I_GCW];
    for (int tok = gw; tok < NBATCH * SEQ_S; tok += NGW) {
        const int b = tok / SEQ_S, s = tok - b * SEQ_S;
        const int lo = s < TCX ? 0 : TCX, hi = s < TCX ? TCX : SEQ_S;
        int rows[4]; bool val[4];
#pragma unroll
        for (int j = 0; j < 4; ++j) { const int sj = s + j - 2; val[j] = sj >= lo && sj < hi; rows[j] = gdn_row(b, val[j] ? sj : s); }
        for (int h = 0; h < NH; ++h) {
            float a[3][2];
#pragma unroll
            for (int p = 0; p < 3; ++p) { a[p][0] = 0.f; a[p][1] = 0.f; }
#pragma unroll
            for (int j = 0; j < 4; ++j) {
#pragma unroll
                for (int p = 0; p < 3; ++p) { const int ch = p * GDW + h * HD + 2 * lane;
                    const unsigned xw = val[j] ? *(const unsigned*)(F_QKV + (size_t)rows[j] * 6144 + ch) : 0u;
                    const f32x2 wv = *(const f32x2*)(cw + (size_t)j * 6144 + ch);
                    a[p][0] += wv.x * bflo(xw); a[p][1] += wv.y * bfhi(xw); } }
#pragma unroll
            for (int p = 0; p < 3; ++p) { a[p][0] = siluf_(a[p][0]); a[p][1] = siluf_(a[p][1]); }
            const float rq = rsqrtf(wave_sum(a[0][0] * a[0][0] + a[0][1] * a[0][1]) + EPS), rk = rsqrtf(wave_sum(a[1][0] * a[1][0] + a[1][1] * a[1][1]) + EPS);
            const unsigned qw = pk2(a[0][0] * rq, a[0][1] * rq), kw = pk2(a[1][0] * rk, a[1][1] * rk), vw = pk2(a[2][0], a[2][1]);
            const float kq = wave_sum(bflo(qw) * bflo(kw) + bfhi(qw) * bfhi(kw));
            const size_t o = ((size_t)b * SEQ_S + s) * GDW + h * HD + 2 * lane;
            *(unsigned*)(F_QN + o) = qw; *(unsigned*)(F_KN + o) = kw; *(unsigned*)(F_VN + o) = vw;
            if (lane == 0) F_KQ[(size_t)(b * NH + h) * SEQ_S + s] = kq;
        }
        if (lane < 32) { const int d = lane >> 4, h = lane & 15; const bf16* bar = F_BA + (size_t)rows[2] * 256;
            const float pb = bf2f(bar[d * 16 + h]), pa = bf2f(bar[32 + d * 16 + h]);
            const float beta = sigmoidf_(pb), g = -__expf(F.in[I_GALOG][d * 16 + h]) * softplusf_(pa + F.in[I_GDT][d * 16 + h]);
            F_GB[(size_t)((d * 2 + b) * NH + h) * SEQ_S + s] = (f32x2){g, beta}; }
    }
}
__device__ __forceinline__ void lru_chains(const Frame& F) {
    if (F.tid < 32) {
        for (int chain = F.vcu * 32 + F.tid; chain < 2 * NBATCH * LW; chain += F.G * 32) {
            const int cg = chain & (LW - 1), b = (chain >> 11) & 1, d = chain >> 12;
            float h = 0.f;
#pragma unroll 4
            for (int step = 0; step < NCH; ++step) { const int cidx = d == 0 ? step : (step < 4 ? 3 - step : NCH - 1 - (step - 4));
                const size_t idx = ((size_t)((d * 2 + b) * NCH + cidx)) * LW + cg; const f32x2 ab = F_CAR[idx]; F_HIN[idx] = h; h = ab.x * h + ab.y; }
        }
    }
}
__device__ __forceinline__ int gdn_spos(int d, int step) { return d == 0 ? step : (step < TCX ? TCX - 1 - step : SEQ_S - 1 - (step - TCX)); }
__device__ __forceinline__ void gdn_seq(const Frame& F, int item) {
    const int sl = item & 3, d = (item >> 2) & 1, h = (item >> 3) & 15, b = item >> 7;
    LAS float* Kst = (LAS float*)F.lds;
    LAS float* Qst = Kst + 2048;
    LAS float* Vst = Qst + 2048;
    LAS float* Gst = Vst + 512;
    LAS f32x2* RED = (LAS f32x2*)(Gst + 64);
    const int tid = F.tid, v = tid & 31, kg = tid >> 5;
    float S[8];
#pragma unroll
    for (int i = 0; i < 8; ++i) S[i] = 0.f;
    const bf16* Kb = F_KN + (size_t)b * SEQ_S * GDW + h * HD + (tid & 31) * 4;
    const bf16* Qb = F_QN + (size_t)b * SEQ_S * GDW + h * HD + (tid & 31) * 4;
    const bf16* Vb = F_VN + (size_t)b * SEQ_S * GDW + h * HD + sl * 32 + (tid & 31);
    const f32x2* GBp = F_GB + (size_t)((d * 2 + b) * NH + h) * SEQ_S; const float* KQp = F_KQ + (size_t)(b * NH + h) * SEQ_S;
    float* Ob = F_O + (size_t)d * ML * GDW + h * HD + sl * 32 + v;
    u32x2 pk, pq; unsigned pv; f32x2 pgb = {0.f, 0.f}; float pkq = 0.f;
#define GDN_LOADG(g0) do { const int s_ = gdn_spos(d, (g0) + (tid >> 5)); pk = *(const u32x2*)(Kb + (size_t)s_ * GDW); pq = *(const u32x2*)(Qb + (size_t)s_ * GDW); pv = Vb[(size_t)s_ * GDW]; \
        if (tid < 16) { const int s2_ = gdn_spos(d, (g0) + tid); pgb = GBp[s2_]; pkq = KQp[s2_]; } } while (0)
    GDN_LOADG(0);
    for (int g0 = 0; g0 < SEQ_S; g0 += 16) {
        *(LAS f32x4*)(Kst + (tid >> 5) * 128 + (tid & 31) * 4) = (f32x4){bflo(pk.x), bfhi(pk.x), bflo(pk.y), bfhi(pk.y)};
        *(LAS f32x4*)(Qst + (tid >> 5) * 128 + (tid & 31) * 4) = (f32x4){bflo(pq.x), bfhi(pq.x), bflo(pq.y), bfhi(pq.y)};
        Vst[(tid >> 5) * 32 + (tid & 31)] = bf2f(pv);
        if (tid < 16) { Gst[tid] = __expf(pgb.x); Gst[16 + tid] = pgb.y; Gst[32 + tid] = pkq; }
        if (g0 + 16 < SEQ_S) GDN_LOADG(g0 + 16);
        __syncthreads();
#pragma unroll 2
        for (int j = 0; j < 16; ++j) {
            const f32x4 k0 = *(const LAS f32x4*)(Kst + j * 128 + kg * 8), k1 = *(const LAS f32x4*)(Kst + j * 128 + kg * 8 + 4);
            const f32x4 q0 = *(const LAS f32x4*)(Qst + j * 128 + kg * 8), q1 = *(const LAS f32x4*)(Qst + j * 128 + kg * 8 + 4);
            const float kk[8] = {k0.x, k0.y, k0.z, k0.w, k1.x, k1.y, k1.z, k1.w}, qq[8] = {q0.x, q0.y, q0.z, q0.w, q1.x, q1.y, q1.z, q1.w};
            const float vv = Vst[j * 32 + v], eg = Gst[j], be = Gst[16 + j], kq = Gst[32 + j];
            float pkk = 0.f, pqq = 0.f;
#pragma unroll
            for (int i = 0; i < 8; ++i) { S[i] *= eg; pkk += kk[i] * S[i]; pqq += qq[i] * S[i]; }
            RED[(j & 1) * 512 + kg * 32 + v] = (f32x2){pkk, pqq};
            __syncthreads();
            float ks = 0.f, qs = 0.f;
#pragma unroll
            for (int g = 0; g < 16; ++g) { const f32x2 r = RED[(j & 1) * 512 + g * 32 + v]; ks += r.x; qs += r.y; }
            const float delta = be * (vv - ks);
#pragma unroll
            for (int i = 0; i < 8; ++i) S[i] += kk[i] * delta;
            if (kg == 0) { const int s = gdn_spos(d, g0 + j); if (s >= TCX) Ob[(size_t)gdn_row(b, s) * GDW] = (qs + delta * kq) * 0.08838834764831845f; }
        }
    }
#undef GDN_LOADG
    __syncthreads();
}
__device__ __forceinline__ void gdn_combine(const Frame& F) {
    const int gw = F.vcu * 8 + F.wave, NGW = F.G * 8, lane = F.lane;
    const f32x2 gn = *(const f32x2*)(F.in[I_GNG] + 2 * lane);
    for (int row = gw; row < ML; row += NGW) {
#pragma unroll 4
        for (int h = 0; h < NH; ++h) { const size_t o = (size_t)row * GDW + h * HD + 2 * lane;
            const f32x2 a = *(const f32x2*)(F_O + o), c = *(const f32x2*)(F_O + (size_t)ML * GDW + o); const float o0 = a.x + c.x, o1 = a.y + c.y;
            const float rs = rsqrtf(wave_sum(o0 * o0 + o1 * o1) * (1.0f / HD) + EPS);
            const unsigned zw = *(const unsigned*)(F_Z + o);
            *(unsigned*)(F_MIX + (size_t)row * DM + LW + h * HD + 2 * lane) = pk2(o0 * rs * gn.x * siluf_(bflo(zw)), o1 * rs * gn.y * siluf_(bfhi(zw))); }
    }
}
__device__ __forceinline__ void lru_normalize(const Frame& F) {
    const int gw = F.vcu * 8 + F.wave, NGW = F.G * 8, lane = F.lane;
    for (int row = gw; row < ML; row += NGW) {
        const float p = lane < 16 ? F_SSQ[(size_t)row * 16 + lane] : 0.f;
        const float rs = rsqrtf(wave_sum(p) * (1.0f / LW) + EPS);
#pragma unroll
        for (int j = 0; j < 4; ++j) { const int c0 = (lane + 64 * j) * 8; u32x4* p4 = (u32x4*)(F_MIX + (size_t)row * DM + c0); const u32x4 w = *p4;
            const f32x4 g0 = *(const f32x4*)(F.in[I_LNG] + c0), g1 = *(const f32x4*)(F.in[I_LNG] + c0 + 4);
            u32x4 o; o.x = pk2(bflo(w.x) * rs * g0.x, bfhi(w.x) * rs * g0.y); o.y = pk2(bflo(w.y) * rs * g0.z, bfhi(w.y) * rs * g0.w);
            o.z = pk2(bflo(w.z) * rs * g1.x, bfhi(w.z) * rs * g1.y); o.w = pk2(bflo(w.w) * rs * g1.z, bfhi(w.w) * rs * g1.w); *p4 = o; }
    }
}
__device__ __forceinline__ void ph_x1(const Frame& F) {
    const int gw = F.vcu * 8 + F.wave, NGW = F.G * 8, lane = F.lane;
    const f32x4* gpm = (const f32x4*)F.in[I_GPOSTMIX]; const f32x4* gpf = (const f32x4*)F.in[I_GPREFFN];
    for (int row = gw; row < ML; row += NGW) {
        const f32x4* md = (const f32x4*)(F_mod + (size_t)(row / TL) * NADA);
        const f32x4* yr = (const f32x4*)(F_Y1 + (size_t)row * DM); const f32x4* xr = (const f32x4*)(F.in[I_X] + (size_t)row * DM); f32x4* outr = (f32x4*)(F.out + (size_t)row * DM);
        f32x4 y[16]; float ss = 0.f;
#pragma unroll
        for (int j = 0; j < 16; ++j) { y[j] = yr[lane + 64 * j]; ss += (y[j].x * y[j].x + y[j].y * y[j].y) + (y[j].z * y[j].z + y[j].w * y[j].w); }
        const float rs = rsqrtf(wave_sum(ss) * (1.0f / DM) + EPS); float s2 = 0.f;
#pragma unroll
        for (int j = 0; j < 16; ++j) { const f32x4 x1 = xr[lane + 64 * j] + md[2 * (DM / 4) + lane + 64 * j] * (y[j] * rs * gpm[lane + 64 * j]);
            outr[lane + 64 * j] = x1; y[j] = x1; s2 += (x1.x * x1.x + x1.y * x1.y) + (x1.z * x1.z + x1.w * x1.w); }
        const float r2 = rsqrtf(wave_sum(s2) * (1.0f / DM) + EPS);
        u32x2* o = (u32x2*)(F_H2 + (size_t)row * DM);
#pragma unroll
        for (int j = 0; j < 16; ++j) { const f32x4 hv = (y[j] * r2 * gpf[lane + 64 * j]) * (md[4 * (DM / 4) + lane + 64 * j] + 1.0f) + md[3 * (DM / 4) + lane + 64 * j];
            u32x2 w; w.x = pk2(hv.x, hv.y); w.y = pk2(hv.z, hv.w); o[lane + 64 * j] = w; }
    }
}
__device__ __forceinline__ void ph_final(const Frame& F) {
    const int gw = F.vcu * 8 + F.wave, NGW = F.G * 8, lane = F.lane;
    const f32x4* gpf = (const f32x4*)F.in[I_GPOSTFFN];
    for (int row = gw; row < ML; row += NGW) {
        const f32x4* md = (const f32x4*)(F_mod + (size_t)(row / TL) * NADA);
        const f32x4* yr = (const f32x4*)(F_Y2 + (size_t)row * DM); f32x4* outr = (f32x4*)(F.out + (size_t)row * DM);
        f32x4 y[16]; float ss = 0.f;
#pragma unroll
        for (int j = 0; j < 16; ++j) { y[j] = yr[lane + 64 * j]; ss += (y[j].x * y[j].x + y[j].y * y[j].y) + (y[j].z * y[j].z + y[j].w * y[j].w); }
        const float rs = rsqrtf(wave_sum(ss) * (1.0f / DM) + EPS);
#pragma unroll
        for (int j = 0; j < 16; ++j) outr[lane + 64 * j] = outr[lane + 64 * j] + md[5 * (DM / 4) + lane + 64 * j] * (y[j] * rs * gpf[lane + 64 * j]);
    }
}
#ifndef MK_N_LAUNCHES
#define MK_N_LAUNCHES 13
#endif
constexpr int N_PHASES = 13;
__global__ void __launch_bounds__(512, 2) fwd(Args args) {
    extern __shared__ __attribute__((aligned(16))) unsigned char lds[];
    Frame F;
    F.lds = (LAS unsigned char*)lds;
    F.tid = threadIdx.x; F.lane = F.tid & 63; F.wave = __builtin_amdgcn_readfirstlane(F.tid >> 6);
    F.G = gridDim.x; { const int bx = blockIdx.x; F.vcu = (F.G % 8 == 0) ? (bx % 8) * (F.G / 8) + bx / 8 : bx; }
    F.in = args.in; F.out = args.out; F.ws = args.ws;
    unsigned char* ws = args.ws;
    volatile LAS unsigned* MISC = (volatile LAS unsigned*)(F.lds + MISC_OFF);
    if (F.tid < 64) MISC[F.tid] = 0u;
    __syncthreads();
    const int lo = args.ph_lo, hi = args.ph_hi;
    XcdBarrier bar; bar.bar = (unsigned*)(ws + WS_CTL) + CW_BAR; bar.x = 0; bar.st = nullptr;
    if (hi - lo > 1) bar = xcd_barrier_post((unsigned*)(ws + WS_CTL) + CW_BAR, MISC + 8);
#ifndef PH_MASK
#define PH_MASK 0x1fff
#endif
#define IN(k) (((PH_MASK >> (k)) & 1) && lo <= (k) && (k) < hi)
#define SEAM(k) do { if (IN(k) && IN((k) + 1)) xcd_barrier(bar); } while (0)
    if (IN(0)) { ph0_prologue(F); } SEAM(0);
    if (IN(1)) { ph1_modreduce(F); } SEAM(1);
    if (IN(2)) { ph2_hrows(F); } SEAM(2);
    if (IN(3)) { pg8::Gemm g{F_H, F_Wt_in, MT, NINP, DM}; pg8::StaticOrder S; S.init(MT, NINP, F.G, (int)blockIdx.x);
        pg8::EpiProj E{F_LX, F_LG, F_QKV, F_Z, F_BA};
        pg8::gemm_phase<pg8::EpiProj, pg8::StaticOrder, true, true>(F.lds, g, S, E); } SEAM(3);
    if (IN(4)) { lru_pass<1>(F); gdn_pre(F); } SEAM(4);
    if (IN(5)) { lru_chains(F); for (int item = F.vcu; item < 256; item += F.G) gdn_seq(F, item); } SEAM(5);
    if (IN(6)) { lru_pass<2>(F); gdn_combine(F); } SEAM(6);
    if (IN(7)) { lru_normalize(F); } SEAM(7);
    if (IN(8)) { pg8::Gemm g{F_MIX, F_Wt_out, ML, DM, DM}; pg8::StaticOrder S; S.init(ML, DM, F.G, (int)blockIdx.x);
        pg8::EpiF32 E{F_Y1, DM};
        pg8::gemm_phase<pg8::EpiF32, pg8::StaticOrder, true, true>(F.lds, g, S, E); } SEAM(8);
    if (IN(9)) { ph_x1(F); } SEAM(9);
    if (IN(10)) { pg8::Gemm g{F_H2, F_Wt_gu, ML, 2 * DFF, DM}; pg8::StaticOrder S; S.init(ML, 2 * DFF, F.G, (int)blockIdx.x);
        pg8::EpiSwiGLU E{F_ACT, DFF};
        pg8::gemm_phase<pg8::EpiSwiGLU, pg8::StaticOrder, true, true>(F.lds, g, S, E); } SEAM(10);
    if (IN(11)) { pg8::Gemm g{F_ACT, F_Wt_dn, ML, DM, DFF}; pg8::StaticOrder S; S.init(ML, DM, F.G, (int)blockIdx.x);
        pg8::EpiF32 E{F_Y2, DM};
        pg8::gemm_phase<pg8::EpiF32, pg8::StaticOrder, true, true>(F.lds, g, S, E); } SEAM(11);
    if (IN(12)) { ph_final(F); }
#undef IN
#undef SEAM
}

extern "C" void kernel_launch(void* const* d_in, const int* in_sizes, int n_in, void* d_out, int out_size, void* d_ws, size_t ws_size, hipStream_t stream) {
    static int grid = 0;
    if (grid == 0) {
        if (n_in != N_INPUTS || in_sizes[0] != ML * DM || out_size != ML * DM || ws_size < WS_END) { fprintf(stderr, "kernel_launch: unexpected problem shape (n_in %d, in0 %d, out %d, ws %zu): nothing launched\n", n_in, n_in > 0 ? in_sizes[0] : -1, out_size, ws_size); grid = -1; return; }
        int dev = 0, cus = 0;
        if (hipGetDevice(&dev) != hipSuccess || hipDeviceGetAttribute(&cus, hipDeviceAttributeMultiprocessorCount, dev) != hipSuccess) { grid = -1; return; }
        if (hipFuncSetAttribute((const void*)fwd, hipFuncAttributeMaxDynamicSharedMemorySize, LDS_BYTES) != hipSuccess) { fprintf(stderr, "kernel_launch: hipFuncSetAttribute failed\n"); grid = -1; return; }
        (void)hipGetLastError();
        grid = cus >= 256 ? 256 : (cus / 16) * 16;
        if (grid < 16) { grid = -1; return; }
    }
    if (grid < 0) return;
    (void)hipMemsetAsync((char*)d_ws + WS_CTL, 0, CTL_ZERO_BYTES, stream);
    Args a{};
    for (int i = 0; i < N_INPUTS; ++i) a.in[i] = (const float*)d_in[i];
    a.out = (float*)d_out; a.ws = (unsigned char*)d_ws;
#if MK_N_LAUNCHES == 1
    a.ph_lo = 0; a.ph_hi = N_PHASES;
    hipLaunchKernelGGL(fwd, dim3(grid), dim3(512), LDS_BYTES, stream, a);
#else
    for (int p = 0; p < N_PHASES; ++p) { a.ph_lo = p; a.ph_hi = p + 1; hipLaunchKernelGGL(fwd, dim3(grid), dim3(512), LDS_BYTES, stream, a); }
#endif
}
```

```cpp
#include <hip/hip_runtime.h>
#include <cstdio>
#include <cstdint>
namespace pg8 {
#define PG8_LAS __attribute__((address_space(3)))
typedef unsigned short bf16_t;
typedef short bf16x8 __attribute__((ext_vector_type(8)));
typedef float f32x4 __attribute__((ext_vector_type(4)));
typedef unsigned u32x4 __attribute__((ext_vector_type(4)));
constexpr int BM = 256, BK = 64, HALF = 128, HTB = HALF * BK * 2  , STAGE_BYTES = 8 * HTB, NXCD = 8, WGM = 8;

__host__ __device__ __forceinline__ int lds_byte(int r, int c) { const int st = (r >> 4) * 2 + (c >> 5), rr = r & 15, cc = c & 31, ob = rr * 64 + cc * 2; return st * 1024 + (ob ^ (((ob >> 9) & 1) << 5)); }
__host__ __device__ __forceinline__ void stage_rc(int b, int& R, int& C) { const int st = b / 1024, sb = b % 1024, swz = sb ^ (((sb >> 9) & 1) << 5); R = (st >> 1) * 16 + swz / 64; C = (st & 1) * 32 + (swz % 64) / 2; }
__host__ __device__ __forceinline__ int perm32(int rho) { const int n = rho >> 4, i = rho & 15; return 8 * (i >> 2) + 4 * n + (i & 3); }

struct Unit { int pm, pn; };
struct Gemm { const bf16_t* A; const bf16_t* Bt; int M, N, K; };

struct StaticOrder {
    int nM, nN, nwg, G, c;
    __host__ __device__ void init(int M, int N, int G_, int c_) { nM = M / BM; nN = N / BM; nwg = nM * nN; G = G_; c = c_; }
    __host__ __device__ bool next(int i, Unit& u) const {
        const long L = (long)i * G + c; if (L >= nwg) return false;
        int wgid = (int)L; { const int q = nwg / NXCD, r = nwg % NXCD, xcd = wgid % NXCD, off = wgid / NXCD; wgid = (xcd < r ? xcd * (q + 1) : r * (q + 1) + (xcd - r) * q) + off; }
        const int nig = WGM * nN, gid = wgid / nig, fm = gid * WGM, gsz = (nM - fm) < WGM ? (nM - fm) : WGM;
        u.pm = fm + ((wgid % nig) % gsz); u.pn = (wgid % nig) / gsz; return true;
    }
    __device__ __forceinline__ void a_ready(const Unit&) const {}
    __device__ __forceinline__ void done(const Unit&) const {}
};
__device__ __forceinline__ unsigned cvt_pk_bf16(float lo, float hi) { unsigned r; asm volatile("v_cvt_pk_bf16_f32 %0, %1, %2" : "=v"(r) : "v"(lo), "v"(hi)); return r; }
struct EpiF32 {
    static constexpr bool PERM = false, AFTER_DRAIN = false;
    float* C; int ldc;
    __device__ __forceinline__ void operator()(const f32x4 (&acc)[2][2][4][2], const Unit& u, int wr, int wc, int fr, int fq) const {
        const int row0 = u.pm * BM + wr * 64 + fr, col0 = u.pn * BM + wc * 32 + 4 * fq;
#pragma unroll
        for (int ai = 0; ai < 2; ++ai)
#pragma unroll
            for (int m = 0; m < 4; ++m) { float* rowp = C + (size_t)(row0 + ai * HALF + m * 16) * ldc + col0;
#pragma unroll
                for (int bj = 0; bj < 2; ++bj)
#pragma unroll
                    for (int n = 0; n < 2; ++n) *(f32x4*)(rowp + bj * HALF + n * 16) = acc[ai][bj][m][n]; }
    }
};
struct EpiProj {
    static constexpr bool PERM = true, AFTER_DRAIN = false;
    bf16_t *lx, *lg, *qkv, *z, *ba;
    __device__ __forceinline__ void operator()(const f32x4 (&acc)[2][2][4][2], const Unit& u, int wr, int wc, int fr, int fq) const {
        const int pn = u.pn; bf16_t* base; int ld, colt;
        if (pn < 8) { base = lx; ld = 2048; colt = pn * BM; }
        else if (pn < 16) { base = lg; ld = 2048; colt = (pn - 8) * BM; }
        else if (pn < 40) { base = qkv; ld = 6144; colt = (pn - 16) * BM; }
        else if (pn < 48) { base = z; ld = 2048; colt = (pn - 40) * BM; }
        else { base = ba; ld = 256; colt = 0; }
        const int row0 = u.pm * BM + wr * 64 + fr, col0 = colt + wc * 32 + 8 * fq;
#pragma unroll
        for (int ai = 0; ai < 2; ++ai)
#pragma unroll
            for (int m = 0; m < 4; ++m) { bf16_t* rowp = base + (size_t)(row0 + ai * HALF + m * 16) * ld + col0;
#pragma unroll
                for (int bj = 0; bj < 2; ++bj) { const f32x4 v0 = acc[ai][bj][m][0], v1 = acc[ai][bj][m][1];
                    u32x4 w; w.x = cvt_pk_bf16(v0[0], v0[1]); w.y = cvt_pk_bf16(v0[2], v0[3]); w.z = cvt_pk_bf16(v1[0], v1[1]); w.w = cvt_pk_bf16(v1[2], v1[3]);
                    *(u32x4*)(rowp + bj * HALF) = w; } }
    }
};
struct EpiSwiGLU {
    static constexpr bool PERM = true, AFTER_DRAIN = false;
    bf16_t* O; int ldc;
    __device__ __forceinline__ void operator()(const f32x4 (&acc)[2][2][4][2], const Unit& u, int wr, int wc, int fr, int fq) const {
        const int row0 = u.pm * BM + wr * 64 + fr, col0 = u.pn * HALF + wc * 32 + 8 * fq;
#pragma unroll
        for (int ai = 0; ai < 2; ++ai)
#pragma unroll
            for (int m = 0; m < 4; ++m) { bf16_t* rowp = O + (size_t)(row0 + ai * HALF + m * 16) * ldc + col0;
                float r[8];
#pragma unroll
                for (int n = 0; n < 2; ++n)
#pragma unroll
                    for (int j = 0; j < 4; ++j) { const float g = acc[ai][0][m][n][j], up = acc[ai][1][m][n][j]; r[4 * n + j] = g * __builtin_amdgcn_rcpf(1.0f + __expf(-g)) * up; }
                u32x4 w; w.x = cvt_pk_bf16(r[0], r[1]); w.y = cvt_pk_bf16(r[2], r[3]); w.z = cvt_pk_bf16(r[4], r[5]); w.w = cvt_pk_bf16(r[6], r[7]);
                *(u32x4*)rowp = w; }
    }
};

template <class Epi, class Sched, bool ALIGN_EPI = false, bool SP2 = false>
__device__ __forceinline__ void gemm_phase(PG8_LAS unsigned char* lds, const Gemm g, const Sched& S, const Epi& E) {
    const int tid = threadIdx.x, wid = __builtin_amdgcn_readfirstlane(tid >> 6), lane = tid & 63, wr = wid >> 2, wc = wid & 3, fr = lane & 15, fq = lane >> 4;
    const int K = g.K, nt = K / BK;
    unsigned voffA[2], voffB[2];
#pragma unroll
    for (int i = 0; i < 2; ++i) { int R, C; stage_rc(tid * 16 + i * 8192, R, C); const int Rb = Epi::PERM ? ((R & ~31) + perm32(R & 31)) : R;
        voffA[i] = (unsigned)(R * K + C) * 2u; voffB[i] = (unsigned)(Rb * K + C) * 2u; }
    const size_t kstep = (size_t)(BK * 2);
    const size_t hstep = (size_t)HALF * K * 2;
    const size_t tstep = 2 * hstep;
    const unsigned ldsw = (unsigned)wid * 1024u;
    const int aoff = lds_byte(wr * 64 + fr, fq * 8), boff = lds_byte(wc * 32 + fr, fq * 8);
#define PG8_SA(b, h) (((b) * 2 + (h)) * HTB)
#define PG8_SB(b, h) ((4 + (b) * 2 + (h)) * HTB)
#define PG8_STAGE(bufoff, gbase, voff) do { _Pragma("unroll") for (int _i = 0; _i < 2; ++_i) \
        __builtin_amdgcn_global_load_lds((const unsigned*)((const char*)(gbase) + (voff)[_i]), (PG8_LAS unsigned*)(lds + (bufoff) + ldsw + _i * 8192), 16, 0, 0); } while (0)
#define PG8_LDA(dst, b, h) do { _Pragma("unroll") for (int m = 0; m < 4; ++m) _Pragma("unroll") for (int k = 0; k < 2; ++k) dst[m][k] = *(const PG8_LAS bf16x8*)(lds + PG8_SA(b, h) + aoff + m * 2048 + k * 1024); } while (0)
#define PG8_LDB(dst, b, h) do { _Pragma("unroll") for (int n = 0; n < 2; ++n) _Pragma("unroll") for (int k = 0; k < 2; ++k) dst[n][k] = *(const PG8_LAS bf16x8*)(lds + PG8_SB(b, h) + boff + n * 2048 + k * 1024); } while (0)
#define PG8_MMA(ai, bj, At, Bt) do { __builtin_amdgcn_s_setprio(1); _Pragma("unroll") for (int m = 0; m < 4; ++m) _Pragma("unroll") for (int n = 0; n < 2; ++n) _Pragma("unroll") for (int k = 0; k < 2; ++k) \
        acc[ai][bj][m][n] = __builtin_amdgcn_mfma_f32_16x16x32_bf16(Bt[n][k], At[m][k], acc[ai][bj][m][n], 0, 0, 0); __builtin_amdgcn_s_setprio(0); } while (0)
#define PG8_WAIT_V(n) asm volatile("s_waitcnt vmcnt(" #n ")" ::: "memory")
#define PG8_WAIT_L(n) asm volatile("s_waitcnt lgkmcnt(" #n ")" ::: "memory")
#define PG8_BAR __builtin_amdgcn_s_barrier()
#define PG8_SCHED __builtin_amdgcn_sched_barrier(0)
    Unit cur, nxt; int ui = 0;
    if (!S.next(0, cur)) return;
    f32x4 acc[2][2][4][2];
#pragma unroll
    for (int a = 0; a < 2; ++a)
#pragma unroll
        for (int b = 0; b < 2; ++b)
#pragma unroll
            for (int m = 0; m < 4; ++m)
#pragma unroll
                for (int n = 0; n < 2; ++n) acc[a][b][m][n] = (f32x4){0.f, 0.f, 0.f, 0.f};
    bf16x8 At[4][2], B0[2][2], B1[2][2];
    const char* cA = (const char*)g.A + (size_t)cur.pm * tstep; const char* cB = (const char*)g.Bt + (size_t)cur.pn * tstep;
    S.a_ready(cur);
    if constexpr (SP2) {
        PG8_STAGE(PG8_SB(0, 0), cB, voffB); PG8_STAGE(PG8_SB(0, 1), cB + hstep, voffB); PG8_STAGE(PG8_SA(0, 0), cA, voffA); PG8_STAGE(PG8_SA(0, 1), cA + hstep, voffA);
        if (wr == 1) PG8_BAR;
        PG8_WAIT_V(2); PG8_BAR;
        PG8_STAGE(PG8_SB(1, 0), cB + kstep, voffB); PG8_STAGE(PG8_SA(1, 0), cA + kstep, voffA); PG8_STAGE(PG8_SB(1, 1), cB + hstep + kstep, voffB);
        PG8_WAIT_V(6); PG8_BAR;
    } else {
        PG8_STAGE(PG8_SB(0, 0), cB, voffB); PG8_STAGE(PG8_SA(0, 0), cA, voffA); PG8_STAGE(PG8_SB(0, 1), cB + hstep, voffB); PG8_STAGE(PG8_SA(0, 1), cA + hstep, voffA);
        if (wr == 1) PG8_BAR;
        PG8_WAIT_V(4); PG8_BAR;
        PG8_STAGE(PG8_SB(1, 0), cB + kstep, voffB); PG8_STAGE(PG8_SA(1, 0), cA + kstep, voffA); PG8_STAGE(PG8_SB(1, 1), cB + hstep + kstep, voffB);
        PG8_WAIT_V(6); PG8_BAR;
    }
    for (;;) {
        const bool has_next = S.next(ui + 1, nxt);
        const char* nA = has_next ? (const char*)g.A + (size_t)nxt.pm * tstep : cA; const char* nB = has_next ? (const char*)g.Bt + (size_t)nxt.pn * tstep : cB;
        for (int t = 0; t < nt; t += 2) {
            const bool last = (t == nt - 2);
            const char* a1 = cA + (size_t)(t + 1) * kstep;
            const char* a2 = last ? nA : cA + (size_t)(t + 2) * kstep; const char* b2 = last ? nB : cB + (size_t)(t + 2) * kstep;
            const char* a3 = a2 + kstep; const char* b3 = b2 + kstep;
            if (last && has_next) S.a_ready(nxt);
            if constexpr (SP2) {
            PG8_LDB(B0, 0, 0); PG8_LDB(B1, 0, 1); PG8_SCHED; PG8_LDA(At, 0, 0); PG8_STAGE(PG8_SA(1, 1), a1 + hstep, voffA);
            PG8_WAIT_V(8); PG8_WAIT_L(0); PG8_BAR; PG8_MMA(0, 0, At, B0); PG8_MMA(0, 1, At, B1); PG8_BAR; PG8_SCHED;
            PG8_LDA(At, 0, 1); PG8_STAGE(PG8_SB(0, 0), b2, voffB); PG8_STAGE(PG8_SB(0, 1), b2 + hstep, voffB); PG8_STAGE(PG8_SA(0, 0), a2, voffA);
            PG8_WAIT_V(8); PG8_WAIT_L(0); PG8_BAR; PG8_MMA(1, 0, At, B0); PG8_MMA(1, 1, At, B1); PG8_BAR; PG8_SCHED;
            PG8_LDB(B0, 1, 0); PG8_LDB(B1, 1, 1); PG8_SCHED; PG8_LDA(At, 1, 0); PG8_STAGE(PG8_SA(0, 1), a2 + hstep, voffA);
            PG8_WAIT_V(8); PG8_WAIT_L(0); PG8_BAR; PG8_MMA(0, 0, At, B0); PG8_MMA(0, 1, At, B1); PG8_BAR; PG8_SCHED;
            PG8_LDA(At, 1, 1); PG8_STAGE(PG8_SB(1, 0), b3, voffB); PG8_STAGE(PG8_SB(1, 1), b3 + hstep, voffB); PG8_STAGE(PG8_SA(1, 0), a3, voffA);
            PG8_WAIT_V(8); PG8_WAIT_L(0); PG8_BAR; PG8_MMA(1, 0, At, B0); PG8_MMA(1, 1, At, B1); PG8_BAR; PG8_SCHED;
            } else {
            PG8_LDB(B0, 0, 0); PG8_SCHED; PG8_LDA(At, 0, 0); PG8_STAGE(PG8_SA(1, 1), a1 + hstep, voffA);
            PG8_WAIT_L(8); PG8_BAR; PG8_WAIT_L(0); PG8_MMA(0, 0, At, B0); PG8_BAR; PG8_SCHED;
            PG8_LDB(B1, 0, 1); PG8_STAGE(PG8_SB(0, 0), b2, voffB);
            PG8_BAR; PG8_WAIT_L(0); PG8_MMA(0, 1, At, B1); PG8_BAR;
            PG8_LDA(At, 0, 1); PG8_STAGE(PG8_SA(0, 0), a2, voffA);
            PG8_BAR; PG8_WAIT_L(0); PG8_MMA(1, 0, At, B0); PG8_BAR; PG8_SCHED;
            PG8_STAGE(PG8_SB(0, 1), b2 + hstep, voffB);
            PG8_WAIT_V(6); PG8_BAR; PG8_MMA(1, 1, At, B1); PG8_BAR;
            PG8_LDB(B0, 1, 0); PG8_SCHED; PG8_LDA(At, 1, 0); PG8_STAGE(PG8_SA(0, 1), a2 + hstep, voffA);
            PG8_WAIT_L(8); PG8_BAR; PG8_WAIT_L(0); PG8_MMA(0, 0, At, B0); PG8_BAR; PG8_SCHED;
            PG8_LDB(B1, 1, 1); PG8_STAGE(PG8_SB(1, 0), b3, voffB);
            PG8_BAR; PG8_WAIT_L(0); PG8_MMA(0, 1, At, B1); PG8_BAR;
            PG8_LDA(At, 1, 1); PG8_STAGE(PG8_SA(1, 0), a3, voffA);
            PG8_BAR; PG8_WAIT_L(0); PG8_MMA(1, 0, At, B0); PG8_BAR; PG8_SCHED;
            PG8_STAGE(PG8_SB(1, 1), b3 + hstep, voffB);
            PG8_WAIT_V(6); PG8_BAR; PG8_MMA(1, 1, At, B1); PG8_BAR;
            }
        }
        if constexpr (ALIGN_EPI) { if (wr == 0) PG8_BAR; }
        if constexpr (!Epi::AFTER_DRAIN) { E(acc, cur, wr, wc, fr, fq); S.done(cur); }
        if (!has_next) break;
#pragma unroll
        for (int a = 0; a < 2; ++a)
#pragma unroll
            for (int b = 0; b < 2; ++b)
#pragma unroll
                for (int m = 0; m < 4; ++m)
#pragma unroll
                    for (int n = 0; n < 2; ++n) acc[a][b][m][n] = (f32x4){0.f, 0.f, 0.f, 0.f};
        cur = nxt; cA = nA; cB = nB; ++ui;
        if constexpr (ALIGN_EPI) { if (wr == 1) PG8_BAR; }
    }
    PG8_WAIT_V(0);
    if constexpr (!ALIGN_EPI) { if (wr == 0) PG8_BAR; }
    PG8_BAR;
    if constexpr (Epi::AFTER_DRAIN) { E.fused(acc, cur, wr, wc, fr, fq, lds, wid, lane); S.done(cur); }
#undef PG8_SA
#undef PG8_SB
#undef PG8_STAGE
#undef PG8_LDA
#undef PG8_LDB
#undef PG8_MMA
#undef PG8_WAIT_V
#undef PG8_WAIT_L
#undef PG8_BAR
#undef PG8_SCHED
}
}
constexpr int DM = 4096, NBATCH = 2, TL = 8192, TCX = 256, ML = NBATCH * TL, MC = NBATCH * TCX, MT = ML + MC;
constexpr int LW = 2048, GDW = 2048, NH = 16, HD = 128, DFF = 11008, NIN = 12352, NINP = 12544, NADA = 6 * DM;
constexpr int SEQ_S = TCX + TL;
constexpr int NCH = 132;
constexpr float EPS = 1e-6f;
enum { I_X = 0, I_C, I_CTX, I_CCTX, I_WADA, I_BADA, I_GPREMIX, I_GPOSTMIX, I_GPREFFN, I_GPOSTFFN, I_WIN, I_LCW, I_LCB, I_LWA, I_LBA, I_LWX, I_LBX, I_LLAM, I_LNG, I_GCW, I_GALOG, I_GDT, I_GNG, I_WOUT, I_WG, I_WU, I_WD, N_INPUTS };

constexpr size_t MiB = 1u << 20;
constexpr size_t WS_CTL = 0, CTL_ZERO_BYTES = 1 * MiB;
constexpr size_t WS_MODP = 1 * MiB, WS_MOD = 11 * MiB, WS_WL = 12 * MiB, WS_CAR = 14 * MiB, WS_HIN = 23 * MiB, WS_GB = 28 * MiB, WS_KQ = 33 * MiB, WS_SSQ = 35 * MiB;
constexpr size_t WS_WOUT = 44 * MiB, WS_WGU = 76 * MiB, WS_WDN = 248 * MiB;
constexpr size_t WS_R2 = 334 * MiB;
constexpr size_t WS_WIN = WS_R2, WS_H = WS_R2 + 98 * MiB;
constexpr size_t WS_QN = WS_R2, WS_KN = WS_R2 + 66 * MiB, WS_VN = WS_R2 + 132 * MiB;
constexpr size_t WS_H2 = WS_R2, WS_Y2 = WS_R2;
constexpr size_t WS_R3 = 590 * MiB;
constexpr size_t WS_LX = WS_R3, WS_LG = WS_R3 + 66 * MiB, WS_QKV = WS_R3 + 132 * MiB, WS_Z = WS_R3 + 330 * MiB, WS_BA = WS_R3 + 396 * MiB;
constexpr size_t WS_Y1 = WS_R3, WS_ACT = WS_R3;
constexpr size_t WS_MIX = 995 * MiB, WS_END = 1123 * MiB;
static_assert(WS_SSQ + (size_t)ML * 128 * 4 <= WS_WOUT && WS_WOUT + (size_t)DM * DM * 2 <= WS_WGU && WS_WGU + (size_t)2 * DFF * DM * 2 <= WS_WDN && WS_WDN + (size_t)DM * DFF * 2 <= WS_R2, "ws map 1");
static_assert(WS_WIN + (size_t)NINP * DM * 2 <= WS_H && WS_H + (size_t)MT * DM * 2 <= WS_R3 && WS_VN + (size_t)NBATCH * SEQ_S * 2048 * 2 <= WS_R3 && WS_Y2 + (size_t)ML * DM * 4 <= WS_R3, "ws map 2");
static_assert((size_t)MT * 2048 * 2 <= 66 * MiB && (size_t)MT * 6144 * 2 <= 198 * MiB && WS_BA + (size_t)MT * 256 * 2 <= WS_MIX && WS_ACT + (size_t)ML * DFF * 2 <= WS_MIX && WS_MIX + (size_t)ML * DM * 2 <= WS_END, "ws map 3");
constexpr int CW_BAR = 4096;

constexpr int LDS_BYTES = 147456;
constexpr int MISC_OFF = LDS_BYTES - 256;

#define GAS __attribute__((address_space(1)))
#define LAS __attribute__((address_space(3)))
typedef unsigned short bf16;
typedef unsigned u32x4 __attribute__((ext_vector_type(4)));
typedef unsigned u32x2 __attribute__((ext_vector_type(2)));
typedef float f32x4 __attribute__((ext_vector_type(4)));
typedef float f32x2 __attribute__((ext_vector_type(2)));
typedef short bf16x8 __attribute__((ext_vector_type(8)));
#define LDS_WAIT() asm volatile("s_waitcnt lgkmcnt(0)" ::: "memory")
#define WAVE_LDS_FENCE() do { asm volatile("s_waitcnt lgkmcnt(0)" ::: "memory"); __builtin_amdgcn_wave_barrier(); } while (0)
__device__ __forceinline__ unsigned f2bf(float f) { unsigned u = __builtin_bit_cast(unsigned, f); return (u + 0x7fffu + ((u >> 16) & 1u)) >> 16; }
__device__ __forceinline__ unsigned pk2(float lo, float hi) { return f2bf(lo) | (f2bf(hi) << 16); }
__device__ __forceinline__ float bf2f(unsigned h) { return __builtin_bit_cast(float, h << 16); }
__device__ __forceinline__ float bflo(unsigned w) { return __builtin_bit_cast(float, w << 16); }
__device__ __forceinline__ float bfhi(unsigned w) { return __builtin_bit_cast(float, w & 0xffff0000u); }
__device__ __forceinline__ float wave_sum(float v) {
#pragma unroll
    for (int o = 1; o < 64; o <<= 1) v += __shfl_xor(v, o);
    return v;
}
__device__ __forceinline__ float sigmoidf_(float x) { return __builtin_amdgcn_rcpf(1.0f + __expf(-x)); }
__device__ __forceinline__ float siluf_(float x) { return x * sigmoidf_(x); }
__device__ __forceinline__ float softplusf_(float x) { return x > 20.f ? x : log1pf(__expf(x)); }
__device__ __forceinline__ float gelu_tanhf_(float x) { const float u = 0.7978845608028654f * (x + 0.044715f * x * x * x); const float t = 1.0f - 2.0f * __builtin_amdgcn_rcpf(__expf(2.0f * u) + 1.0f); return 0.5f * x * (1.0f + t); }
__device__ __forceinline__ float rdlane(float x, int l) { return __builtin_bit_cast(float, __builtin_amdgcn_readlane(__builtin_bit_cast(int, x), l)); }

#define XB_TMO      128
#define XB_XCNT(j)  (256  + 64 * (j))
#define XB_XSUB(j)  (1280 + 64 * (j))
#define XB_XGEN(j)  (2304 + 64 * (j))
#define XB_TOP      3328
#define XB_TOPGEN   3392
#define XCD_BAR_WORDS 3456
#define XB_SPIN_CAP (1u << 22)
__device__ __forceinline__ unsigned xb_ld(unsigned* p)              { return __hip_atomic_load(p, __ATOMIC_RELAXED, __HIP_MEMORY_SCOPE_AGENT); }
__device__ __forceinline__ unsigned xb_add(unsigned* p, unsigned v) { return __hip_atomic_fetch_add(p, v, __ATOMIC_RELAXED, __HIP_MEMORY_SCOPE_AGENT); }
__device__ __forceinline__ unsigned xb_xcc_id() { return (unsigned)__builtin_amdgcn_s_getreg((3 << 11) | 20) & 0xFu; }
#define XB_SPIN(cond, bar) do { unsigned _sp = 0; while (cond) { __builtin_amdgcn_s_sleep(1); \
    if ((++_sp & 255u) == 0u) { if (xb_ld(&(bar)[XB_TMO])) break; if (_sp > XB_SPIN_CAP) { atomicAdd(&(bar)[XB_TMO], 1u); break; } } } } while (0)
struct XcdBarrier { unsigned* bar; unsigned x; volatile LAS unsigned* st; };
__device__ __forceinline__ XcdBarrier xcd_barrier_post(unsigned* bar, volatile LAS unsigned* st) {
    XcdBarrier b; b.bar = bar; b.x = xb_xcc_id(); b.st = st;
    if (threadIdx.x == 0) (void)xb_add(&bar[XB_XCNT(b.x)], 1u);
    return b;
}
__device__ __forceinline__ void xcd_barrier_complete(unsigned* bar, unsigned x, unsigned& nloc, unsigned& nx) {
    const unsigned G = gridDim.x * gridDim.y * gridDim.z;
    unsigned sum, cnt, mine, sp = 0u;
    for (;;) {
        sum = 0u; cnt = 0u; mine = 0u;
#pragma unroll
        for (unsigned j = 0; j < 16; ++j) { const unsigned c = xb_ld(&bar[XB_XCNT(j)]); sum += c; cnt += (c > 0u) ? 1u : 0u; mine = (j == x) ? c : mine; }
        if (sum == G) break;
        __builtin_amdgcn_s_sleep(1);
        if ((++sp & 255u) == 0u) { if (xb_ld(&bar[XB_TMO])) break; if (sp > XB_SPIN_CAP) { atomicAdd(&bar[XB_TMO], 1u); break; } }
    }
    nloc = mine > 0u ? mine : 1u; nx = cnt > 0u ? cnt : 1u;
}
__device__ __forceinline__ void xcd_barrier(const XcdBarrier& b) {
    asm volatile("s_waitcnt vmcnt(0)" ::: "memory");
    __syncthreads();
    if (threadIdx.x == 0) {
        unsigned* bar = b.bar;
        __builtin_amdgcn_s_waitcnt(0);
        unsigned nloc = b.st[0], nx = b.st[1];
        if (nloc == 0u) { xcd_barrier_complete(bar, b.x, nloc, nx); b.st[0] = nloc; b.st[1] = nx; }
        const unsigned old = xb_add(&bar[XB_XSUB(b.x)], 1u);
        const unsigned gen = old / nloc;
        if (old + 1u == (gen + 1u) * nloc) {
            __builtin_amdgcn_fence(__ATOMIC_RELEASE, "agent");
            asm volatile("s_waitcnt vmcnt(0)" ::: "memory");
            const unsigned og = xb_add(&bar[XB_TOP], 1u);
            const unsigned tg = og / nx;
            if (og + 1u == (tg + 1u) * nx) xb_add(&bar[XB_TOPGEN], 1u);
            else XB_SPIN(xb_ld(&bar[XB_TOPGEN]) == tg, bar);
            __builtin_amdgcn_fence(__ATOMIC_ACQUIRE, "agent");
            xb_add(&bar[XB_XGEN(b.x)], 1u);
            asm volatile("s_waitcnt vmcnt(0)" ::: "memory");
        } else {
            XB_SPIN(xb_ld(&bar[XB_XGEN(b.x)]) == gen, bar);
            __builtin_amdgcn_fence(__ATOMIC_ACQUIRE, "agent");
            asm volatile("s_waitcnt vmcnt(0)" ::: "memory");
        }
    }
    __syncthreads();
}

struct Args { const float* in[N_INPUTS]; float* out; unsigned char* ws; int ph_lo, ph_hi; };
struct Frame {
    LAS unsigned char* lds;
    int tid, lane, wave, vcu, G;
    const float* const* in;
    float* out; unsigned char* ws;
};
#define F_modp ((float*)(F.ws + WS_MODP))
#define F_mod ((float*)(F.ws + WS_MOD))
#define F_WL ((bf16*)(F.ws + WS_WL))
#define F_CAR ((f32x2*)(F.ws + WS_CAR))
#define F_HIN ((float*)(F.ws + WS_HIN))
#define F_GB ((f32x2*)(F.ws + WS_GB))
#define F_KQ ((float*)(F.ws + WS_KQ))
#define F_SSQ ((float*)(F.ws + WS_SSQ))
#define F_Wt_out ((bf16*)(F.ws + WS_WOUT))
#define F_Wt_gu ((bf16*)(F.ws + WS_WGU))
#define F_Wt_dn ((bf16*)(F.ws + WS_WDN))
#define F_Wt_in ((bf16*)(F.ws + WS_WIN))
#define F_H ((bf16*)(F.ws + WS_H))
#define F_QN ((bf16*)(F.ws + WS_QN))
#define F_KN ((bf16*)(F.ws + WS_KN))
#define F_VN ((bf16*)(F.ws + WS_VN))
#define F_H2 ((bf16*)(F.ws + WS_H2))
#define F_LX ((bf16*)(F.ws + WS_LX))
#define F_LG ((bf16*)(F.ws + WS_LG))
#define F_QKV ((bf16*)(F.ws + WS_QKV))
#define F_Z ((bf16*)(F.ws + WS_Z))
#define F_BA ((bf16*)(F.ws + WS_BA))
#define F_ACT ((bf16*)(F.ws + WS_ACT))
#define F_MIX ((bf16*)(F.ws + WS_MIX))
#define F_Y1 ((float*)(F.ws + WS_Y1))
#define F_Y2 ((float*)(F.ws + WS_Y2))
#define F_O (F.out)
__device__ __forceinline__ void transpose_item(const float* W, int N, bf16* WT, int Kp, int k0, int n0, int drow0, LAS float* scr, int lane) {
#pragma unroll 8
    for (int i = 0; i < 32; ++i) { const int kk = 2 * i + (lane >> 5); scr[kk * 33 + (lane & 31)] = W[(size_t)(k0 + kk) * N + n0 + (lane & 31)]; }
    LDS_WAIT(); asm volatile("" ::: "memory");
    const int c = lane & 7;
#pragma unroll
    for (int j = 0; j < 4; ++j) { const int n = (lane >> 3) + 8 * j; const LAS float* s = scr + (8 * c) * 33 + n;
        u32x4 o; o.x = pk2(s[0 * 33], s[1 * 33]); o.y = pk2(s[2 * 33], s[3 * 33]); o.z = pk2(s[4 * 33], s[5 * 33]); o.w = pk2(s[6 * 33], s[7 * 33]);
        *(u32x4*)(WT + (size_t)(drow0 + n) * Kp + k0 + 8 * c) = o; }
    LDS_WAIT(); asm volatile("" ::: "memory");
}

__device__ __forceinline__ void ph0_prologue(const Frame& F) {
    const int gw = F.vcu * 8 + F.wave, NGW = F.G * 8, lane = F.lane;
    {
        const float* W = F.in[I_WADA]; const float* c = F.in[I_C]; const float* cc = F.in[I_CCTX];
        for (int it = gw; it < 96 * 32; it += NGW) {
            const int cg = it % 96, kc = it / 96;
            float sv[3][2];
#pragma unroll
            for (int h = 0; h < 2; ++h) { const int k = kc * 128 + h * 64 + lane; sv[0][h] = siluf_(c[k]); sv[1][h] = siluf_(c[DM + k]); sv[2][h] = siluf_(cc[k]); }
            f32x4 a0 = {0.f, 0.f, 0.f, 0.f}, a1 = a0, a2 = a0;
            const f32x4* wp = (const f32x4*)(W + (size_t)kc * 128 * NADA + cg * 256) + lane;
#pragma unroll
            for (int h = 0; h < 2; ++h) {
#pragma unroll 8
                for (int kk = 0; kk < 64; ++kk) { const f32x4 w = wp[(size_t)(h * 64 + kk) * (NADA / 4)];
                    const float s0 = rdlane(sv[0][h], kk), s1 = rdlane(sv[1][h], kk), s2 = rdlane(sv[2][h], kk);
                    a0 += w * s0; a1 += w * s1; a2 += w * s2; } }
            float* mp = F_modp + (size_t)(kc * 3) * NADA + cg * 256;
            ((f32x4*)mp)[lane] = a0; ((f32x4*)(mp + NADA))[lane] = a1; ((f32x4*)(mp + 2 * NADA))[lane] = a2;
        }
    }
    {
        LAS float* scr = (LAS float*)(F.lds + F.wave * 16384);
        constexpr int IT_IN = 64 * (NIN / 32), IT_OUT = 64 * (DM / 32), IT_G = 64 * (DFF / 32), IT_D = (DFF / 64) * (DM / 32), IT_L = 64 * 8;
        constexpr int NITEMS = IT_IN + IT_OUT + 2 * IT_G + IT_D + IT_L;
        for (int it = gw; it < NITEMS; it += NGW) {
            int r = it;
            if (r < IT_IN) { const int kb = r / (NIN / 32), nb = r % (NIN / 32); transpose_item(F.in[I_WIN], NIN, F_Wt_in, DM, 64 * kb, 32 * nb, 32 * nb, scr, lane); continue; } r -= IT_IN;
            if (r < IT_OUT) { const int kb = r / (DM / 32), nb = r % (DM / 32); transpose_item(F.in[I_WOUT], DM, F_Wt_out, DM, 64 * kb, 32 * nb, 32 * nb, scr, lane); continue; } r -= IT_OUT;
            if (r < 2 * IT_G) { const int up = r >= IT_G; if (up) r -= IT_G; const int kb = r / (DFF / 32), nb = r % (DFF / 32), n0 = 32 * nb;
                transpose_item(F.in[up ? I_WU : I_WG], DFF, F_Wt_gu, DM, 64 * kb, n0, 256 * (n0 >> 7) + (n0 & 127) + (up ? 128 : 0), scr, lane); continue; } r -= 2 * IT_G;
            if (r < IT_D) { const int kb = r / (DM / 32), nb = r % (DM / 32); transpose_item(F.in[I_WD], DM, F_Wt_dn, DFF, 64 * kb, 32 * nb, 32 * nb, scr, lane); continue; } r -= IT_D;
            { const int mi = r >> 3, sub = r & 7, kb = sub >> 2, nb = sub & 3, d = mi >> 5, kind = (mi >> 4) & 1, n = mi & 15;
              transpose_item(F.in[kind ? I_LWX : I_LWA] + (size_t)(d * 16 + n) * 16384, 128, F_WL + (size_t)((d * 2 + kind) * 16 + n) * 16384, 128, 64 * kb, 32 * nb, 32 * nb, scr, lane); }
        }
    }
    {
        u32x4* p = (u32x4*)(F_Wt_in + (size_t)NIN * DM); const u32x4 z = {0u, 0u, 0u, 0u};
        for (int i = F.vcu * 512 + F.tid; i < (NINP - NIN) * DM / 8; i += F.G * 512) p[i] = z;
    }
}
__device__ __forceinline__ void ph1_modreduce(const Frame& F) {
    const float* ba = F.in[I_BADA];
    for (int i = F.vcu * 512 + F.tid; i < 3 * NADA; i += F.G * 512) { const int r = i / NADA, col = i - r * NADA; float s = ba[col];
#pragma unroll 8
        for (int kc = 0; kc < 32; ++kc) s += F_modp[(size_t)(kc * 3 + r) * NADA + col];
        F_mod[i] = s; }
}
__device__ __forceinline__ void ph2_hrows(const Frame& F) {
    const int gw = F.vcu * 8 + F.wave, NGW = F.G * 8, lane = F.lane;
    const f32x4* g4 = (const f32x4*)F.in[I_GPREMIX];
    for (int row = gw; row < MT; row += NGW) {
        const float* xr = row < ML ? F.in[I_X] + (size_t)row * DM : F.in[I_CTX] + (size_t)(row - ML) * DM;
        const int mr = row < ML ? row / TL : 2;
        const f32x4* sh4 = (const f32x4*)(F_mod + (size_t)mr * NADA); const f32x4* sc4 = sh4 + DM / 4;
        f32x4 v[16]; float ss = 0.f;
#pragma unroll
        for (int j = 0; j < 16; ++j) { v[j] = ((const f32x4*)xr)[lane + 64 * j]; ss += (v[j].x * v[j].x + v[j].y * v[j].y) + (v[j].z * v[j].z + v[j].w * v[j].w); }
        const float rs = rsqrtf(wave_sum(ss) * (1.0f / DM) + EPS);
        u32x2* o = (u32x2*)(F_H + (size_t)row * DM);
#pragma unroll
        for (int j = 0; j < 16; ++j) { const f32x4 g = g4[lane + 64 * j], sh = sh4[lane + 64 * j], sc = sc4[lane + 64 * j];
            const f32x4 y = (v[j] * rs * g) * (sc + 1.0f) + sh; u32x2 w; w.x = pk2(y.x, y.y); w.y = pk2(y.z, y.w); o[lane + 64 * j] = w; }
    }
}

template <int PASS>
__device__ __forceinline__ void lru_pass(const Frame& F) {
    LAS bf16* U = (LAS bf16*)(F.lds);
    LAS float* XC = (LAS float*)(F.lds + 17408);
    LAS bf16* XCB = (LAS bf16*)(F.lds + 17408 + 32768);
    LAS f32x2* SC = (LAS f32x2*)(F.lds + 17408 + 32768 + 17408 + F.wave * 8192);
    const int tid = F.tid, lane = F.lane, w = F.wave, fr = lane & 15, fq = lane >> 4;
    const int n = F.vcu & 15;
    const int cl = 16 * w + fr, cg = n * 128 + cl;
    float ba[2], bx[2], sp[2];
#pragma unroll
    for (int d = 0; d < 2; ++d) { ba[d] = F.in[I_LBA][d * LW + cg]; bx[d] = F.in[I_LBX][d * LW + cg]; sp[d] = softplusf_(-F.in[I_LLAM][d * LW + cg]); }
    const int cc = tid & 127, tg = tid >> 7;
    float cw[4];
#pragma unroll
    for (int j = 0; j < 4; ++j) cw[j] = F.in[I_LCW][j * LW + n * 128 + cc];
    const float cb = F.in[I_LCB][n * 128 + cc];
    for (int q = F.vcu >> 4; q < NBATCH * NCH; q += F.G >> 4) {
        const int b = q / NCH, cidx = q - b * NCH;
        if (PASS == 2 && cidx < 4) continue;
        const bool isctx = cidx < 4; const int t0 = isctx ? cidx * 64 : (cidx - 4) * 64, Tseq = isctx ? TCX : TL;
        const size_t rowbase = isctx ? (size_t)ML + (size_t)b * TCX : (size_t)b * TL;
        __syncthreads();
        for (int rr = tid >> 4; rr < 67; rr += 32) { const int t = t0 - 2 + rr; u32x4 v = {0u, 0u, 0u, 0u};
            if (t >= 0 && t < Tseq) v = *(const u32x4*)(F_LX + (rowbase + t) * LW + n * 128 + (tid & 15) * 8);
            *(LAS u32x4*)(U + rr * 128 + (tid & 15) * 8) = v; }
        u32x4 gt0 = {0u, 0u, 0u, 0u}, gt1 = gt0;
        if (PASS == 2) { gt0 = *(const u32x4*)(F_LG + (rowbase + t0 + (tid >> 4)) * LW + n * 128 + (tid & 15) * 8); gt1 = *(const u32x4*)(F_LG + (rowbase + t0 + 32 + (tid >> 4)) * LW + n * 128 + (tid & 15) * 8); }
        __syncthreads();
        { float x0 = bf2f(U[(tg * 16 + 0) * 128 + cc]), x1 = bf2f(U[(tg * 16 + 1) * 128 + cc]), x2 = bf2f(U[(tg * 16 + 2) * 128 + cc]);
#pragma unroll
          for (int i = 0; i < 16; ++i) { const int tt = tg * 16 + i; const float x3 = bf2f(U[(tt + 3) * 128 + cc]);
              const float y = cb + cw[0] * x0 + cw[1] * x1 + cw[2] * x2 + cw[3] * x3; XC[tt * 128 + cc] = y; XCB[tt * 136 + cc] = (bf16)f2bf(y); x0 = x1; x1 = x2; x2 = x3; } }
        __syncthreads();
        if (PASS == 2) { *(LAS u32x4*)(U + (tid >> 4) * 128 + (tid & 15) * 8) = gt0; *(LAS u32x4*)(U + (32 + (tid >> 4)) * 128 + (tid & 15) * 8) = gt1; }
        float hsum[4][4];
#pragma unroll
        for (int d = 0; d < 2; ++d) {
            bf16x8 bfr[2][4];
#pragma unroll
            for (int mat = 0; mat < 2; ++mat)
#pragma unroll
                for (int ks = 0; ks < 4; ++ks) bfr[mat][ks] = *(const bf16x8*)(F_WL + ((size_t)((2 * d + mat) * 16 + n) * 128 + cl) * 128 + 32 * ks + 8 * fq);
            f32x4 acc[2][4];
#pragma unroll
            for (int mat = 0; mat < 2; ++mat)
#pragma unroll
                for (int mt = 0; mt < 4; ++mt) acc[mat][mt] = (f32x4){0.f, 0.f, 0.f, 0.f};
#pragma unroll
            for (int mt = 0; mt < 4; ++mt)
#pragma unroll
                for (int ks = 0; ks < 4; ++ks) { const bf16x8 af = *(const LAS bf16x8*)(XCB + (16 * mt + fr) * 136 + 32 * ks + 8 * fq);
                    acc[0][mt] = __builtin_amdgcn_mfma_f32_16x16x32_bf16(af, bfr[0][ks], acc[0][mt], 0, 0, 0);
                    acc[1][mt] = __builtin_amdgcn_mfma_f32_16x16x32_bf16(af, bfr[1][ks], acc[1][mt], 0, 0, 0); }
#pragma unroll
            for (int mt = 0; mt < 4; ++mt)
#pragma unroll
                for (int rg = 0; rg < 4; ++rg) { const int tok = 16 * mt + 4 * fq + rg; const float xcv = XC[tok * 128 + cl];
                    const float r = sigmoidf_(acc[0][mt][rg] + ba[d]), ig = sigmoidf_(acc[1][mt][rg] + bx[d]);
                    const float la = -8.0f * r * sp[d]; const float a = __expf(la); const float x2 = 2.0f * la;
                    const float em = -x2 * (1.0f + x2 * (0.5f + x2 * (0.16666667f + x2 * (0.041666668f + x2 * (0.0083333338f + x2 * 0.0013888889f)))));
                    const float bb = sqrtf(em) * (ig * xcv);
                    SC[tok * 16 + fr] = (f32x2){a, bb}; }
            WAVE_LDS_FENCE();
            float P = 1.0f, h = 0.0f;
#pragma unroll
            for (int i = 0; i < 16; ++i) { const int tok = 16 * fq + (d == 0 ? i : 15 - i); const f32x2 ab = SC[tok * 16 + fr]; h = ab.x * h + ab.y; P *= ab.x; SC[tok * 16 + fr] = (f32x2){P, h}; }
            float As[4], Bs[4];
#pragma unroll
            for (int s = 0; s < 4; ++s) { As[s] = __shfl(P, s * 16 + fr); Bs[s] = __shfl(h, s * 16 + fr); }
            const size_t cidx_off = ((size_t)((d * 2 + b) * NCH + cidx)) * LW + cg;
            if (PASS == 1) {
                float At = 1.0f, Bt = 0.0f;
#pragma unroll
                for (int s = 0; s < 4; ++s) { const int sgi = d == 0 ? s : 3 - s; Bt = As[sgi] * Bt + Bs[sgi]; At *= As[sgi]; }
                if (fq == 0) F_CAR[cidx_off] = (f32x2){At, Bt};
            } else {
                float hin = F_HIN[cidx_off];
#pragma unroll
                for (int s = 0; s < 4; ++s) { const int sgi = d == 0 ? s : 3 - s; const bool before = d == 0 ? (sgi < fq) : (sgi > fq); if (before) hin = As[sgi] * hin + Bs[sgi]; }
#pragma unroll
                for (int i = 0; i < 16; ++i) { const int tok = 16 * fq + i; const f32x2 ph = SC[tok * 16 + fr]; SC[tok * 16 + fr] = (f32x2){ph.x, ph.y + ph.x * hin}; }
                WAVE_LDS_FENCE();
#pragma unroll
                for (int mt = 0; mt < 4; ++mt)
#pragma unroll
                    for (int rg = 0; rg < 4; ++rg) { const float hv = SC[(16 * mt + 4 * fq + rg) * 16 + fr].y; hsum[mt][rg] = d == 0 ? hv : hsum[mt][rg] + hv; }
            }
            WAVE_LDS_FENCE();
        }
        if (PASS == 2) {
            __syncthreads();
#pragma unroll
            for (int mt = 0; mt < 4; ++mt)
#pragma unroll
                for (int rg = 0; rg < 4; ++rg) { const int tok = 16 * mt + 4 * fq + rg;
                    const float y = hsum[mt][rg] * gelu_tanhf_(bf2f(U[tok * 128 + cl])); XCB[tok * 136 + cl] = (bf16)f2bf(y); }
            __syncthreads();
#pragma unroll
            for (int hh = 0; hh < 2; ++hh) { const int tok = hh * 32 + (tid >> 4); const u32x4 wv = *(const LAS u32x4*)(XCB + tok * 136 + (tid & 15) * 8);
                const size_t row = rowbase + t0 + tok; *(u32x4*)(F_MIX + row * DM + n * 128 + (tid & 15) * 8) = wv;
                float sq = (bflo(wv.x) * bflo(wv.x) + bfhi(wv.x) * bfhi(wv.x)) + (bflo(wv.y) * bflo(wv.y) + bfhi(wv.y) * bfhi(wv.y)) + (bflo(wv.z) * bflo(wv.z) + bfhi(wv.z) * bfhi(wv.z)) + (bflo(wv.w) * bflo(wv.w) + bfhi(wv.w) * bfhi(wv.w));
                sq += __shfl_xor(sq, 1); sq += __shfl_xor(sq, 2); sq += __shfl_xor(sq, 4); sq += __shfl_xor(sq, 8);
                if ((tid & 15) == 0) F_SSQ[row * 16 + n] = sq; }
        }
    }
}
__device__ __forceinline__ int gdn_row(int b, int s) {
    if (s < TCX) return ML + b * TCX + s;
    const int m = s - TCX; return b * TL + (m & 127) * 64 + (m >> 7);
}
__device__ __forceinline__ void gdn_pre(const Frame& F) {
    const int gw = F.vcu * 8 + F.wave, NGW = F.G * 8, lane = F.lane;
    const float* cw = F.in[I_GCW];
    for (int tok = gw; tok < NBATCH * SEQ_S; tok += NGW) {
        const int b = tok / SEQ_S, s = tok - b * SEQ_S;
        const int lo = s < TCX ? 0 : TCX, hi = s < TCX ? TCX : SEQ_S;
        int rows[4]; bool val[4];
#pragma unroll
        for (int j = 0; j < 4; ++j) { const int sj = s + j - 2; val[j] = sj >= lo && sj < hi; rows[j] = gdn_row(b, val[j] ? sj : s); }
        for (int h = 0; h < NH; ++h) {
            float a[3][2];
#pragma unroll
            for (int p = 0; p < 3; ++p) { a[p][0] = 0.f; a[p][1] = 0.f; }
#pragma unroll
            for (int j = 0; j < 4; ++j) {
#pragma unroll
                for (int p = 0; p < 3; ++p) { const int ch = p * GDW + h * HD + 2 * lane;
                    const unsigned xw = val[j] ? *(const unsigned*)(F_QKV + (size_t)rows[j] * 6144 + ch) : 0u;
                    const f32x2 wv = *(const f32x2*)(cw + (size_t)j * 6144 + ch);
                    a[p][0] += wv.x * bflo(xw); a[p][1] += wv.y * bfhi(xw); } }
#pragma unroll
            for (int p = 0; p < 3; ++p) { a[p][0] = siluf_(a[p][0]); a[p][1] = siluf_(a[p][1]); }
            const float rq = rsqrtf(wave_sum(a[0][0] * a[0][0] + a[0][1] * a[0][1]) + EPS), rk = rsqrtf(wave_sum(a[1][0] * a[1][0] + a[1][1] * a[1][1]) + EPS);
            const unsigned qw = pk2(a[0][0] * rq, a[0][1] * rq), kw = pk2(a[1][0] * rk, a[1][1] * rk), vw = pk2(a[2][0], a[2][1]);
            const float kq = wave_sum(bflo(qw) * bflo(kw) + bfhi(qw) * bfhi(kw));
            const size_t o = ((size_t)b * SEQ_S + s) * GDW + h * HD + 2 * lane;
            *(unsigned*)(F_QN + o) = qw; *(unsigned*)(F_KN + o) = kw; *(unsigned*)(F_VN + o) = vw;
            if (lane == 0) F_KQ[(size_t)(b * NH + h) * SEQ_S + s] = kq;
        }
        if (lane < 32) { const int d = lane >> 4, h = lane & 15; const bf16* bar = F_BA + (size_t)rows[2] * 256;
            const float pb = bf2f(bar[d * 16 + h]), pa = bf2f(bar[32 + d * 16 + h]);
            const float beta = sigmoidf_(pb), g = -__expf(F.in[I_GALOG][d * 16 + h]) * softplusf_(pa + F.in[I_GDT][d * 16 + h]);
            F_GB[(size_t)((d * 2 + b) * NH + h) * SEQ_S + s] = (f32x2){g, beta}; }
    }
}
__device__ __forceinline__ void lru_chains(const Frame& F) {
    if (F.tid < 32) {
        for (int chain = F.vcu * 32 + F.tid; chain < 2 * NBATCH * LW; chain += F.G * 32) {
            const int cg = chain & (LW - 1), b = (chain >> 11) & 1, d = chain >> 12;
            float h = 0.f;
#pragma unroll 4
            for (int step = 0; step < NCH; ++step) { const int cidx = d == 0 ? step : (step < 4 ? 3 - step : NCH - 1 - (step - 4));
                const size_t idx = ((size_t)((d * 2 + b) * NCH + cidx)) * LW + cg; const f32x2 ab = F_CAR[idx]; F_HIN[idx] = h; h = ab.x * h + ab.y; }
        }
    }
}
__device__ __forceinline__ int gdn_spos(int d, int step) { return d == 0 ? step : (step < TCX ? TCX - 1 - step : SEQ_S - 1 - (step - TCX)); }
__device__ __forceinline__ void gdn_seq(const Frame& F, int item) {
    const int sl = item & 3, d = (item >> 2) & 1, h = (item >> 3) & 15, b = item >> 7;
    LAS float* Kst = (LAS float*)F.lds;
    LAS float* Qst = Kst + 2048;
    LAS float* Vst = Qst + 2048;
    LAS float* Gst = Vst + 512;
    LAS f32x2* RED = (LAS f32x2*)(Gst + 64);
    const int tid = F.tid, v = tid & 31, kg = tid >> 5;
    float S[8];
#pragma unroll
    for (int i = 0; i < 8; ++i) S[i] = 0.f;
    const bf16* Kb = F_KN + (size_t)b * SEQ_S * GDW + h * HD + (tid & 31) * 4;
    const bf16* Qb = F_QN + (size_t)b * SEQ_S * GDW + h * HD + (tid & 31) * 4;
    const bf16* Vb = F_VN + (size_t)b * SEQ_S * GDW + h * HD + sl * 32 + (tid & 31);
    const f32x2* GBp = F_GB + (size_t)((d * 2 + b) * NH + h) * SEQ_S; const float* KQp = F_KQ + (size_t)(b * NH + h) * SEQ_S;
    float* Ob = F_O + (size_t)d * ML * GDW + h * HD + sl * 32 + v;
    u32x2 pk, pq; unsigned pv; f32x2 pgb = {0.f, 0.f}; float pkq = 0.f;
#define GDN_LOADG(g0) do { const int s_ = gdn_spos(d, (g0) + (tid >> 5)); pk = *(const u32x2*)(Kb + (size_t)s_ * GDW); pq = *(const u32x2*)(Qb + (size_t)s_ * GDW); pv = Vb[(size_t)s_ * GDW]; \
        if (tid < 16) { const int s2_ = gdn_spos(d, (g0) + tid); pgb = GBp[s2_]; pkq = KQp[s2_]; } } while (0)
    GDN_LOADG(0);
    for (int g0 = 0; g0 < SEQ_S; g0 += 16) {
        *(LAS f32x4*)(Kst + (tid >> 5) * 128 + (tid & 31) * 4) = (f32x4){bflo(pk.x), bfhi(pk.x), bflo(pk.y), bfhi(pk.y)};
        *(LAS f32x4*)(Qst + (tid >> 5) * 128 + (tid & 31) * 4) = (f32x4){bflo(pq.x), bfhi(pq.x), bflo(pq.y), bfhi(pq.y)};
        Vst[(tid >> 5) * 32 + (tid & 31)] = bf2f(pv);
        if (tid < 16) { Gst[tid] = __expf(pgb.x); Gst[16 + tid] = pgb.y; Gst[32 + tid] = pkq; }
        if (g0 + 16 < SEQ_S) GDN_LOADG(g0 + 16);
        __syncthreads();
#pragma unroll 2
        for (int j = 0; j < 16; ++j) {
            const f32x4 k0 = *(const LAS f32x4*)(Kst + j * 128 + kg * 8), k1 = *(const LAS f32x4*)(Kst + j * 128 + kg * 8 + 4);
            const f32x4 q0 = *(const LAS f32x4*)(Qst + j * 128 + kg * 8), q1 = *(const LAS f32x4*)(Qst + j * 128 + kg * 8 + 4);
            const float kk[8] = {k0.x, k0.y, k0.z, k0.w, k1.x, k1.y, k1.z, k1.w}, qq[8] = {q0.x, q0.y, q0.z, q0.w, q1.x, q1.y, q1.z, q1.w};
            const float vv = Vst[j * 32 + v], eg = Gst[j], be = Gst[16 + j], kq = Gst[32 + j];
            float pkk = 0.f, pqq = 0.f;
#pragma unroll
            for (int i = 0; i < 8; ++i) { S[i] *= eg; pkk += kk[i] * S[i]; pqq += qq[i] * S[i]; }
            RED[(j & 1) * 512 + kg * 32 + v] = (f32x2){pkk, pqq};
            __syncthreads();
            float ks = 0.f, qs = 0.f;
#pragma unroll
            for (int g = 0; g < 16; ++g) { const f32x2 r = RED[(j & 1) * 512 + g * 32 + v]; ks += r.x; qs += r.y; }
            const float delta = be * (vv - ks);
#pragma unroll
            for (int i = 0; i < 8; ++i) S[i] += kk[i] * delta;
            if (kg == 0) { const int s = gdn_spos(d, g0 + j); if (s >= TCX) Ob[(size_t)gdn_row(b, s) * GDW] = (qs + delta * kq) * 0.08838834764831845f; }
        }
    }
#undef GDN_LOADG
    __syncthreads();
}
__device__ __forceinline__ void gdn_combine(const Frame& F) {
    const int gw = F.vcu * 8 + F.wave, NGW = F.G * 8, lane = F.lane;
    const f32x2 gn = *(const f32x2*)(F.in[I_GNG] + 2 * lane);
    for (int row = gw; row < ML; row += NGW) {
#pragma unroll 4
        for (int h = 0; h < NH; ++h) { const size_t o = (size_t)row * GDW + h * HD + 2 * lane;
            const f32x2 a = *(const f32x2*)(F_O + o), c = *(const f32x2*)(F_O + (size_t)ML * GDW + o); const float o0 = a.x + c.x, o1 = a.y + c.y;
            const float rs = rsqrtf(wave_sum(o0 * o0 + o1 * o1) * (1.0f / HD) + EPS);
            const unsigned zw = *(const unsigned*)(F_Z + o);
            *(unsigned*)(F_MIX + (size_t)row * DM + LW + h * HD + 2 * lane) = pk2(o0 * rs * gn.x * siluf_(bflo(zw)), o1 * rs * gn.y * siluf_(bfhi(zw))); }
    }
}
__device__ __forceinline__ void lru_normalize(const Frame& F) {
    const int gw = F.vcu * 8 + F.wave, NGW = F.G * 8, lane = F.lane;
    for (int row = gw; row < ML; row += NGW) {
        const float p = lane < 16 ? F_SSQ[(size_t)row * 16 + lane] : 0.f;
        const float rs = rsqrtf(wave_sum(p) * (1.0f / LW) + EPS);
#pragma unroll
        for (int j = 0; j < 4; ++j) { const int c0 = (lane + 64 * j) * 8; u32x4* p4 = (u32x4*)(F_MIX + (size_t)row * DM + c0); const u32x4 w = *p4;
            const f32x4 g0 = *(const f32x4*)(F.in[I_LNG] + c0), g1 = *(const f32x4*)(F.in[I_LNG] + c0 + 4);
            u32x4 o; o.x = pk2(bflo(w.x) * rs * g0.x, bfhi(w.x) * rs * g0.y); o.y = pk2(bflo(w.y) * rs * g0.z, bfhi(w.y) * rs * g0.w);
            o.z = pk2(bflo(w.z) * rs * g1.x, bfhi(w.z) * rs * g1.y); o.w = pk2(bflo(w.w) * rs * g1.z, bfhi(w.w) * rs * g1.w); *p4 = o; }
    }
}
__device__ __forceinline__ void ph_x1(const Frame& F) {
    const int gw = F.vcu * 8 + F.wave, NGW = F.G * 8, lane = F.lane;
    const f32x4* gpm = (const f32x4*)F.in[I_GPOSTMIX]; const f32x4* gpf = (const f32x4*)F.in[I_GPREFFN];
    for (int row = gw; row < ML; row += NGW) {
        const f32x4* md = (const f32x4*)(F_mod + (size_t)(row / TL) * NADA);
        const f32x4* yr = (const f32x4*)(F_Y1 + (size_t)row * DM); const f32x4* xr = (const f32x4*)(F.in[I_X] + (size_t)row * DM); f32x4* outr = (f32x4*)(F.out + (size_t)row * DM);
        f32x4 y[16]; float ss = 0.f;
#pragma unroll
        for (int j = 0; j < 16; ++j) { y[j] = yr[lane + 64 * j]; ss += (y[j].x * y[j].x + y[j].y * y[j].y) + (y[j].z * y[j].z + y[j].w * y[j].w); }
        const float rs = rsqrtf(wave_sum(ss) * (1.0f / DM) + EPS); float s2 = 0.f;
#pragma unroll
        for (int j = 0; j < 16; ++j) { const f32x4 x1 = xr[lane + 64 * j] + md[2 * (DM / 4) + lane + 64 * j] * (y[j] * rs * gpm[lane + 64 * j]);
            outr[lane + 64 * j] = x1; y[j] = x1; s2 += (x1.x * x1.x + x1.y * x1.y) + (x1.z * x1.z + x1.w * x1.w); }
        const float r2 = rsqrtf(wave_sum(s2) * (1.0f / DM) + EPS);
        u32x2* o = (u32x2*)(F_H2 + (size_t)row * DM);
#pragma unroll
        for (int j = 0; j < 16; ++j) { const f32x4 hv = (y[j] * r2 * gpf[lane + 64 * j]) * (md[4 * (DM / 4) + lane + 64 * j] + 1.0f) + md[3 * (DM / 4) + lane + 64 * j];
            u32x2 w; w.x = pk2(hv.x, hv.y); w.y = pk2(hv.z, hv.w); o[lane + 64 * j] = w; }
    }
}
__device__ __forceinline__ void ph_final(const Frame& F) {
    const int gw = F.vcu * 8 + F.wave, NGW = F.G * 8, lane = F.lane;
    const f32x4* gpf = (const f32x4*)F.in[I_GPOSTFFN];
    for (int row = gw; row < ML; row += NGW) {
        const f32x4* md = (const f32x4*)(F_mod + (size_t)(row / TL) * NADA);
        const f32x4* yr = (const f32x4*)(F_Y2 + (size_t)row * DM); f32x4* outr = (f32x4*)(F.out + (size_t)row * DM);
        f32x4 y[16]; float ss = 0.f;
#pragma unroll
        for (int j = 0; j < 16; ++j) { y[j] = yr[lane + 64 * j]; ss += (y[j].x * y[j].x + y[j].y * y[j].y) + (y[j].z * y[j].z + y[j].w * y[j].w); }
        const float rs = rsqrtf(wave_sum(ss) * (1.0f / DM) + EPS);
#pragma unroll
        for (int j = 0; j < 16; ++j) outr[lane + 64 * j] = outr[lane + 64 * j] + md[5 * (DM / 4) + lane + 64 * j] * (y[j] * rs * gpf[lane + 64 * j]);
    }
}
#ifndef MK_N_LAUNCHES
#define MK_N_LAUNCHES 1
#endif
constexpr int N_PHASES = 13;
__global__ void __launch_bounds__(512, 2) fwd(Args args) {
    extern __shared__ __attribute__((aligned(16))) unsigned char lds[];
    Frame F;
    F.lds = (LAS unsigned char*)lds;
    F.tid = threadIdx.x; F.lane = F.tid & 63; F.wave = __builtin_amdgcn_readfirstlane(F.tid >> 6);
    F.G = gridDim.x; { const int bx = blockIdx.x; F.vcu = (F.G % 8 == 0) ? (bx % 8) * (F.G / 8) + bx / 8 : bx; }
    F.in = args.in; F.out = args.out; F.ws = args.ws;
    unsigned char* ws = args.ws;
    volatile LAS unsigned* MISC = (volatile LAS unsigned*)(F.lds + MISC_OFF);
    if (F.tid < 64) MISC[F.tid] = 0u;
    __syncthreads();
    const int lo = args.ph_lo, hi = args.ph_hi;
    XcdBarrier bar; bar.bar = (unsigned*)(ws + WS_CTL) + CW_BAR; bar.x = 0; bar.st = nullptr;
    if (hi - lo > 1) bar = xcd_barrier_post((unsigned*)(ws + WS_CTL) + CW_BAR, MISC + 8);
#ifndef PH_MASK
#define PH_MASK 0x1fff
#endif
#define IN(k) (((PH_MASK >> (k)) & 1) && lo <= (k) && (k) < hi)
#define SEAM(k) do { if (IN(k) && IN((k) + 1)) xcd_barrier(bar); } while (0)
    if (IN(0)) { ph0_prologue(F); } SEAM(0);
    if (IN(1)) { ph1_modreduce(F); } SEAM(1);
    if (IN(2)) { ph2_hrows(F); } SEAM(2);
    if (IN(3)) { pg8::Gemm g{F_H, F_Wt_in, MT, NINP, DM}; pg8::StaticOrder S; S.init(MT, NINP, F.G, (int)blockIdx.x);
        pg8::EpiProj E{F_LX, F_LG, F_QKV, F_Z, F_BA};
        pg8::gemm_phase<pg8::EpiProj, pg8::StaticOrder, true, true>(F.lds, g, S, E); } SEAM(3);
    if (IN(4)) { lru_pass<1>(F); gdn_pre(F); } SEAM(4);
    if (IN(5)) { lru_chains(F); for (int item = F.vcu; item < 256; item += F.G) gdn_seq(F, item); } SEAM(5);
    if (IN(6)) { lru_pass<2>(F); gdn_combine(F); } SEAM(6);
    if (IN(7)) { lru_normalize(F); } SEAM(7);
    if (IN(8)) { pg8::Gemm g{F_MIX, F_Wt_out, ML, DM, DM}; pg8::StaticOrder S; S.init(ML, DM, F.G, (int)blockIdx.x);
        pg8::EpiF32 E{F_Y1, DM};
        pg8::gemm_phase<pg8::EpiF32, pg8::StaticOrder, true, true>(F.lds, g, S, E); } SEAM(8);
    if (IN(9)) { ph_x1(F); } SEAM(9);
    if (IN(10)) { pg8::Gemm g{F_H2, F_Wt_gu, ML, 2 * DFF, DM}; pg8::StaticOrder S; S.init(ML, 2 * DFF, F.G, (int)blockIdx.x);
        pg8::EpiSwiGLU E{F_ACT, DFF};
        pg8::gemm_phase<pg8::EpiSwiGLU, pg8::StaticOrder, true, true>(F.lds, g, S, E); } SEAM(10);
    if (IN(11)) { pg8::Gemm g{F_ACT, F_Wt_dn, ML, DM, DFF}; pg8::StaticOrder S; S.init(ML, DM, F.G, (int)blockIdx.x);
        pg8::EpiF32 E{F_Y2, DM};
        pg8::gemm_phase<pg8::EpiF32, pg8::StaticOrder, true, true>(F.lds, g, S, E); } SEAM(11);
    if (IN(12)) { ph_final(F); }
#undef IN
#undef SEAM
}

extern "C" void kernel_launch(void* const* d_in, const int* in_sizes, int n_in, void* d_out, int out_size, void* d_ws, size_t ws_size, hipStream_t stream) {
    static int grid = 0;
    if (grid == 0) {
        if (n_in != N_INPUTS || in_sizes[0] != ML * DM || out_size != ML * DM || ws_size < WS_END) { fprintf(stderr, "kernel_launch: unexpected problem shape (n_in %d, in0 %d, out %d, ws %zu): nothing launched\n", n_in, n_in > 0 ? in_sizes[0] : -1, out_size, ws_size); grid = -1; return; }
        int dev = 0, cus = 0;
        if (hipGetDevice(&dev) != hipSuccess || hipDeviceGetAttribute(&cus, hipDeviceAttributeMultiprocessorCount, dev) != hipSuccess) { grid = -1; return; }
        if (hipFuncSetAttribute((const void*)fwd, hipFuncAttributeMaxDynamicSharedMemorySize, LDS_BYTES) != hipSuccess) { fprintf(stderr, "kernel_launch: hipFuncSetAttribute failed\n"); grid = -1; return; }
        (void)hipGetLastError();
        grid = cus >= 256 ? 256 : (cus / 16) * 16;
        if (grid < 16) { grid = -1; return; }
    }
    if (grid < 0) return;
    (void)hipMemsetAsync((char*)d_ws + WS_CTL, 0, CTL_ZERO_BYTES, stream);
    Args a{};
    for (int i = 0; i < N_INPUTS; ++i) a.in[i] = (const float*)d_in[i];
    a.out = (float*)d_out; a.ws = (unsigned char*)d_ws;
#if MK_N_LAUNCHES == 1
    a.ph_lo = 0; a.ph_hi = N_PHASES;
    hipLaunchKernelGGL(fwd, dim3(grid), dim3(512), LDS_BYTES, stream, a);
#else
    for (int p = 0; p < N_PHASES; ++p) { a.ph_lo = p; a.ph_hi = p + 1; hipLaunchKernelGGL(fwd, dim3(grid), dim3(512), LDS_BYTES, stream, a); }
#endif
}
```

```cpp
#include <hip/hip_runtime.h>
#include <cstdio>
#include <cstdint>
namespace pg8 {
#define PG8_LAS __attribute__((address_space(3)))
typedef unsigned short bf16_t;
typedef short bf16x8 __attribute__((ext_vector_type(8)));
typedef float f32x4 __attribute__((ext_vector_type(4)));
typedef unsigned u32x4 __attribute__((ext_vector_type(4)));
constexpr int BM = 256, BK = 64, HALF = 128, HTB = HALF * BK * 2  , STAGE_BYTES = 8 * HTB, NXCD = 8, WGM = 8;

__host__ __device__ __forceinline__ int lds_byte(int r, int c) { const int st = (r >> 4) * 2 + (c >> 5), rr = r & 15, cc = c & 31, ob = rr * 64 + cc * 2; return st * 1024 + (ob ^ (((ob >> 9) & 1) << 5)); }
__host__ __device__ __forceinline__ void stage_rc(int b, int& R, int& C) { const int st = b / 1024, sb = b % 1024, swz = sb ^ (((sb >> 9) & 1) << 5); R = (st >> 1) * 16 + swz / 64; C = (st & 1) * 32 + (swz % 64) / 2; }
__host__ __device__ __forceinline__ int perm32(int rho) { const int n = rho >> 4, i = rho & 15; return 8 * (i >> 2) + 4 * n + (i & 3); }

struct Unit { int pm, pn; };
struct Gemm { const bf16_t* A; const bf16_t* Bt; int M, N, K; };

struct StaticOrder {
    int nM, nN, nwg, G, c;
    __host__ __device__ void init(int M, int N, int G_, int c_) { nM = M / BM; nN = N / BM; nwg = nM * nN; G = G_; c = c_; }
    __host__ __device__ bool next(int i, Unit& u) const {
        const long L = (long)i * G + c; if (L >= nwg) return false;
        int wgid = (int)L; { const int q = nwg / NXCD, r = nwg % NXCD, xcd = wgid % NXCD, off = wgid / NXCD; wgid = (xcd < r ? xcd * (q + 1) : r * (q + 1) + (xcd - r) * q) + off; }
        const int nig = WGM * nN, gid = wgid / nig, fm = gid * WGM, gsz = (nM - fm) < WGM ? (nM - fm) : WGM;
        u.pm = fm + ((wgid % nig) % gsz); u.pn = (wgid % nig) / gsz; return true;
    }
    __device__ __forceinline__ void a_ready(const Unit&) const {}
    __device__ __forceinline__ void done(const Unit&) const {}
};
__device__ __forceinline__ unsigned cvt_pk_bf16(float lo, float hi) { unsigned r; asm volatile("v_cvt_pk_bf16_f32 %0, %1, %2" : "=v"(r) : "v"(lo), "v"(hi)); return r; }
struct EpiF32 {
    static constexpr bool PERM = false, AFTER_DRAIN = false;
    float* C; int ldc;
    __device__ __forceinline__ void operator()(const f32x4 (&acc)[2][2][4][2], const Unit& u, int wr, int wc, int fr, int fq) const {
        const int row0 = u.pm * BM + wr * 64 + fr, col0 = u.pn * BM + wc * 32 + 4 * fq;
#pragma unroll
        for (int ai = 0; ai < 2; ++ai)
#pragma unroll
            for (int m = 0; m < 4; ++m) { float* rowp = C + (size_t)(row0 + ai * HALF + m * 16) * ldc + col0;
#pragma unroll
                for (int bj = 0; bj < 2; ++bj)
#pragma unroll
                    for (int n = 0; n < 2; ++n) *(f32x4*)(rowp + bj * HALF + n * 16) = acc[ai][bj][m][n]; }
    }
};
struct EpiProj {
    static constexpr bool PERM = true, AFTER_DRAIN = false;
    bf16_t *lx, *lg, *qkv, *z, *ba;
    __device__ __forceinline__ void operator()(const f32x4 (&acc)[2][2][4][2], const Unit& u, int wr, int wc, int fr, int fq) const {
        const int pn = u.pn; bf16_t* base; int ld, colt;
        if (pn < 8) { base = lx; ld = 2048; colt = pn * BM; }
        else if (pn < 16) { base = lg; ld = 2048; colt = (pn - 8) * BM; }
        else if (pn < 40) { base = qkv; ld = 6144; colt = (pn - 16) * BM; }
        else if (pn < 48) { base = z; ld = 2048; colt = (pn - 40) * BM; }
        else { base = ba; ld = 256; colt = 0; }
        const int row0 = u.pm * BM + wr * 64 + fr, col0 = colt + wc * 32 + 8 * fq;
#pragma unroll
        for (int ai = 0; ai < 2; ++ai)
#pragma unroll
            for (int m = 0; m < 4; ++m) { bf16_t* rowp = base + (size_t)(row0 + ai * HALF + m * 16) * ld + col0;
#pragma unroll
                for (int bj = 0; bj < 2; ++bj) { const f32x4 v0 = acc[ai][bj][m][0], v1 = acc[ai][bj][m][1];
                    u32x4 w; w.x = cvt_pk_bf16(v0[0], v0[1]); w.y = cvt_pk_bf16(v0[2], v0[3]); w.z = cvt_pk_bf16(v1[0], v1[1]); w.w = cvt_pk_bf16(v1[2], v1[3]);
                    *(u32x4*)(rowp + bj * HALF) = w; } }
    }
};
struct EpiSwiGLU {
    static constexpr bool PERM = true, AFTER_DRAIN = false;
    bf16_t* O; int ldc;
    __device__ __forceinline__ void operator()(const f32x4 (&acc)[2][2][4][2], const Unit& u, int wr, int wc, int fr, int fq) const {
        const int row0 = u.pm * BM + wr * 64 + fr, col0 = u.pn * HALF + wc * 32 + 8 * fq;
#pragma unroll
        for (int ai = 0; ai < 2; ++ai)
#pragma unroll
            for (int m = 0; m < 4; ++m) { bf16_t* rowp = O + (size_t)(row0 + ai * HALF + m * 16) * ldc + col0;
                float r[8];
#pragma unroll
                for (int n = 0; n < 2; ++n)
#pragma unroll
                    for (int j = 0; j < 4; ++j) { const float g = acc[ai][0][m][n][j], up = acc[ai][1][m][n][j]; r[4 * n + j] = g * __builtin_amdgcn_rcpf(1.0f + __expf(-g)) * up; }
                u32x4 w; w.x = cvt_pk_bf16(r[0], r[1]); w.y = cvt_pk_bf16(r[2], r[3]); w.z = cvt_pk_bf16(r[4], r[5]); w.w = cvt_pk_bf16(r[6], r[7]);
                *(u32x4*)rowp = w; }
    }
};

template <class Epi, class Sched, bool ALIGN_EPI = false, bool SP2 = false>
__device__ __forceinline__ void gemm_phase(PG8_LAS unsigned char* lds, const Gemm g, const Sched& S, const Epi& E) {
    const int tid = threadIdx.x, wid = __builtin_amdgcn_readfirstlane(tid >> 6), lane = tid & 63, wr = wid >> 2, wc = wid & 3, fr = lane & 15, fq = lane >> 4;
    const int K = g.K, nt = K / BK;
    unsigned voffA[2], voffB[2];
#pragma unroll
    for (int i = 0; i < 2; ++i) { int R, C; stage_rc(tid * 16 + i * 8192, R, C); const int Rb = Epi::PERM ? ((R & ~31) + perm32(R & 31)) : R;
        voffA[i] = (unsigned)(R * K + C) * 2u; voffB[i] = (unsigned)(Rb * K + C) * 2u; }
    const size_t kstep = (size_t)(BK * 2);
    const size_t hstep = (size_t)HALF * K * 2;
    const size_t tstep = 2 * hstep;
    const unsigned ldsw = (unsigned)wid * 1024u;
    const int aoff = lds_byte(wr * 64 + fr, fq * 8), boff = lds_byte(wc * 32 + fr, fq * 8);
#define PG8_SA(b, h) (((b) * 2 + (h)) * HTB)
#define PG8_SB(b, h) ((4 + (b) * 2 + (h)) * HTB)
#define PG8_STAGE(bufoff, gbase, voff) do { _Pragma("unroll") for (int _i = 0; _i < 2; ++_i) \
        __builtin_amdgcn_global_load_lds((const unsigned*)((const char*)(gbase) + (voff)[_i]), (PG8_LAS unsigned*)(lds + (bufoff) + ldsw + _i * 8192), 16, 0, 0); } while (0)
#define PG8_LDA(dst, b, h) do { _Pragma("unroll") for (int m = 0; m < 4; ++m) _Pragma("unroll") for (int k = 0; k < 2; ++k) dst[m][k] = *(const PG8_LAS bf16x8*)(lds + PG8_SA(b, h) + aoff + m * 2048 + k * 1024); } while (0)
#define PG8_LDB(dst, b, h) do { _Pragma("unroll") for (int n = 0; n < 2; ++n) _Pragma("unroll") for (int k = 0; k < 2; ++k) dst[n][k] = *(const PG8_LAS bf16x8*)(lds + PG8_SB(b, h) + boff + n * 2048 + k * 1024); } while (0)
#define PG8_MMA(ai, bj, At, Bt) do { __builtin_amdgcn_s_setprio(1); _Pragma("unroll") for (int m = 0; m < 4; ++m) _Pragma("unroll") for (int n = 0; n < 2; ++n) _Pragma("unroll") for (int k = 0; k < 2; ++k) \
        acc[ai][bj][m][n] = __builtin_amdgcn_mfma_f32_16x16x32_bf16(Bt[n][k], At[m][k], acc[ai][bj][m][n], 0, 0, 0); __builtin_amdgcn_s_setprio(0); } while (0)
#define PG8_WAIT_V(n) asm volatile("s_waitcnt vmcnt(" #n ")" ::: "memory")
#define PG8_WAIT_L(n) asm volatile("s_waitcnt lgkmcnt(" #n ")" ::: "memory")
#define PG8_BAR __builtin_amdgcn_s_barrier()
#define PG8_SCHED __builtin_amdgcn_sched_barrier(0)
    Unit cur, nxt; int ui = 0;
    if (!S.next(0, cur)) return;
    f32x4 acc[2][2][4][2];
#pragma unroll
    for (int a = 0; a < 2; ++a)
#pragma unroll
        for (int b = 0; b < 2; ++b)
#pragma unroll
            for (int m = 0; m < 4; ++m)
#pragma unroll
                for (int n = 0; n < 2; ++n) acc[a][b][m][n] = (f32x4){0.f, 0.f, 0.f, 0.f};
    bf16x8 At[4][2], B0[2][2], B1[2][2];
    const char* cA = (const char*)g.A + (size_t)cur.pm * tstep; const char* cB = (const char*)g.Bt + (size_t)cur.pn * tstep;
    S.a_ready(cur);
    if constexpr (SP2) {
        PG8_STAGE(PG8_SB(0, 0), cB, voffB); PG8_STAGE(PG8_SB(0, 1), cB + hstep, voffB); PG8_STAGE(PG8_SA(0, 0), cA, voffA); PG8_STAGE(PG8_SA(0, 1), cA + hstep, voffA);
        if (wr == 1) PG8_BAR;
        PG8_WAIT_V(2); PG8_BAR;
        PG8_STAGE(PG8_SB(1, 0), cB + kstep, voffB); PG8_STAGE(PG8_SA(1, 0), cA + kstep, voffA); PG8_STAGE(PG8_SB(1, 1), cB + hstep + kstep, voffB);
        PG8_WAIT_V(6); PG8_BAR;
    } else {
        PG8_STAGE(PG8_SB(0, 0), cB, voffB); PG8_STAGE(PG8_SA(0, 0), cA, voffA); PG8_STAGE(PG8_SB(0, 1), cB + hstep, voffB); PG8_STAGE(PG8_SA(0, 1), cA + hstep, voffA);
        if (wr == 1) PG8_BAR;
        PG8_WAIT_V(4); PG8_BAR;
        PG8_STAGE(PG8_SB(1, 0), cB + kstep, voffB); PG8_STAGE(PG8_SA(1, 0), cA + kstep, voffA); PG8_STAGE(PG8_SB(1, 1), cB + hstep + kstep, voffB);
        PG8_WAIT_V(6); PG8_BAR;
    }
    for (;;) {
        const bool has_next = S.next(ui + 1, nxt);
        const char* nA = has_next ? (const char*)g.A + (size_t)nxt.pm * tstep : cA; const char* nB = has_next ? (const char*)g.Bt + (size_t)nxt.pn * tstep : cB;
        for (int t = 0; t < nt; t += 2) {
            const bool last = (t == nt - 2);
            const char* a1 = cA + (size_t)(t + 1) * kstep;
            const char* a2 = last ? nA : cA + (size_t)(t + 2) * kstep; const char* b2 = last ? nB : cB + (size_t)(t + 2) * kstep;
            const char* a3 = a2 + kstep; const char* b3 = b2 + kstep;
            if (last && has_next) S.a_ready(nxt);
            if constexpr (SP2) {
            PG8_LDB(B0, 0, 0); PG8_LDB(B1, 0, 1); PG8_SCHED; PG8_LDA(At, 0, 0); PG8_STAGE(PG8_SA(1, 1), a1 + hstep, voffA);
            PG8_WAIT_V(8); PG8_WAIT_L(0); PG8_BAR; PG8_MMA(0, 0, At, B0); PG8_MMA(0, 1, At, B1); PG8_BAR; PG8_SCHED;
            PG8_LDA(At, 0, 1); PG8_STAGE(PG8_SB(0, 0), b2, voffB); PG8_STAGE(PG8_SB(0, 1), b2 + hstep, voffB); PG8_STAGE(PG8_SA(0, 0), a2, voffA);
            PG8_WAIT_V(8); PG8_WAIT_L(0); PG8_BAR; PG8_MMA(1, 0, At, B0); PG8_MMA(1, 1, At, B1); PG8_BAR; PG8_SCHED;
            PG8_LDB(B0, 1, 0); PG8_LDB(B1, 1, 1); PG8_SCHED; PG8_LDA(At, 1, 0); PG8_STAGE(PG8_SA(0, 1), a2 + hstep, voffA);
            PG8_WAIT_V(8); PG8_WAIT_L(0); PG8_BAR; PG8_MMA(0, 0, At, B0); PG8_MMA(0, 1, At, B1); PG8_BAR; PG8_SCHED;
            PG8_LDA(At, 1, 1); PG8_STAGE(PG8_SB(1, 0), b3, voffB); PG8_STAGE(PG8_SB(1, 1), b3 + hstep, voffB); PG8_STAGE(PG8_SA(1, 0), a3, voffA);
            PG8_WAIT_V(8); PG8_WAIT_L(0); PG8_BAR; PG8_MMA(1, 0, At, B0); PG8_MMA(1, 1, At, B1); PG8_BAR; PG8_SCHED;
            } else {
            PG8_LDB(B0, 0, 0); PG8_SCHED; PG8_LDA(At, 0, 0); PG8_STAGE(PG8_SA(1, 1), a1 + hstep, voffA);
            PG8_WAIT_L(8); PG8_BAR; PG8_WAIT_L(0); PG8_MMA(0, 0, At, B0); PG8_BAR; PG8_SCHED;
            PG8_LDB(B1, 0, 1); PG8_STAGE(PG8_SB(0, 0), b2, voffB);
            PG8_BAR; PG8_WAIT_L(0); PG8_MMA(0, 1, At, B1); PG8_BAR;
            PG8_LDA(At, 0, 1); PG8_STAGE(PG8_SA(0, 0), a2, voffA);
            PG8_BAR; PG8_WAIT_L(0); PG8_MMA(1, 0, At, B0); PG8_BAR; PG8_SCHED;
            PG8_STAGE(PG8_SB(0, 1), b2 + hstep, voffB);
            PG8_WAIT_V(6); PG8_BAR; PG8_MMA(1, 1, At, B1); PG8_BAR;
            PG8_LDB(B0, 1, 0); PG8_SCHED; PG8_LDA(At, 1, 0); PG8_STAGE(PG8_SA(0, 1), a2 + hstep, voffA);
            PG8_WAIT_L(8); PG8_BAR; PG8_WAIT_L(0); PG8_MMA(0, 0, At, B0); PG8_BAR; PG8_SCHED;
            PG8_LDB(B1, 1, 1); PG8_STAGE(PG8_SB(1, 0), b3, voffB);
            PG8_BAR; PG8_WAIT_L(0); PG8_MMA(0, 1, At, B1); PG8_BAR;
            PG8_LDA(At, 1, 1); PG8_STAGE(PG8_SA(1, 0), a3, voffA);
            PG8_BAR; PG8_WAIT_L(0); PG8_MMA(1, 0, At, B0); PG8_BAR; PG8_SCHED;
            PG8_STAGE(PG8_SB(1, 1), b3 + hstep, voffB);
            PG8_WAIT_V(6); PG8_BAR; PG8_MMA(1, 1, At, B1); PG8_BAR;
            }
        }
        if constexpr (ALIGN_EPI) { if (wr == 0) PG8_BAR; }
        if constexpr (!Epi::AFTER_DRAIN) { E(acc, cur, wr, wc, fr, fq); S.done(cur); }
        if (!has_next) break;
#pragma unroll
        for (int a = 0; a < 2; ++a)
#pragma unroll
            for (int b = 0; b < 2; ++b)
#pragma unroll
                for (int m = 0; m < 4; ++m)
#pragma unroll
                    for (int n = 0; n < 2; ++n) acc[a][b][m][n] = (f32x4){0.f, 0.f, 0.f, 0.f};
        cur = nxt; cA = nA; cB = nB; ++ui;
        if constexpr (ALIGN_EPI) { if (wr == 1) PG8_BAR; }
    }
    PG8_WAIT_V(0);
    if constexpr (!ALIGN_EPI) { if (wr == 0) PG8_BAR; }
    PG8_BAR;
    if constexpr (Epi::AFTER_DRAIN) { E.fused(acc, cur, wr, wc, fr, fq, lds, wid, lane); S.done(cur); }
#undef PG8_SA
#undef PG8_SB
#undef PG8_STAGE
#undef PG8_LDA
#undef PG8_LDB
#undef PG8_MMA
#undef PG8_WAIT_V
#undef PG8_WAIT_L
#undef PG8_BAR
#undef PG8_SCHED
}
}
constexpr int DM = 4096, NBATCH = 2, TL = 8192, TCX = 256, ML = NBATCH * TL, MC = NBATCH * TCX, MT = ML + MC;
constexpr int LW = 2048, GDW = 2048, NH = 16, HD = 128, DFF = 11008, NIN = 12352, NINP = 12544, NADA = 6 * DM;
constexpr int SEQ_S = TCX + TL;
constexpr int NCH = 132;
constexpr float EPS = 1e-6f;
enum { I_X = 0, I_C, I_CTX, I_CCTX, I_WADA, I_BADA, I_GPREMIX, I_GPOSTMIX, I_GPREFFN, I_GPOSTFFN, I_WIN, I_LCW, I_LCB, I_LWA, I_LBA, I_LWX, I_LBX, I_LLAM, I_LNG, I_GCW, I_GALOG, I_GDT, I_GNG, I_WOUT, I_WG, I_WU, I_WD, N_INPUTS };

constexpr size_t MiB = 1u << 20;
constexpr size_t WS_CTL = 0, CTL_ZERO_BYTES = 1 * MiB;
constexpr size_t WS_MODP = 1 * MiB, WS_MOD = 11 * MiB, WS_WL = 12 * MiB, WS_CAR = 14 * MiB, WS_HIN = 23 * MiB, WS_GB = 28 * MiB, WS_KQ = 33 * MiB, WS_SSQ = 35 * MiB;
constexpr size_t WS_WOUT = 44 * MiB, WS_WGU = 76 * MiB, WS_WDN = 248 * MiB;
constexpr size_t WS_R2 = 334 * MiB;
constexpr size_t WS_WIN = WS_R2, WS_H = WS_R2 + 98 * MiB;
constexpr size_t WS_QN = WS_R2, WS_KN = WS_R2 + 66 * MiB, WS_VN = WS_R2 + 132 * MiB;
constexpr size_t WS_H2 = WS_R2, WS_Y2 = WS_R2;
constexpr size_t WS_R3 = 590 * MiB;
constexpr size_t WS_LX = WS_R3, WS_LG = WS_R3 + 66 * MiB, WS_QKV = WS_R3 + 132 * MiB, WS_Z = WS_R3 + 330 * MiB, WS_BA = WS_R3 + 396 * MiB;
constexpr size_t WS_Y1 = WS_R3, WS_ACT = WS_R3;
constexpr size_t WS_MIX = 995 * MiB;
constexpr size_t WS_UT = 1123 * MiB, WS_W = 1255 * MiB, WS_INTRA = 1387 * MiB, WS_END = 1453 * MiB;
constexpr size_t WS_KT = WS_QKV, WS_GSC = 37 * MiB;
static_assert(WS_SSQ + (size_t)ML * 16 * 4 <= WS_WOUT && WS_WOUT + (size_t)DM * DM * 2 <= WS_WGU && WS_WGU + (size_t)2 * DFF * DM * 2 <= WS_WDN && WS_WDN + (size_t)DM * DFF * 2 <= WS_R2, "ws map 1");
static_assert(WS_WIN + (size_t)NINP * DM * 2 <= WS_H && WS_H + (size_t)MT * DM * 2 <= WS_R3 && WS_VN + (size_t)NBATCH * SEQ_S * 2048 * 2 <= WS_R3 && WS_Y2 + (size_t)ML * DM * 4 <= WS_R3, "ws map 2");
static_assert((size_t)MT * 2048 * 2 <= 66 * MiB && (size_t)MT * 6144 * 2 <= 198 * MiB && WS_BA + (size_t)MT * 256 * 2 <= WS_MIX && WS_ACT + (size_t)ML * DFF * 2 <= WS_MIX && WS_MIX + (size_t)ML * DM * 2 <= WS_UT, "ws map 3");
static_assert((size_t)NBATCH * NH * NCH * 2 * 8192 * 2 == 132 * MiB && WS_KT + 132 * MiB <= WS_Z && WS_GSC + (size_t)NBATCH * NH * NCH * 2 * 128 * 4 <= WS_WOUT && WS_SSQ + (size_t)ML * 16 * 4 <= WS_GSC, "ws map 4");
constexpr int CW_BAR = 4096;

constexpr int LDS_BYTES = 147456;
constexpr int MISC_OFF = LDS_BYTES - 256;

#define GAS __attribute__((address_space(1)))
#define LAS __attribute__((address_space(3)))
typedef unsigned short bf16;
typedef unsigned u32x4 __attribute__((ext_vector_type(4)));
typedef unsigned u32x2 __attribute__((ext_vector_type(2)));
typedef float f32x4 __attribute__((ext_vector_type(4)));
typedef float f32x2 __attribute__((ext_vector_type(2)));
typedef short bf16x8 __attribute__((ext_vector_type(8)));
#define LDS_WAIT() asm volatile("s_waitcnt lgkmcnt(0)" ::: "memory")
#define WAVE_LDS_FENCE() do { asm volatile("s_waitcnt lgkmcnt(0)" ::: "memory"); __builtin_amdgcn_wave_barrier(); } while (0)
__device__ __forceinline__ unsigned f2bf(float f) { unsigned u = __builtin_bit_cast(unsigned, f); return (u + 0x7fffu + ((u >> 16) & 1u)) >> 16; }
__device__ __forceinline__ unsigned pk2(float lo, float hi) { return f2bf(lo) | (f2bf(hi) << 16); }
__device__ __forceinline__ float bf2f(unsigned h) { return __builtin_bit_cast(float, h << 16); }
__device__ __forceinline__ float bflo(unsigned w) { return __builtin_bit_cast(float, w << 16); }
__device__ __forceinline__ float bfhi(unsigned w) { return __builtin_bit_cast(float, w & 0xffff0000u); }
__device__ __forceinline__ float wave_sum(float v) {
#pragma unroll
    for (int o = 1; o < 64; o <<= 1) v += __shfl_xor(v, o);
    return v;
}
__device__ __forceinline__ float sigmoidf_(float x) { return __builtin_amdgcn_rcpf(1.0f + __expf(-x)); }
__device__ __forceinline__ float siluf_(float x) { return x * sigmoidf_(x); }
__device__ __forceinline__ float softplusf_(float x) { return x > 20.f ? x : log1pf(__expf(x)); }
__device__ __forceinline__ float gelu_tanhf_(float x) { const float u = 0.7978845608028654f * (x + 0.044715f * x * x * x); const float t = 1.0f - 2.0f * __builtin_amdgcn_rcpf(__expf(2.0f * u) + 1.0f); return 0.5f * x * (1.0f + t); }
__device__ __forceinline__ float rdlane(float x, int l) { return __builtin_bit_cast(float, __builtin_amdgcn_readlane(__builtin_bit_cast(int, x), l)); }

#define XB_TMO      128
#define XB_XCNT(j)  (256  + 64 * (j))
#define XB_XSUB(j)  (1280 + 64 * (j))
#define XB_XGEN(j)  (2304 + 64 * (j))
#define XB_TOP      3328
#define XB_TOPGEN   3392
#define XCD_BAR_WORDS 3456
#define XB_SPIN_CAP (1u << 22)
__device__ __forceinline__ unsigned xb_ld(unsigned* p)              { return __hip_atomic_load(p, __ATOMIC_RELAXED, __HIP_MEMORY_SCOPE_AGENT); }
__device__ __forceinline__ unsigned xb_add(unsigned* p, unsigned v) { return __hip_atomic_fetch_add(p, v, __ATOMIC_RELAXED, __HIP_MEMORY_SCOPE_AGENT); }
__device__ __forceinline__ unsigned xb_xcc_id() { return (unsigned)__builtin_amdgcn_s_getreg((3 << 11) | 20) & 0xFu; }
#define XB_SPIN(cond, bar) do { unsigned _sp = 0; while (cond) { __builtin_amdgcn_s_sleep(1); \
    if ((++_sp & 255u) == 0u) { if (xb_ld(&(bar)[XB_TMO])) break; if (_sp > XB_SPIN_CAP) { atomicAdd(&(bar)[XB_TMO], 1u); break; } } } } while (0)
struct XcdBarrier { unsigned* bar; unsigned x; volatile LAS unsigned* st; };
__device__ __forceinline__ XcdBarrier xcd_barrier_post(unsigned* bar, volatile LAS unsigned* st) {
    XcdBarrier b; b.bar = bar; b.x = xb_xcc_id(); b.st = st;
    if (threadIdx.x == 0) (void)xb_add(&bar[XB_XCNT(b.x)], 1u);
    return b;
}
__device__ __forceinline__ void xcd_barrier_complete(unsigned* bar, unsigned x, unsigned& nloc, unsigned& nx) {
    const unsigned G = gridDim.x * gridDim.y * gridDim.z;
    unsigned sum, cnt, mine, sp = 0u;
    for (;;) {
        sum = 0u; cnt = 0u; mine = 0u;
#pragma unroll
        for (unsigned j = 0; j < 16; ++j) { const unsigned c = xb_ld(&bar[XB_XCNT(j)]); sum += c; cnt += (c > 0u) ? 1u : 0u; mine = (j == x) ? c : mine; }
        if (sum == G) break;
        __builtin_amdgcn_s_sleep(1);
        if ((++sp & 255u) == 0u) { if (xb_ld(&bar[XB_TMO])) break; if (sp > XB_SPIN_CAP) { atomicAdd(&bar[XB_TMO], 1u); break; } }
    }
    nloc = mine > 0u ? mine : 1u; nx = cnt > 0u ? cnt : 1u;
}
__device__ __forceinline__ void xcd_barrier(const XcdBarrier& b) {
    asm volatile("s_waitcnt vmcnt(0)" ::: "memory");
    __syncthreads();
    if (threadIdx.x == 0) {
        unsigned* bar = b.bar;
        __builtin_amdgcn_s_waitcnt(0);
        unsigned nloc = b.st[0], nx = b.st[1];
        if (nloc == 0u) { xcd_barrier_complete(bar, b.x, nloc, nx); b.st[0] = nloc; b.st[1] = nx; }
        const unsigned old = xb_add(&bar[XB_XSUB(b.x)], 1u);
        const unsigned gen = old / nloc;
        if (old + 1u == (gen + 1u) * nloc) {
            __builtin_amdgcn_fence(__ATOMIC_RELEASE, "agent");
            asm volatile("s_waitcnt vmcnt(0)" ::: "memory");
            const unsigned og = xb_add(&bar[XB_TOP], 1u);
            const unsigned tg = og / nx;
            if (og + 1u == (tg + 1u) * nx) xb_add(&bar[XB_TOPGEN], 1u);
            else XB_SPIN(xb_ld(&bar[XB_TOPGEN]) == tg, bar);
            __builtin_amdgcn_fence(__ATOMIC_ACQUIRE, "agent");
            xb_add(&bar[XB_XGEN(b.x)], 1u);
            asm volatile("s_waitcnt vmcnt(0)" ::: "memory");
        } else {
            XB_SPIN(xb_ld(&bar[XB_XGEN(b.x)]) == gen, bar);
            __builtin_amdgcn_fence(__ATOMIC_ACQUIRE, "agent");
            asm volatile("s_waitcnt vmcnt(0)" ::: "memory");
        }
    }
    __syncthreads();
}

struct Args { const float* in[N_INPUTS]; float* out; unsigned char* ws; int ph_lo, ph_hi; };
struct Frame {
    LAS unsigned char* lds;
    int tid, lane, wave, vcu, G;
    const float* const* in;
    float* out; unsigned char* ws;
};
#define F_modp ((float*)(F.ws + WS_MODP))
#define F_mod ((float*)(F.ws + WS_MOD))
#define F_WL ((bf16*)(F.ws + WS_WL))
#define F_CAR ((f32x2*)(F.ws + WS_CAR))
#define F_HIN ((float*)(F.ws + WS_HIN))
#define F_GB ((f32x2*)(F.ws + WS_GB))
#define F_KQ ((float*)(F.ws + WS_KQ))
#define F_SSQ ((float*)(F.ws + WS_SSQ))
#define F_Wt_out ((bf16*)(F.ws + WS_WOUT))
#define F_Wt_gu ((bf16*)(F.ws + WS_WGU))
#define F_Wt_dn ((bf16*)(F.ws + WS_WDN))
#define F_Wt_in ((bf16*)(F.ws + WS_WIN))
#define F_H ((bf16*)(F.ws + WS_H))
#define F_QN ((bf16*)(F.ws + WS_QN))
#define F_KN ((bf16*)(F.ws + WS_KN))
#define F_VN ((bf16*)(F.ws + WS_VN))
#define F_H2 ((bf16*)(F.ws + WS_H2))
#define F_LX ((bf16*)(F.ws + WS_LX))
#define F_LG ((bf16*)(F.ws + WS_LG))
#define F_QKV ((bf16*)(F.ws + WS_QKV))
#define F_Z ((bf16*)(F.ws + WS_Z))
#define F_BA ((bf16*)(F.ws + WS_BA))
#define F_ACT ((bf16*)(F.ws + WS_ACT))
#define F_MIX ((bf16*)(F.ws + WS_MIX))
#define F_Y1 ((float*)(F.ws + WS_Y1))
#define F_Y2 ((float*)(F.ws + WS_Y2))
#define F_O (F.out)
#define F_UT ((bf16*)(F.ws + WS_UT))
#define F_W ((bf16*)(F.ws + WS_W))
#define F_INTRA ((bf16*)(F.ws + WS_INTRA))
#define F_KT ((bf16*)(F.ws + WS_KT))
#define F_GSC ((float*)(F.ws + WS_GSC))
__device__ __forceinline__ void transpose_item(const float* W, int N, bf16* WT, int Kp, int k0, int n0, int drow0, LAS float* scr, int lane) {
#pragma unroll 8
    for (int i = 0; i < 32; ++i) { const int kk = 2 * i + (lane >> 5); scr[kk * 33 + (lane & 31)] = W[(size_t)(k0 + kk) * N + n0 + (lane & 31)]; }
    LDS_WAIT(); asm volatile("" ::: "memory");
    const int c = lane & 7;
#pragma unroll
    for (int j = 0; j < 4; ++j) { const int n = (lane >> 3) + 8 * j; const LAS float* s = scr + (8 * c) * 33 + n;
        u32x4 o; o.x = pk2(s[0 * 33], s[1 * 33]); o.y = pk2(s[2 * 33], s[3 * 33]); o.z = pk2(s[4 * 33], s[5 * 33]); o.w = pk2(s[6 * 33], s[7 * 33]);
        *(u32x4*)(WT + (size_t)(drow0 + n) * Kp + k0 + 8 * c) = o; }
    LDS_WAIT(); asm volatile("" ::: "memory");
}

__device__ __forceinline__ void ph0_prologue(const Frame& F) {
    const int gw = F.vcu * 8 + F.wave, NGW = F.G * 8, lane = F.lane;
    {
        const float* W = F.in[I_WADA]; const float* c = F.in[I_C]; const float* cc = F.in[I_CCTX];
        for (int it = gw; it < 96 * 32; it += NGW) {
            const int cg = it % 96, kc = it / 96;
            float sv[3][2];
#pragma unroll
            for (int h = 0; h < 2; ++h) { const int k = kc * 128 + h * 64 + lane; sv[0][h] = siluf_(c[k]); sv[1][h] = siluf_(c[DM + k]); sv[2][h] = siluf_(cc[k]); }
            f32x4 a0 = {0.f, 0.f, 0.f, 0.f}, a1 = a0, a2 = a0;
            const f32x4* wp = (const f32x4*)(W + (size_t)kc * 128 * NADA + cg * 256) + lane;
#pragma unroll
            for (int h = 0; h < 2; ++h) {
#pragma unroll 8
                for (int kk = 0; kk < 64; ++kk) { const f32x4 w = wp[(size_t)(h * 64 + kk) * (NADA / 4)];
                    const float s0 = rdlane(sv[0][h], kk), s1 = rdlane(sv[1][h], kk), s2 = rdlane(sv[2][h], kk);
                    a0 += w * s0; a1 += w * s1; a2 += w * s2; } }
            float* mp = F_modp + (size_t)(kc * 3) * NADA + cg * 256;
            ((f32x4*)mp)[lane] = a0; ((f32x4*)(mp + NADA))[lane] = a1; ((f32x4*)(mp + 2 * NADA))[lane] = a2;
        }
    }
    {
        LAS float* scr = (LAS float*)(F.lds + F.wave * 16384);
        constexpr int IT_IN = 64 * (NIN / 32), IT_OUT = 64 * (DM / 32), IT_G = 64 * (DFF / 32), IT_D = (DFF / 64) * (DM / 32), IT_L = 64 * 8;
        constexpr int NITEMS = IT_IN + IT_OUT + 2 * IT_G + IT_D + IT_L;
        for (int it = gw; it < NITEMS; it += NGW) {
            int r = it;
            if (r < IT_IN) { const int kb = r / (NIN / 32), nb = r % (NIN / 32); transpose_item(F.in[I_WIN], NIN, F_Wt_in, DM, 64 * kb, 32 * nb, 32 * nb, scr, lane); continue; } r -= IT_IN;
            if (r < IT_OUT) { const int kb = r / (DM / 32), nb = r % (DM / 32); transpose_item(F.in[I_WOUT], DM, F_Wt_out, DM, 64 * kb, 32 * nb, 32 * nb, scr, lane); continue; } r -= IT_OUT;
            if (r < 2 * IT_G) { const int up = r >= IT_G; if (up) r -= IT_G; const int kb = r / (DFF / 32), nb = r % (DFF / 32), n0 = 32 * nb;
                transpose_item(F.in[up ? I_WU : I_WG], DFF, F_Wt_gu, DM, 64 * kb, n0, 256 * (n0 >> 7) + (n0 & 127) + (up ? 128 : 0), scr, lane); continue; } r -= 2 * IT_G;
            if (r < IT_D) { const int kb = r / (DM / 32), nb = r % (DM / 32); transpose_item(F.in[I_WD], DM, F_Wt_dn, DFF, 64 * kb, 32 * nb, 32 * nb, scr, lane); continue; } r -= IT_D;
            { const int mi = r >> 3, sub = r & 7, kb = sub >> 2, nb = sub & 3, d = mi >> 5, kind = (mi >> 4) & 1, n = mi & 15;
              transpose_item(F.in[kind ? I_LWX : I_LWA] + (size_t)(d * 16 + n) * 16384, 128, F_WL + (size_t)((d * 2 + kind) * 16 + n) * 16384, 128, 64 * kb, 32 * nb, 32 * nb, scr, lane); }
        }
    }
    {
        u32x4* p = (u32x4*)(F_Wt_in + (size_t)NIN * DM); const u32x4 z = {0u, 0u, 0u, 0u};
        for (int i = F.vcu * 512 + F.tid; i < (NINP - NIN) * DM / 8; i += F.G * 512) p[i] = z;
    }
}
__device__ __forceinline__ void ph1_modreduce(const Frame& F) {
    const float* ba = F.in[I_BADA];
    for (int i = F.vcu * 512 + F.tid; i < 3 * NADA; i += F.G * 512) { const int r = i / NADA, col = i - r * NADA; float s = ba[col];
#pragma unroll 8
        for (int kc = 0; kc < 32; ++kc) s += F_modp[(size_t)(kc * 3 + r) * NADA + col];
        F_mod[i] = s; }
}
__device__ __forceinline__ void ph2_hrows(const Frame& F) {
    const int gw = F.vcu * 8 + F.wave, NGW = F.G * 8, lane = F.lane;
    const f32x4* g4 = (const f32x4*)F.in[I_GPREMIX];
    for (int row = gw; row < MT; row += NGW) {
        const float* xr = row < ML ? F.in[I_X] + (size_t)row * DM : F.in[I_CTX] + (size_t)(row - ML) * DM;
        const int mr = row < ML ? row / TL : 2;
        const f32x4* sh4 = (const f32x4*)(F_mod + (size_t)mr * NADA); const f32x4* sc4 = sh4 + DM / 4;
        f32x4 v[16]; float ss = 0.f;
#pragma unroll
        for (int j = 0; j < 16; ++j) { v[j] = ((const f32x4*)xr)[lane + 64 * j]; ss += (v[j].x * v[j].x + v[j].y * v[j].y) + (v[j].z * v[j].z + v[j].w * v[j].w); }
        const float rs = rsqrtf(wave_sum(ss) * (1.0f / DM) + EPS);
        u32x2* o = (u32x2*)(F_H + (size_t)row * DM);
#pragma unroll
        for (int j = 0; j < 16; ++j) { const f32x4 g = g4[lane + 64 * j], sh = sh4[lane + 64 * j], sc = sc4[lane + 64 * j];
            const f32x4 y = (v[j] * rs * g) * (sc + 1.0f) + sh; u32x2 w; w.x = pk2(y.x, y.y); w.y = pk2(y.z, y.w); o[lane + 64 * j] = w; }
    }
}

template <int PASS>
__device__ __forceinline__ void lru_pass(const Frame& F) {
    LAS bf16* U = (LAS bf16*)(F.lds);
    LAS float* XC = (LAS float*)(F.lds + 17408);
    LAS bf16* XCB = (LAS bf16*)(F.lds + 17408 + 32768);
    LAS f32x2* SC = (LAS f32x2*)(F.lds + 17408 + 32768 + 17408 + F.wave * 8192);
    const int tid = F.tid, lane = F.lane, w = F.wave, fr = lane & 15, fq = lane >> 4;
    const int n = F.vcu & 15;
    const int cl = 16 * w + fr, cg = n * 128 + cl;
    float ba[2], bx[2], sp[2];
#pragma unroll
    for (int d = 0; d < 2; ++d) { ba[d] = F.in[I_LBA][d * LW + cg]; bx[d] = F.in[I_LBX][d * LW + cg]; sp[d] = softplusf_(-F.in[I_LLAM][d * LW + cg]); }
    const int cc = tid & 127, tg = tid >> 7;
    float cw[4];
#pragma unroll
    for (int j = 0; j < 4; ++j) cw[j] = F.in[I_LCW][j * LW + n * 128 + cc];
    const float cb = F.in[I_LCB][n * 128 + cc];
    for (int q = F.vcu >> 4; q < NBATCH * NCH; q += F.G >> 4) {
        const int b = q / NCH, cidx = q - b * NCH;
        if (PASS == 2 && cidx < 4) continue;
        const bool isctx = cidx < 4; const int t0 = isctx ? cidx * 64 : (cidx - 4) * 64, Tseq = isctx ? TCX : TL;
        const size_t rowbase = isctx ? (size_t)ML + (size_t)b * TCX : (size_t)b * TL;
        __syncthreads();
        for (int rr = tid >> 4; rr < 67; rr += 32) { const int t = t0 - 2 + rr; u32x4 v = {0u, 0u, 0u, 0u};
            if (t >= 0 && t < Tseq) v = *(const u32x4*)(F_LX + (rowbase + t) * LW + n * 128 + (tid & 15) * 8);
            *(LAS u32x4*)(U + rr * 128 + (tid & 15) * 8) = v; }
        u32x4 gt0 = {0u, 0u, 0u, 0u}, gt1 = gt0;
        if (PASS == 2) { gt0 = *(const u32x4*)(F_LG + (rowbase + t0 + (tid >> 4)) * LW + n * 128 + (tid & 15) * 8); gt1 = *(const u32x4*)(F_LG + (rowbase + t0 + 32 + (tid >> 4)) * LW + n * 128 + (tid & 15) * 8); }
        __syncthreads();
        { float x0 = bf2f(U[(tg * 16 + 0) * 128 + cc]), x1 = bf2f(U[(tg * 16 + 1) * 128 + cc]), x2 = bf2f(U[(tg * 16 + 2) * 128 + cc]);
#pragma unroll
          for (int i = 0; i < 16; ++i) { const int tt = tg * 16 + i; const float x3 = bf2f(U[(tt + 3) * 128 + cc]);
              const float y = cb + cw[0] * x0 + cw[1] * x1 + cw[2] * x2 + cw[3] * x3; XC[tt * 128 + cc] = y; XCB[tt * 136 + cc] = (bf16)f2bf(y); x0 = x1; x1 = x2; x2 = x3; } }
        __syncthreads();
        if (PASS == 2) { *(LAS u32x4*)(U + (tid >> 4) * 128 + (tid & 15) * 8) = gt0; *(LAS u32x4*)(U + (32 + (tid >> 4)) * 128 + (tid & 15) * 8) = gt1; }
        float hsum[4][4];
#pragma unroll
        for (int d = 0; d < 2; ++d) {
            bf16x8 bfr[2][4];
#pragma unroll
            for (int mat = 0; mat < 2; ++mat)
#pragma unroll
                for (int ks = 0; ks < 4; ++ks) bfr[mat][ks] = *(const bf16x8*)(F_WL + ((size_t)((2 * d + mat) * 16 + n) * 128 + cl) * 128 + 32 * ks + 8 * fq);
            f32x4 acc[2][4];
#pragma unroll
            for (int mat = 0; mat < 2; ++mat)
#pragma unroll
                for (int mt = 0; mt < 4; ++mt) acc[mat][mt] = (f32x4){0.f, 0.f, 0.f, 0.f};
#pragma unroll
            for (int mt = 0; mt < 4; ++mt)
#pragma unroll
                for (int ks = 0; ks < 4; ++ks) { const bf16x8 af = *(const LAS bf16x8*)(XCB + (16 * mt + fr) * 136 + 32 * ks + 8 * fq);
                    acc[0][mt] = __builtin_amdgcn_mfma_f32_16x16x32_bf16(af, bfr[0][ks], acc[0][mt], 0, 0, 0);
                    acc[1][mt] = __builtin_amdgcn_mfma_f32_16x16x32_bf16(af, bfr[1][ks], acc[1][mt], 0, 0, 0); }
#pragma unroll
            for (int mt = 0; mt < 4; ++mt)
#pragma unroll
                for (int rg = 0; rg < 4; ++rg) { const int tok = 16 * mt + 4 * fq + rg; const float xcv = XC[tok * 128 + cl];
                    const float r = sigmoidf_(acc[0][mt][rg] + ba[d]), ig = sigmoidf_(acc[1][mt][rg] + bx[d]);
                    const float la = -8.0f * r * sp[d]; const float a = __expf(la); const float x2 = 2.0f * la;
                    const float em = -x2 * (1.0f + x2 * (0.5f + x2 * (0.16666667f + x2 * (0.041666668f + x2 * (0.0083333338f + x2 * 0.0013888889f)))));
                    const float bb = sqrtf(em) * (ig * xcv);
                    SC[tok * 16 + fr] = (f32x2){a, bb}; }
            WAVE_LDS_FENCE();
            float P = 1.0f, h = 0.0f;
#pragma unroll
            for (int i = 0; i < 16; ++i) { const int tok = 16 * fq + (d == 0 ? i : 15 - i); const f32x2 ab = SC[tok * 16 + fr]; h = ab.x * h + ab.y; P *= ab.x; SC[tok * 16 + fr] = (f32x2){P, h}; }
            float As[4], Bs[4];
#pragma unroll
            for (int s = 0; s < 4; ++s) { As[s] = __shfl(P, s * 16 + fr); Bs[s] = __shfl(h, s * 16 + fr); }
            const size_t cidx_off = ((size_t)((d * 2 + b) * NCH + cidx)) * LW + cg;
            if (PASS == 1) {
                float At = 1.0f, Bt = 0.0f;
#pragma unroll
                for (int s = 0; s < 4; ++s) { const int sgi = d == 0 ? s : 3 - s; Bt = As[sgi] * Bt + Bs[sgi]; At *= As[sgi]; }
                if (fq == 0) F_CAR[cidx_off] = (f32x2){At, Bt};
            } else {
                float hin = F_HIN[cidx_off];
#pragma unroll
                for (int s = 0; s < 4; ++s) { const int sgi = d == 0 ? s : 3 - s; const bool before = d == 0 ? (sgi < fq) : (sgi > fq); if (before) hin = As[sgi] * hin + Bs[sgi]; }
#pragma unroll
                for (int i = 0; i < 16; ++i) { const int tok = 16 * fq + i; const f32x2 ph = SC[tok * 16 + fr]; SC[tok * 16 + fr] = (f32x2){ph.x, ph.y + ph.x * hin}; }
                WAVE_LDS_FENCE();
#pragma unroll
                for (int mt = 0; mt < 4; ++mt)
#pragma unroll
                    for (int rg = 0; rg < 4; ++rg) { const float hv = SC[(16 * mt + 4 * fq + rg) * 16 + fr].y; hsum[mt][rg] = d == 0 ? hv : hsum[mt][rg] + hv; }
            }
            WAVE_LDS_FENCE();
        }
        if (PASS == 2) {
            __syncthreads();
#pragma unroll
            for (int mt = 0; mt < 4; ++mt)
#pragma unroll
                for (int rg = 0; rg < 4; ++rg) { const int tok = 16 * mt + 4 * fq + rg;
                    const float y = hsum[mt][rg] * gelu_tanhf_(bf2f(U[tok * 128 + cl])); XCB[tok * 136 + cl] = (bf16)f2bf(y); }
            __syncthreads();
#pragma unroll
            for (int hh = 0; hh < 2; ++hh) { const int tok = hh * 32 + (tid >> 4); const u32x4 wv = *(const LAS u32x4*)(XCB + tok * 136 + (tid & 15) * 8);
                const size_t row = rowbase + t0 + tok; *(u32x4*)(F_MIX + row * DM + n * 128 + (tid & 15) * 8) = wv;
                float sq = (bflo(wv.x) * bflo(wv.x) + bfhi(wv.x) * bfhi(wv.x)) + (bflo(wv.y) * bflo(wv.y) + bfhi(wv.y) * bfhi(wv.y)) + (bflo(wv.z) * bflo(wv.z) + bfhi(wv.z) * bfhi(wv.z)) + (bflo(wv.w) * bflo(wv.w) + bfhi(wv.w) * bfhi(wv.w));
                sq += __shfl_xor(sq, 1); sq += __shfl_xor(sq, 2); sq += __shfl_xor(sq, 4); sq += __shfl_xor(sq, 8);
                if ((tid & 15) == 0) F_SSQ[row * 16 + n] = sq; }
        }
    }
}
__device__ __forceinline__ int gdn_row(int b, int s) {
    if (s < TCX) return ML + b * TCX + s;
    const int m = s - TCX; return b * TL + (m & 127) * 64 + (m >> 7);
}
__device__ __forceinline__ void gdn_pre(const Frame& F) {
    const int gw = F.vcu * 8 + F.wave, NGW = F.G * 8, lane = F.lane;
    const float* cw = F.in[I_GCW];
    for (int tok = gw; tok < NBATCH * SEQ_S; tok += NGW) {
        const int b = tok / SEQ_S, s = tok - b * SEQ_S;
        const int lo = s < TCX ? 0 : TCX, hi = s < TCX ? TCX : SEQ_S;
        int rows[4]; bool val[4];
#pragma unroll
        for (int j = 0; j < 4; ++j) { const int sj = s + j - 2; val[j] = sj >= lo && sj < hi; rows[j] = gdn_row(b, val[j] ? sj : s); }
        for (int h = 0; h < NH; ++h) {
            float a[3][2];
#pragma unroll
            for (int p = 0; p < 3; ++p) { a[p][0] = 0.f; a[p][1] = 0.f; }
#pragma unroll
            for (int j = 0; j < 4; ++j) {
#pragma unroll
                for (int p = 0; p < 3; ++p) { const int ch = p * GDW + h * HD + 2 * lane;
                    const unsigned xw = val[j] ? *(const unsigned*)(F_QKV + (size_t)rows[j] * 6144 + ch) : 0u;
                    const f32x2 wv = *(const f32x2*)(cw + (size_t)j * 6144 + ch);
                    a[p][0] += wv.x * bflo(xw); a[p][1] += wv.y * bfhi(xw); } }
#pragma unroll
            for (int p = 0; p < 3; ++p) { a[p][0] = siluf_(a[p][0]); a[p][1] = siluf_(a[p][1]); }
            const float rq = rsqrtf(wave_sum(a[0][0] * a[0][0] + a[0][1] * a[0][1]) + EPS), rk = rsqrtf(wave_sum(a[1][0] * a[1][0] + a[1][1] * a[1][1]) + EPS);
            const unsigned qw = pk2(a[0][0] * rq, a[0][1] * rq), kw = pk2(a[1][0] * rk, a[1][1] * rk), vw = pk2(a[2][0], a[2][1]);
            const float kq = wave_sum(bflo(qw) * bflo(kw) + bfhi(qw) * bfhi(kw));
            const size_t o = ((size_t)b * SEQ_S + s) * GDW + h * HD + 2 * lane;
            *(unsigned*)(F_QN + o) = qw; *(unsigned*)(F_KN + o) = kw; *(unsigned*)(F_VN + o) = vw;
            if (lane == 0) F_KQ[(size_t)(b * NH + h) * SEQ_S + s] = kq;
        }
        if (lane < 32) { const int d = lane >> 4, h = lane & 15; const bf16* bar = F_BA + (size_t)rows[2] * 256;
            const float pb = bf2f(bar[d * 16 + h]), pa = bf2f(bar[32 + d * 16 + h]);
            const float beta = sigmoidf_(pb), g = -__expf(F.in[I_GALOG][d * 16 + h]) * softplusf_(pa + F.in[I_GDT][d * 16 + h]);
            F_GB[(size_t)((d * 2 + b) * NH + h) * SEQ_S + s] = (f32x2){g, beta}; }
    }
}
__device__ __forceinline__ void lru_chains(const Frame& F) {
    if (F.tid < 32) {
        for (int chain = F.vcu * 32 + F.tid; chain < 2 * NBATCH * LW; chain += F.G * 32) {
            const int cg = chain & (LW - 1), b = (chain >> 11) & 1, d = chain >> 12;
            float h = 0.f;
#pragma unroll 4
            for (int step = 0; step < NCH; ++step) { const int cidx = d == 0 ? step : (step < 4 ? 3 - step : NCH - 1 - (step - 4));
                const size_t idx = ((size_t)((d * 2 + b) * NCH + cidx)) * LW + cg; const f32x2 ab = F_CAR[idx]; F_HIN[idx] = h; h = ab.x * h + ab.y; }
        }
    }
}
__device__ __forceinline__ int gdn_spos(int d, int step) { return d == 0 ? step : (step < TCX ? TCX - 1 - step : SEQ_S - 1 - (step - TCX)); }
__device__ __forceinline__ void gdn_seq(const Frame& F, int item) {
    const int sl = item & 3, d = (item >> 2) & 1, h = (item >> 3) & 15, b = item >> 7;
    LAS float* Kst = (LAS float*)F.lds;
    LAS float* Qst = Kst + 2048;
    LAS float* Vst = Qst + 2048;
    LAS float* Gst = Vst + 512;
    LAS f32x2* RED = (LAS f32x2*)(Gst + 64);
    const int tid = F.tid, v = tid & 31, kg = tid >> 5;
    float S[8];
#pragma unroll
    for (int i = 0; i < 8; ++i) S[i] = 0.f;
    const bf16* Kb = F_KN + (size_t)b * SEQ_S * GDW + h * HD + (tid & 31) * 4;
    const bf16* Qb = F_QN + (size_t)b * SEQ_S * GDW + h * HD + (tid & 31) * 4;
    const bf16* Vb = F_VN + (size_t)b * SEQ_S * GDW + h * HD + sl * 32 + (tid & 31);
    const f32x2* GBp = F_GB + (size_t)((d * 2 + b) * NH + h) * SEQ_S; const float* KQp = F_KQ + (size_t)(b * NH + h) * SEQ_S;
    float* Ob = F_O + (size_t)d * ML * GDW + h * HD + sl * 32 + v;
    u32x2 pk, pq; unsigned pv; f32x2 pgb = {0.f, 0.f}; float pkq = 0.f;
#define GDN_LOADG(g0) do { const int s_ = gdn_spos(d, (g0) + (tid >> 5)); pk = *(const u32x2*)(Kb + (size_t)s_ * GDW); pq = *(const u32x2*)(Qb + (size_t)s_ * GDW); pv = Vb[(size_t)s_ * GDW]; \
        if (tid < 16) { const int s2_ = gdn_spos(d, (g0) + tid); pgb = GBp[s2_]; pkq = KQp[s2_]; } } while (0)
    GDN_LOADG(0);
    for (int g0 = 0; g0 < SEQ_S; g0 += 16) {
        *(LAS f32x4*)(Kst + (tid >> 5) * 128 + (tid & 31) * 4) = (f32x4){bflo(pk.x), bfhi(pk.x), bflo(pk.y), bfhi(pk.y)};
        *(LAS f32x4*)(Qst + (tid >> 5) * 128 + (tid & 31) * 4) = (f32x4){bflo(pq.x), bfhi(pq.x), bflo(pq.y), bfhi(pq.y)};
        Vst[(tid >> 5) * 32 + (tid & 31)] = bf2f(pv);
        if (tid < 16) { Gst[tid] = __expf(pgb.x); Gst[16 + tid] = pgb.y; Gst[32 + tid] = pkq; }
        if (g0 + 16 < SEQ_S) GDN_LOADG(g0 + 16);
        __syncthreads();
#pragma unroll 2
        for (int j = 0; j < 16; ++j) {
            const f32x4 k0 = *(const LAS f32x4*)(Kst + j * 128 + kg * 8), k1 = *(const LAS f32x4*)(Kst + j * 128 + kg * 8 + 4);
            const f32x4 q0 = *(const LAS f32x4*)(Qst + j * 128 + kg * 8), q1 = *(const LAS f32x4*)(Qst + j * 128 + kg * 8 + 4);
            const float kk[8] = {k0.x, k0.y, k0.z, k0.w, k1.x, k1.y, k1.z, k1.w}, qq[8] = {q0.x, q0.y, q0.z, q0.w, q1.x, q1.y, q1.z, q1.w};
            const float vv = Vst[j * 32 + v], eg = Gst[j], be = Gst[16 + j], kq = Gst[32 + j];
            float pkk = 0.f, pqq = 0.f;
#pragma unroll
            for (int i = 0; i < 8; ++i) { S[i] *= eg; pkk += kk[i] * S[i]; pqq += qq[i] * S[i]; }
            RED[(j & 1) * 512 + kg * 32 + v] = (f32x2){pkk, pqq};
            __syncthreads();
            float ks = 0.f, qs = 0.f;
#pragma unroll
            for (int g = 0; g < 16; ++g) { const f32x2 r = RED[(j & 1) * 512 + g * 32 + v]; ks += r.x; qs += r.y; }
            const float delta = be * (vv - ks);
#pragma unroll
            for (int i = 0; i < 8; ++i) S[i] += kk[i] * delta;
            if (kg == 0) { const int s = gdn_spos(d, g0 + j); if (s >= TCX) Ob[(size_t)gdn_row(b, s) * GDW] = (qs + delta * kq) * 0.08838834764831845f; }
        }
    }
#undef GDN_LOADG
    __syncthreads();
}
__device__ __forceinline__ void gdn_combine(const Frame& F) {
    const int gw = F.vcu * 8 + F.wave, NGW = F.G * 8, lane = F.lane;
    const f32x2 gn = *(const f32x2*)(F.in[I_GNG] + 2 * lane);
    for (int row = gw; row < ML; row += NGW) {
#pragma unroll 4
        for (int h = 0; h < NH; ++h) { const size_t o = (size_t)row * GDW + h * HD + 2 * lane;
            const f32x2 a = *(const f32x2*)(F_O + o), c = *(const f32x2*)(F_O + (size_t)ML * GDW + o); const float o0 = a.x + c.x, o1 = a.y + c.y;
            const float rs = rsqrtf(wave_sum(o0 * o0 + o1 * o1) * (1.0f / HD) + EPS);
            const unsigned zw = *(const unsigned*)(F_Z + o);
            *(unsigned*)(F_MIX + (size_t)row * DM + LW + h * HD + 2 * lane) = pk2(o0 * rs * gn.x * siluf_(bflo(zw)), o1 * rs * gn.y * siluf_(bfhi(zw))); }
    }
}
__device__ __forceinline__ void lru_normalize(const Frame& F) {
    const int gw = F.vcu * 8 + F.wave, NGW = F.G * 8, lane = F.lane;
    for (int row = gw; row < ML; row += NGW) {
        const float p = lane < 16 ? F_SSQ[(size_t)row * 16 + lane] : 0.f;
        const float rs = rsqrtf(wave_sum(p) * (1.0f / LW) + EPS);
#pragma unroll
        for (int j = 0; j < 4; ++j) { const int c0 = (lane + 64 * j) * 8; u32x4* p4 = (u32x4*)(F_MIX + (size_t)row * DM + c0); const u32x4 w = *p4;
            const f32x4 g0 = *(const f32x4*)(F.in[I_LNG] + c0), g1 = *(const f32x4*)(F.in[I_LNG] + c0 + 4);
            u32x4 o; o.x = pk2(bflo(w.x) * rs * g0.x, bfhi(w.x) * rs * g0.y); o.y = pk2(bflo(w.y) * rs * g0.z, bfhi(w.y) * rs * g0.w);
            o.z = pk2(bflo(w.z) * rs * g1.x, bfhi(w.z) * rs * g1.y); o.w = pk2(bflo(w.w) * rs * g1.z, bfhi(w.w) * rs * g1.w); *p4 = o; }
    }
}
__device__ __forceinline__ void ph_x1(const Frame& F) {
    const int gw = F.vcu * 8 + F.wave, NGW = F.G * 8, lane = F.lane;
    const f32x4* gpm = (const f32x4*)F.in[I_GPOSTMIX]; const f32x4* gpf = (const f32x4*)F.in[I_GPREFFN];
    for (int row = gw; row < ML; row += NGW) {
        const f32x4* md = (const f32x4*)(F_mod + (size_t)(row / TL) * NADA);
        const f32x4* yr = (const f32x4*)(F_Y1 + (size_t)row * DM); const f32x4* xr = (const f32x4*)(F.in[I_X] + (size_t)row * DM); f32x4* outr = (f32x4*)(F.out + (size_t)row * DM);
        f32x4 y[16]; float ss = 0.f;
#pragma unroll
        for (int j = 0; j < 16; ++j) { y[j] = yr[lane + 64 * j]; ss += (y[j].x * y[j].x + y[j].y * y[j].y) + (y[j].z * y[j].z + y[j].w * y[j].w); }
        const float rs = rsqrtf(wave_sum(ss) * (1.0f / DM) + EPS); float s2 = 0.f;
#pragma unroll
        for (int j = 0; j < 16; ++j) { const f32x4 x1 = xr[lane + 64 * j] + md[2 * (DM / 4) + lane + 64 * j] * (y[j] * rs * gpm[lane + 64 * j]);
            outr[lane + 64 * j] = x1; y[j] = x1; s2 += (x1.x * x1.x + x1.y * x1.y) + (x1.z * x1.z + x1.w * x1.w); }
        const float r2 = rsqrtf(wave_sum(s2) * (1.0f / DM) + EPS);
        u32x2* o = (u32x2*)(F_H2 + (size_t)row * DM);
#pragma unroll
        for (int j = 0; j < 16; ++j) { const f32x4 hv = (y[j] * r2 * gpf[lane + 64 * j]) * (md[4 * (DM / 4) + lane + 64 * j] + 1.0f) + md[3 * (DM / 4) + lane + 64 * j];
            u32x2 w; w.x = pk2(hv.x, hv.y); w.y = pk2(hv.z, hv.w); o[lane + 64 * j] = w; }
    }
}
__device__ __forceinline__ void ph_final(const Frame& F) {
    const int gw = F.vcu * 8 + F.wave, NGW = F.G * 8, lane = F.lane;
    const f32x4* gpf = (const f32x4*)F.in[I_GPOSTFFN];
    for (int row = gw; row < ML; row += NGW) {
        const f32x4* md = (const f32x4*)(F_mod + (size_t)(row / TL) * NADA);
        const f32x4* yr = (const f32x4*)(F_Y2 + (size_t)row * DM); f32x4* outr = (f32x4*)(F.out + (size_t)row * DM);
        f32x4 y[16]; float ss = 0.f;
#pragma unroll
        for (int j = 0; j < 16; ++j) { y[j] = yr[lane + 64 * j]; ss += (y[j].x * y[j].x + y[j].y * y[j].y) + (y[j].z * y[j].z + y[j].w * y[j].w); }
        const float rs = rsqrtf(wave_sum(ss) * (1.0f / DM) + EPS);
#pragma unroll
        for (int j = 0; j < 16; ++j) outr[lane + 64 * j] = outr[lane + 64 * j] + md[5 * (DM / 4) + lane + 64 * j] * (y[j] * rs * gpf[lane + 64 * j]);
    }
}
__device__ __forceinline__ size_t gdn_item(int b, int h, int c, int d) { return ((size_t)((b * NH + h) * NCH + c)) * 2 + d; }
__device__ __forceinline__ void gdn_chunk_pre(const Frame& F) {
    LAS bf16* Kt_ = (LAS bf16*)(F.lds);
    LAS bf16* Qt_ = (LAS bf16*)(F.lds + 17408);
    LAS bf16* Vt_ = (LAS bf16*)(F.lds + 34816);
    LAS float* L_ = (LAS float*)(F.lds + 52224);
    LAS float* GC_ = (LAS float*)(F.lds + 84992);
    LAS float* BE_ = GC_ + 128;
    LAS float* BEG_ = GC_ + 256;
    LAS bf16* XW_ = (LAS bf16*)(F.lds + 86528);
    const int tid = F.tid, lane = F.lane, w = F.wave, fr = lane & 15, fq = lane >> 4;
    for (int it = F.vcu; it < NBATCH * NH * NCH; it += F.G) {
        const int c = it % NCH, bh = it / NCH, h = bh % NH, b = bh / NH;
        const size_t item0 = gdn_item(b, h, c, 0);
        __syncthreads();
        { const size_t gbase = ((size_t)b * SEQ_S + (size_t)c * 64) * GDW + h * HD;
#pragma unroll
          for (int r = 0; r < 2; ++r) { const int pc = tid + 512 * r, row = pc >> 4, cc = (pc & 15) * 8; const size_t g = gbase + (size_t)row * GDW + cc;
              *(LAS u32x4*)(Kt_ + row * 136 + cc) = *(const u32x4*)(F_KN + g); *(LAS u32x4*)(Qt_ + row * 136 + cc) = *(const u32x4*)(F_QN + g); *(LAS u32x4*)(Vt_ + row * 136 + cc) = *(const u32x4*)(F_VN + g); }
          if (tid < 128) { const int d = tid >> 6, p = tid & 63, i = d ? 63 - p : p;
              const f32x2 gb = F_GB[(size_t)((d * 2 + b) * NH + h) * SEQ_S + c * 64 + i];
              float gc = gb.x;
#pragma unroll
              for (int o = 1; o < 64; o <<= 1) { const float t = __shfl_up(gc, o); if (lane >= o) gc += t; }
              GC_[d * 64 + p] = gc; BE_[d * 64 + p] = gb.y; BEG_[d * 64 + p] = gb.y * __expf(gc);
              F_GSC[(item0 + d) * 128 + p] = 0.08838834764831845f * __expf(gc);
              if (p == 63) F_GSC[(item0 + d) * 128 + 64] = __expf(gc); } }
        __syncthreads();
        { const int mt = w >> 1; LAS bf16* IN_ = XW_;
          bf16x8 kA[4], qA[4];
#pragma unroll
          for (int ks = 0; ks < 4; ++ks) { kA[ks] = *(const LAS bf16x8*)(Kt_ + (16 * mt + fr) * 136 + 32 * ks + 8 * fq); qA[ks] = *(const LAS bf16x8*)(Qt_ + (16 * mt + fr) * 136 + 32 * ks + 8 * fq); }
#pragma unroll
          for (int t2 = 0; t2 < 2; ++t2) { const int nt = 2 * (w & 1) + t2;
              f32x4 aK = {0.f, 0.f, 0.f, 0.f}, aQ = aK;
#pragma unroll
              for (int ks = 0; ks < 4; ++ks) { const bf16x8 kB = *(const LAS bf16x8*)(Kt_ + (16 * nt + fr) * 136 + 32 * ks + 8 * fq);
                  aK = __builtin_amdgcn_mfma_f32_16x16x32_bf16(kA[ks], kB, aK, 0, 0, 0); aQ = __builtin_amdgcn_mfma_f32_16x16x32_bf16(qA[ks], kB, aQ, 0, 0, 0); }
              const int j = 16 * nt + fr, q1 = 63 - j; const float g0j = GC_[j], g1q = GC_[64 + q1];
#pragma unroll
              for (int rg = 0; rg < 4; ++rg) { const int i = 16 * mt + 4 * fq + rg, p1 = 63 - i;
                  const float e0 = i >= j ? __expf(GC_[i] - g0j) : 0.f, e1 = i <= j ? __expf(GC_[64 + p1] - g1q) : 0.f;
                  if (i > j) L_[i * 64 + j] = BE_[i] * aK[rg] * e0;
                  if (i < j) L_[4096 + p1 * 64 + q1] = BE_[64 + p1] * aK[rg] * e1;
                  const float y = aQ[rg] * 0.08838834764831845f;
                  IN_[i * 72 + j] = (bf16)f2bf(y * e0); IN_[64 * 72 + p1 * 72 + q1] = (bf16)f2bf(y * e1); } }
        }
        __syncthreads();
        { LAS bf16* IN_ = XW_;
#pragma unroll
          for (int r = 0; r < 2; ++r) { const int pc = tid + 512 * r, d = pc >> 9, row = (pc >> 3) & 63, cc = (pc & 7) * 8;
              *(u32x4*)(F_INTRA + (item0 + d) * 4096 + row * 64 + cc) = *(const LAS u32x4*)(IN_ + d * 64 * 72 + row * 72 + cc); } }
        { const int d = w >> 2, isw = (w >> 1) & 1, col = 64 * (w & 1) + lane;
          const LAS float* Ld = L_ + d * 4096; const LAS float* cf = (isw ? BEG_ : BE_) + d * 64; const LAS bf16* Tt = isw ? Kt_ : Vt_;
          float x[64];
#pragma unroll
          for (int p = 0; p < 64; ++p) { const int i = d ? 63 - p : p;
              float a0 = cf[p] * bf2f(Tt[i * 136 + col]), a1 = 0.f, a2 = 0.f, a3 = 0.f;
#pragma unroll
              for (int q4 = 0; q4 < p / 4; ++q4) { const f32x4 l = *(const LAS f32x4*)(Ld + p * 64 + 4 * q4); a0 -= l.x * x[4 * q4]; a1 -= l.y * x[4 * q4 + 1]; a2 -= l.z * x[4 * q4 + 2]; a3 -= l.w * x[4 * q4 + 3]; }
#pragma unroll
              for (int q = (p / 4) * 4; q < p; ++q) a0 -= Ld[p * 64 + q] * x[q];
              x[p] = (a0 + a1) + (a2 + a3); }
          __syncthreads();
          if (!isw) {
              u32x4* up = (u32x4*)(F_UT + (item0 + d) * 8192 + (size_t)col * 64); u32x4* kp = (u32x4*)(F_KT + (item0 + d) * 8192 + (size_t)col * 64);
              const float glast = GC_[d * 64 + 63];
#pragma unroll
              for (int p8 = 0; p8 < 8; ++p8) { u32x4 o; o.x = pk2(x[8 * p8], x[8 * p8 + 1]); o.y = pk2(x[8 * p8 + 2], x[8 * p8 + 3]); o.z = pk2(x[8 * p8 + 4], x[8 * p8 + 5]); o.w = pk2(x[8 * p8 + 6], x[8 * p8 + 7]); up[p8] = o;
                  float kt[8];
#pragma unroll
                  for (int e = 0; e < 8; ++e) { const int p = 8 * p8 + e, i = d ? 63 - p : p; kt[e] = bf2f(Kt_[i * 136 + col]) * __expf(glast - GC_[d * 64 + p]); }
                  u32x4 k4; k4.x = pk2(kt[0], kt[1]); k4.y = pk2(kt[2], kt[3]); k4.z = pk2(kt[4], kt[5]); k4.w = pk2(kt[6], kt[7]); kp[p8] = k4; }
          } else {
#pragma unroll
              for (int p = 0; p < 64; ++p) XW_[d * 64 * 136 + p * 136 + col] = (bf16)f2bf(x[p]);
          }
        }
        __syncthreads();
#pragma unroll
        for (int r = 0; r < 4; ++r) { const int pc = tid + 512 * r, d = pc >> 10, row = (pc >> 4) & 63, cc = (pc & 15) * 8;
            *(u32x4*)(F_W + (item0 + d) * 8192 + row * 128 + cc) = *(const LAS u32x4*)(XW_ + d * 64 * 136 + row * 136 + cc); }
    }
}
__device__ __forceinline__ void gdn_seq_chunked(const Frame& F, int item) {
    const int sl = item & 3, d = (item >> 2) & 1, h = (item >> 3) & 15, b = item >> 7;
    LAS bf16* St = (LAS bf16*)(F.lds);
    LAS bf16* Vt = (LAS bf16*)(F.lds + 8704);
    const int tid = F.tid, lane = F.lane, w = F.wave, fr = lane & 15, fq = lane >> 4;
    const int mt = w & 3, nt = w >> 2;
    for (int e = tid; e < 32 * 136 / 2; e += 512) ((LAS unsigned*)St)[e] = 0u;
    f32x4 S0 = {0.f, 0.f, 0.f, 0.f}, S1 = S0;
    const bf16* Qb = F_QN + (size_t)b * SEQ_S * GDW + h * HD + 8 * fq;
    float* Ob = F_O + (size_t)d * ML * GDW + h * HD + sl * 32 + 16 * nt + fr;
    bf16x8 wf[4], qf[4], inf[2], ktf[2]; u32x2 utv; f32x4 sqv; float gl;
#define GDN_LOADC(step) do { const int c_ = d == 0 ? (step) : ((step) < 4 ? 3 - (step) : NCH - 1 - ((step) - 4)); const size_t it_ = gdn_item(b, h, c_, d); \
        const int prow_ = 16 * mt + fr, irow_ = d ? 63 - prow_ : prow_; \
        _Pragma("unroll") for (int ks = 0; ks < 4; ++ks) { wf[ks] = *(const bf16x8*)(F_W + it_ * 8192 + prow_ * 128 + 32 * ks + 8 * fq); qf[ks] = *(const bf16x8*)(Qb + (size_t)(c_ * 64 + irow_) * GDW + 32 * ks); } \
        _Pragma("unroll") for (int ks = 0; ks < 2; ++ks) { inf[ks] = *(const bf16x8*)(F_INTRA + it_ * 4096 + prow_ * 64 + 32 * ks + 8 * fq); ktf[ks] = *(const bf16x8*)(F_KT + it_ * 8192 + (16 * w + fr) * 64 + 32 * ks + 8 * fq); } \
        utv = *(const u32x2*)(F_UT + it_ * 8192 + (size_t)(32 * sl + 16 * nt + fr) * 64 + 16 * mt + 4 * fq); sqv = *(const f32x4*)(F_GSC + it_ * 128 + 16 * mt + 4 * fq); gl = F_GSC[it_ * 128 + 64]; } while (0)
    GDN_LOADC(0);
    __syncthreads();
    for (int step = 0; step < NCH; ++step) {
        const int c = d == 0 ? step : (step < 4 ? 3 - step : NCH - 1 - (step - 4));
        bf16x8 cw[4], cq[4], ci[2], ck[2]; const u32x2 cu = utv; const f32x4 csq = sqv; const float cgl = gl;
#pragma unroll
        for (int ks = 0; ks < 4; ++ks) { cw[ks] = wf[ks]; cq[ks] = qf[ks]; }
#pragma unroll
        for (int ks = 0; ks < 2; ++ks) { ci[ks] = inf[ks]; ck[ks] = ktf[ks]; }
        if (step + 1 < NCH) GDN_LOADC(step + 1);
        f32x4 aW = {0.f, 0.f, 0.f, 0.f}, aQ = aW;
#pragma unroll
        for (int ks = 0; ks < 4; ++ks) { const bf16x8 bS = *(const LAS bf16x8*)(St + (16 * nt + fr) * 136 + 32 * ks + 8 * fq);
            aW = __builtin_amdgcn_mfma_f32_16x16x32_bf16(cw[ks], bS, aW, 0, 0, 0); aQ = __builtin_amdgcn_mfma_f32_16x16x32_bf16(cq[ks], bS, aQ, 0, 0, 0); }
        { const float v0 = bflo(cu.x) - aW[0], v1 = bfhi(cu.x) - aW[1], v2 = bflo(cu.y) - aW[2], v3 = bfhi(cu.y) - aW[3];
          u32x2 vn; vn.x = pk2(v0, v1); vn.y = pk2(v2, v3); *(LAS u32x2*)(Vt + (16 * nt + fr) * 72 + 16 * mt + 4 * fq) = vn; }
        f32x4 o = aQ * csq;
        __syncthreads();
        { const bf16x8 b0 = *(const LAS bf16x8*)(Vt + (16 * nt + fr) * 72 + 8 * fq), b1 = *(const LAS bf16x8*)(Vt + (16 * nt + fr) * 72 + 32 + 8 * fq);
          o = __builtin_amdgcn_mfma_f32_16x16x32_bf16(ci[0], b0, o, 0, 0, 0); o = __builtin_amdgcn_mfma_f32_16x16x32_bf16(ci[1], b1, o, 0, 0, 0); }
        { const bf16x8 b00 = *(const LAS bf16x8*)(Vt + fr * 72 + 8 * fq), b01 = *(const LAS bf16x8*)(Vt + fr * 72 + 32 + 8 * fq);
          const bf16x8 b10 = *(const LAS bf16x8*)(Vt + (16 + fr) * 72 + 8 * fq), b11 = *(const LAS bf16x8*)(Vt + (16 + fr) * 72 + 32 + 8 * fq);
          S0 = S0 * cgl; S1 = S1 * cgl;
          S0 = __builtin_amdgcn_mfma_f32_16x16x32_bf16(ck[0], b00, S0, 0, 0, 0); S0 = __builtin_amdgcn_mfma_f32_16x16x32_bf16(ck[1], b01, S0, 0, 0, 0);
          S1 = __builtin_amdgcn_mfma_f32_16x16x32_bf16(ck[0], b10, S1, 0, 0, 0); S1 = __builtin_amdgcn_mfma_f32_16x16x32_bf16(ck[1], b11, S1, 0, 0, 0);
          u32x2 s0; s0.x = pk2(S0[0], S0[1]); s0.y = pk2(S0[2], S0[3]); *(LAS u32x2*)(St + fr * 136 + 16 * w + 4 * fq) = s0;
          u32x2 s1; s1.x = pk2(S1[0], S1[1]); s1.y = pk2(S1[2], S1[3]); *(LAS u32x2*)(St + (16 + fr) * 136 + 16 * w + 4 * fq) = s1; }
        if (c >= 4) {
#pragma unroll
            for (int rg = 0; rg < 4; ++rg) { const int p = 16 * mt + 4 * fq + rg, i = d ? 63 - p : p; Ob[(size_t)gdn_row(b, c * 64 + i) * GDW] = o[rg]; } }
        __syncthreads();
    }
#undef GDN_LOADC
}
#ifndef MK_N_LAUNCHES
#define MK_N_LAUNCHES 1
#endif
constexpr int N_PHASES = 14;
__global__ void __launch_bounds__(512, 2) fwd(Args args) {
    extern __shared__ __attribute__((aligned(16))) unsigned char lds[];
    Frame F;
    F.lds = (LAS unsigned char*)lds;
    F.tid = threadIdx.x; F.lane = F.tid & 63; F.wave = __builtin_amdgcn_readfirstlane(F.tid >> 6);
    F.G = gridDim.x; { const int bx = blockIdx.x; F.vcu = (F.G % 8 == 0) ? (bx % 8) * (F.G / 8) + bx / 8 : bx; }
    F.in = args.in; F.out = args.out; F.ws = args.ws;
    unsigned char* ws = args.ws;
    volatile LAS unsigned* MISC = (volatile LAS unsigned*)(F.lds + MISC_OFF);
    if (F.tid < 64) MISC[F.tid] = 0u;
    __syncthreads();
    const int lo = args.ph_lo, hi = args.ph_hi;
    XcdBarrier bar; bar.bar = (unsigned*)(ws + WS_CTL) + CW_BAR; bar.x = 0; bar.st = nullptr;
    if (hi - lo > 1) bar = xcd_barrier_post((unsigned*)(ws + WS_CTL) + CW_BAR, MISC + 8);
#ifndef PH_MASK
#define PH_MASK 0x3fff
#endif
#define IN(k) (((PH_MASK >> (k)) & 1) && lo <= (k) && (k) < hi)
#define SEAM(k) do { if (IN(k) && IN((k) + 1)) xcd_barrier(bar); } while (0)
    if (IN(0)) { ph0_prologue(F); } SEAM(0);
    if (IN(1)) { ph1_modreduce(F); } SEAM(1);
    if (IN(2)) { ph2_hrows(F); } SEAM(2);
    if (IN(3)) { pg8::Gemm g{F_H, F_Wt_in, MT, NINP, DM}; pg8::StaticOrder S; S.init(MT, NINP, F.G, (int)blockIdx.x);
        pg8::EpiProj E{F_LX, F_LG, F_QKV, F_Z, F_BA};
        pg8::gemm_phase<pg8::EpiProj, pg8::StaticOrder, true, true>(F.lds, g, S, E); } SEAM(3);
    if (IN(4)) { lru_pass<1>(F); gdn_pre(F); } SEAM(4);
    if (IN(5)) { lru_chains(F); gdn_chunk_pre(F); } SEAM(5);
    if (IN(6)) { for (int item = F.vcu; item < 256; item += F.G) gdn_seq_chunked(F, item); } SEAM(6);
    if (IN(7)) { lru_pass<2>(F); gdn_combine(F); } SEAM(7);
    if (IN(8)) { lru_normalize(F); } SEAM(8);
    if (IN(9)) { pg8::Gemm g{F_MIX, F_Wt_out, ML, DM, DM}; pg8::StaticOrder S; S.init(ML, DM, F.G, (int)blockIdx.x);
        pg8::EpiF32 E{F_Y1, DM};
        pg8::gemm_phase<pg8::EpiF32, pg8::StaticOrder, true, true>(F.lds, g, S, E); } SEAM(9);
    if (IN(10)) { ph_x1(F); } SEAM(10);
    if (IN(11)) { pg8::Gemm g{F_H2, F_Wt_gu, ML, 2 * DFF, DM}; pg8::StaticOrder S; S.init(ML, 2 * DFF, F.G, (int)blockIdx.x);
        pg8::EpiSwiGLU E{F_ACT, DFF};
        pg8::gemm_phase<pg8::EpiSwiGLU, pg8::StaticOrder, true, true>(F.lds, g, S, E); } SEAM(11);
    if (IN(12)) { pg8::Gemm g{F_ACT, F_Wt_dn, ML, DM, DFF}; pg8::StaticOrder S; S.init(ML, DM, F.G, (int)blockIdx.x);
        pg8::EpiF32 E{F_Y2, DM};
        pg8::gemm_phase<pg8::EpiF32, pg8::StaticOrder, true, true>(F.lds, g, S, E); } SEAM(12);
    if (IN(13)) { ph_final(F); }
#undef IN
#undef SEAM
}

extern "C" void kernel_launch(void* const* d_in, const int* in_sizes, int n_in, void* d_out, int out_size, void* d_ws, size_t ws_size, hipStream_t stream) {
    static int grid = 0;
    if (grid == 0) {
        if (n_in != N_INPUTS || in_sizes[0] != ML * DM || out_size != ML * DM || ws_size < WS_END) { fprintf(stderr, "kernel_launch: unexpected problem shape (n_in %d, in0 %d, out %d, ws %zu): nothing launched\n", n_in, n_in > 0 ? in_sizes[0] : -1, out_size, ws_size); grid = -1; return; }
        int dev = 0, cus = 0;
        if (hipGetDevice(&dev) != hipSuccess || hipDeviceGetAttribute(&cus, hipDeviceAttributeMultiprocessorCount, dev) != hipSuccess) { grid = -1; return; }
        if (hipFuncSetAttribute((const void*)fwd, hipFuncAttributeMaxDynamicSharedMemorySize, LDS_BYTES) != hipSuccess) { fprintf(stderr, "kernel_launch: hipFuncSetAttribute failed\n"); grid = -1; return; }
        (void)hipGetLastError();
        grid = cus >= 256 ? 256 : (cus / 16) * 16;
        if (grid < 16) { grid = -1; return; }
    }
    if (grid < 0) return;
    (void)hipMemsetAsync((char*)d_ws + WS_CTL, 0, CTL_ZERO_BYTES, stream);
    Args a{};
    for (int i = 0; i < N_INPUTS; ++i) a.in[i] = (const float*)d_in[i];
    a.out = (float*)d_out; a.ws = (unsigned char*)d_ws;
#if MK_N_LAUNCHES == 1
    a.ph_lo = 0; a.ph_hi = N_PHASES;
    hipLaunchKernelGGL(fwd, dim3(grid), dim3(512), LDS_BYTES, stream, a);
#else
#ifndef PROBE_REPEAT_MASK
#define PROBE_REPEAT_MASK 0
#endif
    for (int p = 0; p < N_PHASES; ++p) { a.ph_lo = p; a.ph_hi = p + 1; hipLaunchKernelGGL(fwd, dim3(grid), dim3(512), LDS_BYTES, stream, a);
        if ((PROBE_REPEAT_MASK >> p) & 1) hipLaunchKernelGGL(fwd, dim3(grid), dim3(512), LDS_BYTES, stream, a); }
#endif
}
```

```cpp
#include <hip/hip_runtime.h>
#include <cstdio>
#include <cstdint>
namespace pg8 {
#define PG8_LAS __attribute__((address_space(3)))
typedef unsigned short bf16_t;
typedef short bf16x8 __attribute__((ext_vector_type(8)));
typedef float f32x4 __attribute__((ext_vector_type(4)));
typedef unsigned u32x4 __attribute__((ext_vector_type(4)));
constexpr int BM = 256, BK = 64, HALF = 128, HTB = HALF * BK * 2  , STAGE_BYTES = 8 * HTB, NXCD = 8, WGM = 8;

__host__ __device__ __forceinline__ int lds_byte(int r, int c) { const int st = (r >> 4) * 2 + (c >> 5), rr = r & 15, cc = c & 31, ob = rr * 64 + cc * 2; return st * 1024 + (ob ^ (((ob >> 9) & 1) << 5)); }
__host__ __device__ __forceinline__ void stage_rc(int b, int& R, int& C) { const int st = b / 1024, sb = b % 1024, swz = sb ^ (((sb >> 9) & 1) << 5); R = (st >> 1) * 16 + swz / 64; C = (st & 1) * 32 + (swz % 64) / 2; }
__host__ __device__ __forceinline__ int perm32(int rho) { const int n = rho >> 4, i = rho & 15; return 8 * (i >> 2) + 4 * n + (i & 3); }

struct Unit { int pm, pn; };
struct Gemm { const bf16_t* A; const bf16_t* Bt; int M, N, K; };

struct StaticOrder {
    int nM, nN, nwg, G, c;
    __host__ __device__ void init(int M, int N, int G_, int c_) { nM = M / BM; nN = N / BM; nwg = nM * nN; G = G_; c = c_; }
    __host__ __device__ bool next(int i, Unit& u) const {
        const long L = (long)i * G + c; if (L >= nwg) return false;
        int wgid = (int)L; { const int q = nwg / NXCD, r = nwg % NXCD, xcd = wgid % NXCD, off = wgid / NXCD; wgid = (xcd < r ? xcd * (q + 1) : r * (q + 1) + (xcd - r) * q) + off; }
        const int nig = WGM * nN, gid = wgid / nig, fm = gid * WGM, gsz = (nM - fm) < WGM ? (nM - fm) : WGM;
        u.pm = fm + ((wgid % nig) % gsz); u.pn = (wgid % nig) / gsz; return true;
    }
    __device__ __forceinline__ void a_ready(const Unit&) const {}
    __device__ __forceinline__ void done(const Unit&) const {}
};
__device__ __forceinline__ unsigned cvt_pk_bf16(float lo, float hi) { unsigned r; asm volatile("v_cvt_pk_bf16_f32 %0, %1, %2" : "=v"(r) : "v"(lo), "v"(hi)); return r; }
struct EpiF32 {
    static constexpr bool PERM = false, AFTER_DRAIN = false;
    float* C; int ldc;
    __device__ __forceinline__ void operator()(const f32x4 (&acc)[2][2][4][2], const Unit& u, int wr, int wc, int fr, int fq) const {
        const int row0 = u.pm * BM + wr * 64 + fr, col0 = u.pn * BM + wc * 32 + 4 * fq;
#pragma unroll
        for (int ai = 0; ai < 2; ++ai)
#pragma unroll
            for (int m = 0; m < 4; ++m) { float* rowp = C + (size_t)(row0 + ai * HALF + m * 16) * ldc + col0;
#pragma unroll
                for (int bj = 0; bj < 2; ++bj)
#pragma unroll
                    for (int n = 0; n < 2; ++n) *(f32x4*)(rowp + bj * HALF + n * 16) = acc[ai][bj][m][n]; }
    }
};
struct EpiProj {
    static constexpr bool PERM = true, AFTER_DRAIN = false;
    bf16_t *lx, *lg, *qkv, *z, *ba;
    __device__ __forceinline__ void operator()(const f32x4 (&acc)[2][2][4][2], const Unit& u, int wr, int wc, int fr, int fq) const {
        const int pn = u.pn; bf16_t* base; int ld, colt;
        if (pn < 8) { base = lx; ld = 2048; colt = pn * BM; }
        else if (pn < 16) { base = lg; ld = 2048; colt = (pn - 8) * BM; }
        else if (pn < 40) { base = qkv; ld = 6144; colt = (pn - 16) * BM; }
        else if (pn < 48) { base = z; ld = 2048; colt = (pn - 40) * BM; }
        else { base = ba; ld = 256; colt = 0; }
        const int row0 = u.pm * BM + wr * 64 + fr, col0 = colt + wc * 32 + 8 * fq;
#pragma unroll
        for (int ai = 0; ai < 2; ++ai)
#pragma unroll
            for (int m = 0; m < 4; ++m) { bf16_t* rowp = base + (size_t)(row0 + ai * HALF + m * 16) * ld + col0;
#pragma unroll
                for (int bj = 0; bj < 2; ++bj) { const f32x4 v0 = acc[ai][bj][m][0], v1 = acc[ai][bj][m][1];
                    u32x4 w; w.x = cvt_pk_bf16(v0[0], v0[1]); w.y = cvt_pk_bf16(v0[2], v0[3]); w.z = cvt_pk_bf16(v1[0], v1[1]); w.w = cvt_pk_bf16(v1[2], v1[3]);
                    *(u32x4*)(rowp + bj * HALF) = w; } }
    }
};
struct EpiSwiGLU {
    static constexpr bool PERM = true, AFTER_DRAIN = false;
    bf16_t* O; int ldc;
    __device__ __forceinline__ void operator()(const f32x4 (&acc)[2][2][4][2], const Unit& u, int wr, int wc, int fr, int fq) const {
        const int row0 = u.pm * BM + wr * 64 + fr, col0 = u.pn * HALF + wc * 32 + 8 * fq;
#pragma unroll
        for (int ai = 0; ai < 2; ++ai)
#pragma unroll
            for (int m = 0; m < 4; ++m) { bf16_t* rowp = O + (size_t)(row0 + ai * HALF + m * 16) * ldc + col0;
                float r[8];
#pragma unroll
                for (int n = 0; n < 2; ++n)
#pragma unroll
                    for (int j = 0; j < 4; ++j) { const float g = acc[ai][0][m][n][j], up = acc[ai][1][m][n][j]; r[4 * n + j] = g * __builtin_amdgcn_rcpf(1.0f + __expf(-g)) * up; }
                u32x4 w; w.x = cvt_pk_bf16(r[0], r[1]); w.y = cvt_pk_bf16(r[2], r[3]); w.z = cvt_pk_bf16(r[4], r[5]); w.w = cvt_pk_bf16(r[6], r[7]);
                *(u32x4*)rowp = w; }
    }
};

template <class Epi, class Sched, bool ALIGN_EPI = false, bool SP2 = false>
__device__ __forceinline__ void gemm_phase(PG8_LAS unsigned char* lds, const Gemm g, const Sched& S, const Epi& E) {
    const int tid = threadIdx.x, wid = __builtin_amdgcn_readfirstlane(tid >> 6), lane = tid & 63, wr = wid >> 2, wc = wid & 3, fr = lane & 15, fq = lane >> 4;
    const int K = g.K, nt = K / BK;
    unsigned voffA[2], voffB[2];
#pragma unroll
    for (int i = 0; i < 2; ++i) { int R, C; stage_rc(tid * 16 + i * 8192, R, C); const int Rb = Epi::PERM ? ((R & ~31) + perm32(R & 31)) : R;
        voffA[i] = (unsigned)(R * K + C) * 2u; voffB[i] = (unsigned)(Rb * K + C) * 2u; }
    const size_t kstep = (size_t)(BK * 2);
    const size_t hstep = (size_t)HALF * K * 2;
    const size_t tstep = 2 * hstep;
    const unsigned ldsw = (unsigned)wid * 1024u;
    const int aoff = lds_byte(wr * 64 + fr, fq * 8), boff = lds_byte(wc * 32 + fr, fq * 8);
#define PG8_SA(b, h) (((b) * 2 + (h)) * HTB)
#define PG8_SB(b, h) ((4 + (b) * 2 + (h)) * HTB)
#define PG8_STAGE(bufoff, gbase, voff) do { _Pragma("unroll") for (int _i = 0; _i < 2; ++_i) \
        __builtin_amdgcn_global_load_lds((const unsigned*)((const char*)(gbase) + (voff)[_i]), (PG8_LAS unsigned*)(lds + (bufoff) + ldsw + _i * 8192), 16, 0, 0); } while (0)
#define PG8_LDA(dst, b, h) do { _Pragma("unroll") for (int m = 0; m < 4; ++m) _Pragma("unroll") for (int k = 0; k < 2; ++k) dst[m][k] = *(const PG8_LAS bf16x8*)(lds + PG8_SA(b, h) + aoff + m * 2048 + k * 1024); } while (0)
#define PG8_LDB(dst, b, h) do { _Pragma("unroll") for (int n = 0; n < 2; ++n) _Pragma("unroll") for (int k = 0; k < 2; ++k) dst[n][k] = *(const PG8_LAS bf16x8*)(lds + PG8_SB(b, h) + boff + n * 2048 + k * 1024); } while (0)
#define PG8_MMA(ai, bj, At, Bt) do { __builtin_amdgcn_s_setprio(1); _Pragma("unroll") for (int m = 0; m < 4; ++m) _Pragma("unroll") for (int n = 0; n < 2; ++n) _Pragma("unroll") for (int k = 0; k < 2; ++k) \
        acc[ai][bj][m][n] = __builtin_amdgcn_mfma_f32_16x16x32_bf16(Bt[n][k], At[m][k], acc[ai][bj][m][n], 0, 0, 0); __builtin_amdgcn_s_setprio(0); } while (0)
#define PG8_WAIT_V(n) asm volatile("s_waitcnt vmcnt(" #n ")" ::: "memory")
#define PG8_WAIT_L(n) asm volatile("s_waitcnt lgkmcnt(" #n ")" ::: "memory")
#define PG8_BAR __builtin_amdgcn_s_barrier()
#define PG8_SCHED __builtin_amdgcn_sched_barrier(0)
    Unit cur, nxt; int ui = 0;
    if (!S.next(0, cur)) return;
    f32x4 acc[2][2][4][2];
#pragma unroll
    for (int a = 0; a < 2; ++a)
#pragma unroll
        for (int b = 0; b < 2; ++b)
#pragma unroll
            for (int m = 0; m < 4; ++m)
#pragma unroll
                for (int n = 0; n < 2; ++n) acc[a][b][m][n] = (f32x4){0.f, 0.f, 0.f, 0.f};
    bf16x8 At[4][2], B0[2][2], B1[2][2];
    const char* cA = (const char*)g.A + (size_t)cur.pm * tstep; const char* cB = (const char*)g.Bt + (size_t)cur.pn * tstep;
    S.a_ready(cur);
    if constexpr (SP2) {
        PG8_STAGE(PG8_SB(0, 0), cB, voffB); PG8_STAGE(PG8_SB(0, 1), cB + hstep, voffB); PG8_STAGE(PG8_SA(0, 0), cA, voffA); PG8_STAGE(PG8_SA(0, 1), cA + hstep, voffA);
        if (wr == 1) PG8_BAR;
        PG8_WAIT_V(2); PG8_BAR;
        PG8_STAGE(PG8_SB(1, 0), cB + kstep, voffB); PG8_STAGE(PG8_SA(1, 0), cA + kstep, voffA); PG8_STAGE(PG8_SB(1, 1), cB + hstep + kstep, voffB);
        PG8_WAIT_V(6); PG8_BAR;
    } else {
        PG8_STAGE(PG8_SB(0, 0), cB, voffB); PG8_STAGE(PG8_SA(0, 0), cA, voffA); PG8_STAGE(PG8_SB(0, 1), cB + hstep, voffB); PG8_STAGE(PG8_SA(0, 1), cA + hstep, voffA);
        if (wr == 1) PG8_BAR;
        PG8_WAIT_V(4); PG8_BAR;
        PG8_STAGE(PG8_SB(1, 0), cB + kstep, voffB); PG8_STAGE(PG8_SA(1, 0), cA + kstep, voffA); PG8_STAGE(PG8_SB(1, 1), cB + hstep + kstep, voffB);
        PG8_WAIT_V(6); PG8_BAR;
    }
    for (;;) {
        const bool has_next = S.next(ui + 1, nxt);
        const char* nA = has_next ? (const char*)g.A + (size_t)nxt.pm * tstep : cA; const char* nB = has_next ? (const char*)g.Bt + (size_t)nxt.pn * tstep : cB;
        for (int t = 0; t < nt; t += 2) {
            const bool last = (t == nt - 2);
            const char* a1 = cA + (size_t)(t + 1) * kstep;
            const char* a2 = last ? nA : cA + (size_t)(t + 2) * kstep; const char* b2 = last ? nB : cB + (size_t)(t + 2) * kstep;
            const char* a3 = a2 + kstep; const char* b3 = b2 + kstep;
            if (last && has_next) S.a_ready(nxt);
            if constexpr (SP2) {
            PG8_LDB(B0, 0, 0); PG8_LDB(B1, 0, 1); PG8_SCHED; PG8_LDA(At, 0, 0); PG8_STAGE(PG8_SA(1, 1), a1 + hstep, voffA);
            PG8_WAIT_V(8); PG8_WAIT_L(0); PG8_BAR; PG8_MMA(0, 0, At, B0); PG8_MMA(0, 1, At, B1); PG8_BAR; PG8_SCHED;
            PG8_LDA(At, 0, 1); PG8_STAGE(PG8_SB(0, 0), b2, voffB); PG8_STAGE(PG8_SB(0, 1), b2 + hstep, voffB); PG8_STAGE(PG8_SA(0, 0), a2, voffA);
            PG8_WAIT_V(8); PG8_WAIT_L(0); PG8_BAR; PG8_MMA(1, 0, At, B0); PG8_MMA(1, 1, At, B1); PG8_BAR; PG8_SCHED;
            PG8_LDB(B0, 1, 0); PG8_LDB(B1, 1, 1); PG8_SCHED; PG8_LDA(At, 1, 0); PG8_STAGE(PG8_SA(0, 1), a2 + hstep, voffA);
            PG8_WAIT_V(8); PG8_WAIT_L(0); PG8_BAR; PG8_MMA(0, 0, At, B0); PG8_MMA(0, 1, At, B1); PG8_BAR; PG8_SCHED;
            PG8_LDA(At, 1, 1); PG8_STAGE(PG8_SB(1, 0), b3, voffB); PG8_STAGE(PG8_SB(1, 1), b3 + hstep, voffB); PG8_STAGE(PG8_SA(1, 0), a3, voffA);
            PG8_WAIT_V(8); PG8_WAIT_L(0); PG8_BAR; PG8_MMA(1, 0, At, B0); PG8_MMA(1, 1, At, B1); PG8_BAR; PG8_SCHED;
            } else {
            PG8_LDB(B0, 0, 0); PG8_SCHED; PG8_LDA(At, 0, 0); PG8_STAGE(PG8_SA(1, 1), a1 + hstep, voffA);
            PG8_WAIT_L(8); PG8_BAR; PG8_WAIT_L(0); PG8_MMA(0, 0, At, B0); PG8_BAR; PG8_SCHED;
            PG8_LDB(B1, 0, 1); PG8_STAGE(PG8_SB(0, 0), b2, voffB);
            PG8_BAR; PG8_WAIT_L(0); PG8_MMA(0, 1, At, B1); PG8_BAR;
            PG8_LDA(At, 0, 1); PG8_STAGE(PG8_SA(0, 0), a2, voffA);
            PG8_BAR; PG8_WAIT_L(0); PG8_MMA(1, 0, At, B0); PG8_BAR; PG8_SCHED;
            PG8_STAGE(PG8_SB(0, 1), b2 + hstep, voffB);
            PG8_WAIT_V(6); PG8_BAR; PG8_MMA(1, 1, At, B1); PG8_BAR;
            PG8_LDB(B0, 1, 0); PG8_SCHED; PG8_LDA(At, 1, 0); PG8_STAGE(PG8_SA(0, 1), a2 + hstep, voffA);
            PG8_WAIT_L(8); PG8_BAR; PG8_WAIT_L(0); PG8_MMA(0, 0, At, B0); PG8_BAR; PG8_SCHED;
            PG8_LDB(B1, 1, 1); PG8_STAGE(PG8_SB(1, 0), b3, voffB);
            PG8_BAR; PG8_WAIT_L(0); PG8_MMA(0, 1, At, B1); PG8_BAR;
            PG8_LDA(At, 1, 1); PG8_STAGE(PG8_SA(1, 0), a3, voffA);
            PG8_BAR; PG8_WAIT_L(0); PG8_MMA(1, 0, At, B0); PG8_BAR; PG8_SCHED;
            PG8_STAGE(PG8_SB(1, 1), b3 + hstep, voffB);
            PG8_WAIT_V(6); PG8_BAR; PG8_MMA(1, 1, At, B1); PG8_BAR;
            }
        }
        if constexpr (ALIGN_EPI) { if (wr == 0) PG8_BAR; }
        if constexpr (!Epi::AFTER_DRAIN) { E(acc, cur, wr, wc, fr, fq); S.done(cur); }
        if (!has_next) break;
#pragma unroll
        for (int a = 0; a < 2; ++a)
#pragma unroll
            for (int b = 0; b < 2; ++b)
#pragma unroll
                for (int m = 0; m < 4; ++m)
#pragma unroll
                    for (int n = 0; n < 2; ++n) acc[a][b][m][n] = (f32x4){0.f, 0.f, 0.f, 0.f};
        cur = nxt; cA = nA; cB = nB; ++ui;
        if constexpr (ALIGN_EPI) { if (wr == 1) PG8_BAR; }
    }
    PG8_WAIT_V(0);
    if constexpr (!ALIGN_EPI) { if (wr == 0) PG8_BAR; }
    PG8_BAR;
    if constexpr (Epi::AFTER_DRAIN) { E.fused(acc, cur, wr, wc, fr, fq, lds, wid, lane); S.done(cur); }
#undef PG8_SA
#undef PG8_SB
#undef PG8_STAGE
#undef PG8_LDA
#undef PG8_LDB
#undef PG8_MMA
#undef PG8_WAIT_V
#undef PG8_WAIT_L
#undef PG8_BAR
#undef PG8_SCHED
}
}
constexpr int DM = 4096, NBATCH = 2, TL = 8192, TCX = 256, ML = NBATCH * TL, MC = NBATCH * TCX, MT = ML + MC;
constexpr int LW = 2048, GDW = 2048, NH = 16, HD = 128, DFF = 11008, NIN = 12352, NINP = 12544, NADA = 6 * DM;
constexpr int SEQ_S = TCX + TL;
constexpr int NCH = 132;
constexpr float EPS = 1e-6f;
enum { I_X = 0, I_C, I_CTX, I_CCTX, I_WADA, I_BADA, I_GPREMIX, I_GPOSTMIX, I_GPREFFN, I_GPOSTFFN, I_WIN, I_LCW, I_LCB, I_LWA, I_LBA, I_LWX, I_LBX, I_LLAM, I_LNG, I_GCW, I_GALOG, I_GDT, I_GNG, I_WOUT, I_WG, I_WU, I_WD, N_INPUTS };

constexpr size_t MiB = 1u << 20;
constexpr size_t WS_CTL = 0, CTL_ZERO_BYTES = 1 * MiB;
constexpr size_t WS_MODP = 1 * MiB, WS_MOD = 11 * MiB, WS_WL = 12 * MiB, WS_CAR = 14 * MiB, WS_HIN = 23 * MiB, WS_GB = 28 * MiB, WS_KQ = 33 * MiB, WS_SSQ = 35 * MiB;
constexpr size_t WS_WOUT = 44 * MiB, WS_WGU = 76 * MiB, WS_WDN = 248 * MiB;
constexpr size_t WS_R2 = 334 * MiB;
constexpr size_t WS_WIN = WS_R2, WS_H = WS_R2 + 98 * MiB;
constexpr size_t WS_QN = WS_R2, WS_KN = WS_R2 + 66 * MiB, WS_VN = WS_R2 + 132 * MiB;
constexpr size_t WS_H2 = WS_R2, WS_Y2 = WS_R2;
constexpr size_t WS_R3 = 590 * MiB;
constexpr size_t WS_LX = WS_R3, WS_LG = WS_R3 + 66 * MiB, WS_QKV = WS_R3 + 132 * MiB, WS_Z = WS_R3 + 330 * MiB, WS_BA = WS_R3 + 396 * MiB;
constexpr size_t WS_Y1 = WS_R3, WS_ACT = WS_R3;
constexpr size_t WS_MIX = 995 * MiB;
constexpr size_t WS_UT = 1123 * MiB, WS_W = 1255 * MiB, WS_INTRA = 1387 * MiB, WS_END = 1453 * MiB;
constexpr size_t WS_KT = WS_QKV, WS_GSC = 37 * MiB;
static_assert(WS_SSQ + (size_t)ML * 16 * 4 <= WS_WOUT && WS_WOUT + (size_t)DM * DM * 2 <= WS_WGU && WS_WGU + (size_t)2 * DFF * DM * 2 <= WS_WDN && WS_WDN + (size_t)DM * DFF * 2 <= WS_R2, "ws map 1");
static_assert(WS_WIN + (size_t)NINP * DM * 2 <= WS_H && WS_H + (size_t)MT * DM * 2 <= WS_R3 && WS_VN + (size_t)NBATCH * SEQ_S * 2048 * 2 <= WS_R3 && WS_Y2 + (size_t)ML * DM * 4 <= WS_R3, "ws map 2");
static_assert((size_t)MT * 2048 * 2 <= 66 * MiB && (size_t)MT * 6144 * 2 <= 198 * MiB && WS_BA + (size_t)MT * 256 * 2 <= WS_MIX && WS_ACT + (size_t)ML * DFF * 2 <= WS_MIX && WS_MIX + (size_t)ML * DM * 2 <= WS_UT, "ws map 3");
static_assert((size_t)NBATCH * NH * NCH * 2 * 8192 * 2 == 132 * MiB && WS_KT + 132 * MiB <= WS_Z && WS_GSC + (size_t)NBATCH * NH * NCH * 2 * 128 * 4 <= WS_WOUT && WS_SSQ + (size_t)ML * 16 * 4 <= WS_GSC, "ws map 4");
constexpr int CW_BAR = 4096;

constexpr int LDS_BYTES = 147456;
constexpr int MISC_OFF = LDS_BYTES - 256;

#define GAS __attribute__((address_space(1)))
#define LAS __attribute__((address_space(3)))
typedef unsigned short bf16;
typedef unsigned u32x4 __attribute__((ext_vector_type(4)));
typedef unsigned u32x2 __attribute__((ext_vector_type(2)));
typedef float f32x4 __attribute__((ext_vector_type(4)));
typedef float f32x2 __attribute__((ext_vector_type(2)));
typedef short bf16x8 __attribute__((ext_vector_type(8)));
#define LDS_WAIT() asm volatile("s_waitcnt lgkmcnt(0)" ::: "memory")
#define WAVE_LDS_FENCE() do { asm volatile("s_waitcnt lgkmcnt(0)" ::: "memory"); __builtin_amdgcn_wave_barrier(); } while (0)
__device__ __forceinline__ unsigned f2bf(float f) { unsigned u = __builtin_bit_cast(unsigned, f); return (u + 0x7fffu + ((u >> 16) & 1u)) >> 16; }
__device__ __forceinline__ unsigned pk2(float lo, float hi) { return f2bf(lo) | (f2bf(hi) << 16); }
__device__ __forceinline__ float bf2f(unsigned h) { return __builtin_bit_cast(float, h << 16); }
__device__ __forceinline__ float bflo(unsigned w) { return __builtin_bit_cast(float, w << 16); }
__device__ __forceinline__ float bfhi(unsigned w) { return __builtin_bit_cast(float, w & 0xffff0000u); }
__device__ __forceinline__ float wave_sum(float v) {
#pragma unroll
    for (int o = 1; o < 64; o <<= 1) v += __shfl_xor(v, o);
    return v;
}
__device__ __forceinline__ float sigmoidf_(float x) { return __builtin_amdgcn_rcpf(1.0f + __expf(-x)); }
__device__ __forceinline__ float siluf_(float x) { return x * sigmoidf_(x); }
__device__ __forceinline__ float softplusf_(float x) { return x > 20.f ? x : log1pf(__expf(x)); }
__device__ __forceinline__ float gelu_tanhf_(float x) { const float u = 0.7978845608028654f * (x + 0.044715f * x * x * x); const float t = 1.0f - 2.0f * __builtin_amdgcn_rcpf(__expf(2.0f * u) + 1.0f); return 0.5f * x * (1.0f + t); }
__device__ __forceinline__ float rdlane(float x, int l) { return __builtin_bit_cast(float, __builtin_amdgcn_readlane(__builtin_bit_cast(int, x), l)); }

#define XB_TMO      128
#define XB_XCNT(j)  (256  + 64 * (j))
#define XB_XSUB(j)  (1280 + 64 * (j))
#define XB_XGEN(j)  (2304 + 64 * (j))
#define XB_TOP      3328
#define XB_TOPGEN   3392
#define XCD_BAR_WORDS 3456
#define XB_SPIN_CAP (1u << 22)
__device__ __forceinline__ unsigned xb_ld(unsigned* p)              { return __hip_atomic_load(p, __ATOMIC_RELAXED, __HIP_MEMORY_SCOPE_AGENT); }
__device__ __forceinline__ unsigned xb_add(unsigned* p, unsigned v) { return __hip_atomic_fetch_add(p, v, __ATOMIC_RELAXED, __HIP_MEMORY_SCOPE_AGENT); }
__device__ __forceinline__ unsigned xb_xcc_id() { return (unsigned)__builtin_amdgcn_s_getreg((3 << 11) | 20) & 0xFu; }
#define XB_SPIN(cond, bar) do { unsigned _sp = 0; while (cond) { __builtin_amdgcn_s_sleep(1); \
    if ((++_sp & 255u) == 0u) { if (xb_ld(&(bar)[XB_TMO])) break; if (_sp > XB_SPIN_CAP) { atomicAdd(&(bar)[XB_TMO], 1u); break; } } } } while (0)
struct XcdBarrier { unsigned* bar; unsigned x; volatile LAS unsigned* st; };
__device__ __forceinline__ XcdBarrier xcd_barrier_post(unsigned* bar, volatile LAS unsigned* st) {
    XcdBarrier b; b.bar = bar; b.x = xb_xcc_id(); b.st = st;
    if (threadIdx.x == 0) (void)xb_add(&bar[XB_XCNT(b.x)], 1u);
    return b;
}
__device__ __forceinline__ void xcd_barrier_complete(unsigned* bar, unsigned x, unsigned& nloc, unsigned& nx) {
    const unsigned G = gridDim.x * gridDim.y * gridDim.z;
    unsigned sum, cnt, mine, sp = 0u;
    for (;;) {
        sum = 0u; cnt = 0u; mine = 0u;
#pragma unroll
        for (unsigned j = 0; j < 16; ++j) { const unsigned c = xb_ld(&bar[XB_XCNT(j)]); sum += c; cnt += (c > 0u) ? 1u : 0u; mine = (j == x) ? c : mine; }
        if (sum == G) break;
        __builtin_amdgcn_s_sleep(1);
        if ((++sp & 255u) == 0u) { if (xb_ld(&bar[XB_TMO])) break; if (sp > XB_SPIN_CAP) { atomicAdd(&bar[XB_TMO], 1u); break; } }
    }
    nloc = mine > 0u ? mine : 1u; nx = cnt > 0u ? cnt : 1u;
}
__device__ __forceinline__ void xcd_barrier(const XcdBarrier& b) {
    asm volatile("s_waitcnt vmcnt(0)" ::: "memory");
    __syncthreads();
    if (threadIdx.x == 0) {
        unsigned* bar = b.bar;
        __builtin_amdgcn_s_waitcnt(0);
        unsigned nloc = b.st[0], nx = b.st[1];
        if (nloc == 0u) { xcd_barrier_complete(bar, b.x, nloc, nx); b.st[0] = nloc; b.st[1] = nx; }
        const unsigned old = xb_add(&bar[XB_XSUB(b.x)], 1u);
        const unsigned gen = old / nloc;
        if (old + 1u == (gen + 1u) * nloc) {
            __builtin_amdgcn_fence(__ATOMIC_RELEASE, "agent");
            asm volatile("s_waitcnt vmcnt(0)" ::: "memory");
            const unsigned og = xb_add(&bar[XB_TOP], 1u);
            const unsigned tg = og / nx;
            if (og + 1u == (tg + 1u) * nx) xb_add(&bar[XB_TOPGEN], 1u);
            else XB_SPIN(xb_ld(&bar[XB_TOPGEN]) == tg, bar);
            __builtin_amdgcn_fence(__ATOMIC_ACQUIRE, "agent");
            xb_add(&bar[XB_XGEN(b.x)], 1u);
            asm volatile("s_waitcnt vmcnt(0)" ::: "memory");
        } else {
            XB_SPIN(xb_ld(&bar[XB_XGEN(b.x)]) == gen, bar);
            __builtin_amdgcn_fence(__ATOMIC_ACQUIRE, "agent");
            asm volatile("s_waitcnt vmcnt(0)" ::: "memory");
        }
    }
    __syncthreads();
}

struct Args { const float* in[N_INPUTS]; float* out; unsigned char* ws; int ph_lo, ph_hi; };
struct Frame {
    LAS unsigned char* lds;
    int tid, lane, wave, vcu, G;
    const float* const* in;
    float* out; unsigned char* ws;
};
#define F_modp ((float*)(F.ws + WS_MODP))
#define F_mod ((float*)(F.ws + WS_MOD))
#define F_WL ((bf16*)(F.ws + WS_WL))
#define F_CAR ((f32x2*)(F.ws + WS_CAR))
#define F_HIN ((float*)(F.ws + WS_HIN))
#define F_GB ((f32x2*)(F.ws + WS_GB))
#define F_KQ ((float*)(F.ws + WS_KQ))
#define F_SSQ ((float*)(F.ws + WS_SSQ))
#define F_Wt_out ((bf16*)(F.ws + WS_WOUT))
#define F_Wt_gu ((bf16*)(F.ws + WS_WGU))
#define F_Wt_dn ((bf16*)(F.ws + WS_WDN))
#define F_Wt_in ((bf16*)(F.ws + WS_WIN))
#define F_H ((bf16*)(F.ws + WS_H))
#define F_QN ((bf16*)(F.ws + WS_QN))
#define F_KN ((bf16*)(F.ws + WS_KN))
#define F_VN ((bf16*)(F.ws + WS_VN))
#define F_H2 ((bf16*)(F.ws + WS_H2))
#define F_LX ((bf16*)(F.ws + WS_LX))
#define F_LG ((bf16*)(F.ws + WS_LG))
#define F_QKV ((bf16*)(F.ws + WS_QKV))
#define F_Z ((bf16*)(F.ws + WS_Z))
#define F_BA ((bf16*)(F.ws + WS_BA))
#define F_ACT ((bf16*)(F.ws + WS_ACT))
#define F_MIX ((bf16*)(F.ws + WS_MIX))
#define F_Y1 ((float*)(F.ws + WS_Y1))
#define F_Y2 ((float*)(F.ws + WS_Y2))
#define F_O (F.out)
#define F_UT ((bf16*)(F.ws + WS_UT))
#define F_W ((bf16*)(F.ws + WS_W))
#define F_INTRA ((bf16*)(F.ws + WS_INTRA))
#define F_KT ((bf16*)(F.ws + WS_KT))
#define F_GSC ((float*)(F.ws + WS_GSC))
__device__ __forceinline__ void transpose_item(const float* W, int N, bf16* WT, int Kp, int k0, int n0, int drow0, LAS float* scr, int lane) {
#pragma unroll 8
    for (int i = 0; i < 32; ++i) { const int kk = 2 * i + (lane >> 5); scr[kk * 33 + (lane & 31)] = W[(size_t)(k0 + kk) * N + n0 + (lane & 31)]; }
    LDS_WAIT(); asm volatile("" ::: "memory");
    const int c = lane & 7;
#pragma unroll
    for (int j = 0; j < 4; ++j) { const int n = (lane >> 3) + 8 * j; const LAS float* s = scr + (8 * c) * 33 + n;
        u32x4 o; o.x = pk2(s[0 * 33], s[1 * 33]); o.y = pk2(s[2 * 33], s[3 * 33]); o.z = pk2(s[4 * 33], s[5 * 33]); o.w = pk2(s[6 * 33], s[7 * 33]);
        *(u32x4*)(WT + (size_t)(drow0 + n) * Kp + k0 + 8 * c) = o; }
    LDS_WAIT(); asm volatile("" ::: "memory");
}

__device__ __forceinline__ void ph0_prologue(const Frame& F) {
    const int gw = F.vcu * 8 + F.wave, NGW = F.G * 8, lane = F.lane;
    {
        const float* W = F.in[I_WADA]; const float* c = F.in[I_C]; const float* cc = F.in[I_CCTX];
        for (int it = gw; it < 96 * 32; it += NGW) {
            const int cg = it % 96, kc = it / 96;
            float sv[3][2];
#pragma unroll
            for (int h = 0; h < 2; ++h) { const int k = kc * 128 + h * 64 + lane; sv[0][h] = siluf_(c[k]); sv[1][h] = siluf_(c[DM + k]); sv[2][h] = siluf_(cc[k]); }
            f32x4 a0 = {0.f, 0.f, 0.f, 0.f}, a1 = a0, a2 = a0;
            const f32x4* wp = (const f32x4*)(W + (size_t)kc * 128 * NADA + cg * 256) + lane;
#pragma unroll
            for (int h = 0; h < 2; ++h) {
#pragma unroll 8
                for (int kk = 0; kk < 64; ++kk) { const f32x4 w = wp[(size_t)(h * 64 + kk) * (NADA / 4)];
                    const float s0 = rdlane(sv[0][h], kk), s1 = rdlane(sv[1][h], kk), s2 = rdlane(sv[2][h], kk);
                    a0 += w * s0; a1 += w * s1; a2 += w * s2; } }
            float* mp = F_modp + (size_t)(kc * 3) * NADA + cg * 256;
            ((f32x4*)mp)[lane] = a0; ((f32x4*)(mp + NADA))[lane] = a1; ((f32x4*)(mp + 2 * NADA))[lane] = a2;
        }
    }
    {
        LAS float* scr = (LAS float*)(F.lds + F.wave * 16384);
        constexpr int IT_IN = 64 * (NIN / 32), IT_OUT = 64 * (DM / 32), IT_G = 64 * (DFF / 32), IT_D = (DFF / 64) * (DM / 32), IT_L = 64 * 8;
        constexpr int NITEMS = IT_IN + IT_OUT + 2 * IT_G + IT_D + IT_L;
        for (int it = gw; it < NITEMS; it += NGW) {
            int r = it;
            if (r < IT_IN) { const int kb = r / (NIN / 32), nb = r % (NIN / 32); transpose_item(F.in[I_WIN], NIN, F_Wt_in, DM, 64 * kb, 32 * nb, 32 * nb, scr, lane); continue; } r -= IT_IN;
            if (r < IT_OUT) { const int kb = r / (DM / 32), nb = r % (DM / 32); transpose_item(F.in[I_WOUT], DM, F_Wt_out, DM, 64 * kb, 32 * nb, 32 * nb, scr, lane); continue; } r -= IT_OUT;
            if (r < 2 * IT_G) { const int up = r >= IT_G; if (up) r -= IT_G; const int kb = r / (DFF / 32), nb = r % (DFF / 32), n0 = 32 * nb;
                transpose_item(F.in[up ? I_WU : I_WG], DFF, F_Wt_gu, DM, 64 * kb, n0, 256 * (n0 >> 7) + (n0 & 127) + (up ? 128 : 0), scr, lane); continue; } r -= 2 * IT_G;
            if (r < IT_D) { const int kb = r / (DM / 32), nb = r % (DM / 32); transpose_item(F.in[I_WD], DM, F_Wt_dn, DFF, 64 * kb, 32 * nb, 32 * nb, scr, lane); continue; } r -= IT_D;
            { const int mi = r >> 3, sub = r & 7, kb = sub >> 2, nb = sub & 3, d = mi >> 5, kind = (mi >> 4) & 1, n = mi & 15;
              transpose_item(F.in[kind ? I_LWX : I_LWA] + (size_t)(d * 16 + n) * 16384, 128, F_WL + (size_t)((d * 2 + kind) * 16 + n) * 16384, 128, 64 * kb, 32 * nb, 32 * nb, scr, lane); }
        }
    }
    {
        u32x4* p = (u32x4*)(F_Wt_in + (size_t)NIN * DM); const u32x4 z = {0u, 0u, 0u, 0u};
        for (int i = F.vcu * 512 + F.tid; i < (NINP - NIN) * DM / 8; i += F.G * 512) p[i] = z;
    }
}
__device__ __forceinline__ void ph1_modreduce(const Frame& F) {
    const float* ba = F.in[I_BADA];
    for (int i = F.vcu * 512 + F.tid; i < 3 * NADA; i += F.G * 512) { const int r = i / NADA, col = i - r * NADA; float s = ba[col];
#pragma unroll 8
        for (int kc = 0; kc < 32; ++kc) s += F_modp[(size_t)(kc * 3 + r) * NADA + col];
        F_mod[i] = s; }
}
__device__ __forceinline__ void ph2_hrows(const Frame& F) {
    const int gw = F.vcu * 8 + F.wave, NGW = F.G * 8, lane = F.lane;
    const f32x4* g4 = (const f32x4*)F.in[I_GPREMIX];
    for (int row = gw; row < MT; row += NGW) {
        const float* xr = row < ML ? F.in[I_X] + (size_t)row * DM : F.in[I_CTX] + (size_t)(row - ML) * DM;
        const int mr = row < ML ? row / TL : 2;
        const f32x4* sh4 = (const f32x4*)(F_mod + (size_t)mr * NADA); const f32x4* sc4 = sh4 + DM / 4;
        f32x4 v[16]; float ss = 0.f;
#pragma unroll
        for (int j = 0; j < 16; ++j) { v[j] = ((const f32x4*)xr)[lane + 64 * j]; ss += (v[j].x * v[j].x + v[j].y * v[j].y) + (v[j].z * v[j].z + v[j].w * v[j].w); }
        const float rs = rsqrtf(wave_sum(ss) * (1.0f / DM) + EPS);
        u32x2* o = (u32x2*)(F_H + (size_t)row * DM);
#pragma unroll
        for (int j = 0; j < 16; ++j) { const f32x4 g = g4[lane + 64 * j], sh = sh4[lane + 64 * j], sc = sc4[lane + 64 * j];
            const f32x4 y = (v[j] * rs * g) * (sc + 1.0f) + sh; u32x2 w; w.x = pk2(y.x, y.y); w.y = pk2(y.z, y.w); o[lane + 64 * j] = w; }
    }
}

template <int PASS>
__device__ __forceinline__ void lru_pass(const Frame& F) {
    LAS bf16* U = (LAS bf16*)(F.lds);
    LAS float* XC = (LAS float*)(F.lds + 17408);
    LAS bf16* XCB = (LAS bf16*)(F.lds + 17408 + 32768);
    LAS f32x2* SC = (LAS f32x2*)(F.lds + 17408 + 32768 + 17408 + F.wave * 8192);
    const int tid = F.tid, lane = F.lane, w = F.wave, fr = lane & 15, fq = lane >> 4;
    const int n = F.vcu & 15;
    const int cl = 16 * w + fr, cg = n * 128 + cl;
    float ba[2], bx[2], sp[2];
#pragma unroll
    for (int d = 0; d < 2; ++d) { ba[d] = F.in[I_LBA][d * LW + cg]; bx[d] = F.in[I_LBX][d * LW + cg]; sp[d] = softplusf_(-F.in[I_LLAM][d * LW + cg]); }
    const int cc = tid & 127, tg = tid >> 7;
    float cw[4];
#pragma unroll
    for (int j = 0; j < 4; ++j) cw[j] = F.in[I_LCW][j * LW + n * 128 + cc];
    const float cb = F.in[I_LCB][n * 128 + cc];
    for (int q = F.vcu >> 4; q < NBATCH * NCH; q += F.G >> 4) {
        const int b = q / NCH, cidx = q - b * NCH;
        if (PASS == 2 && cidx < 4) continue;
        const bool isctx = cidx < 4; const int t0 = isctx ? cidx * 64 : (cidx - 4) * 64, Tseq = isctx ? TCX : TL;
        const size_t rowbase = isctx ? (size_t)ML + (size_t)b * TCX : (size_t)b * TL;
        __syncthreads();
        for (int rr = tid >> 4; rr < 67; rr += 32) { const int t = t0 - 2 + rr; u32x4 v = {0u, 0u, 0u, 0u};
            if (t >= 0 && t < Tseq) v = *(const u32x4*)(F_LX + (rowbase + t) * LW + n * 128 + (tid & 15) * 8);
            *(LAS u32x4*)(U + rr * 128 + (tid & 15) * 8) = v; }
        u32x4 gt0 = {0u, 0u, 0u, 0u}, gt1 = gt0;
        if (PASS == 2) { gt0 = *(const u32x4*)(F_LG + (rowbase + t0 + (tid >> 4)) * LW + n * 128 + (tid & 15) * 8); gt1 = *(const u32x4*)(F_LG + (rowbase + t0 + 32 + (tid >> 4)) * LW + n * 128 + (tid & 15) * 8); }
        __syncthreads();
        { float x0 = bf2f(U[(tg * 16 + 0) * 128 + cc]), x1 = bf2f(U[(tg * 16 + 1) * 128 + cc]), x2 = bf2f(U[(tg * 16 + 2) * 128 + cc]);
#pragma unroll
          for (int i = 0; i < 16; ++i) { const int tt = tg * 16 + i; const float x3 = bf2f(U[(tt + 3) * 128 + cc]);
              const float y = cb + cw[0] * x0 + cw[1] * x1 + cw[2] * x2 + cw[3] * x3; XC[tt * 128 + cc] = y; XCB[tt * 136 + cc] = (bf16)f2bf(y); x0 = x1; x1 = x2; x2 = x3; } }
        __syncthreads();
        if (PASS == 2) { *(LAS u32x4*)(U + (tid >> 4) * 128 + (tid & 15) * 8) = gt0; *(LAS u32x4*)(U + (32 + (tid >> 4)) * 128 + (tid & 15) * 8) = gt1; }
        float hsum[4][4];
#pragma unroll
        for (int d = 0; d < 2; ++d) {
            bf16x8 bfr[2][4];
#pragma unroll
            for (int mat = 0; mat < 2; ++mat)
#pragma unroll
                for (int ks = 0; ks < 4; ++ks) bfr[mat][ks] = *(const bf16x8*)(F_WL + ((size_t)((2 * d + mat) * 16 + n) * 128 + cl) * 128 + 32 * ks + 8 * fq);
            f32x4 acc[2][4];
#pragma unroll
            for (int mat = 0; mat < 2; ++mat)
#pragma unroll
                for (int mt = 0; mt < 4; ++mt) acc[mat][mt] = (f32x4){0.f, 0.f, 0.f, 0.f};
#pragma unroll
            for (int mt = 0; mt < 4; ++mt)
#pragma unroll
                for (int ks = 0; ks < 4; ++ks) { const bf16x8 af = *(const LAS bf16x8*)(XCB + (16 * mt + fr) * 136 + 32 * ks + 8 * fq);
                    acc[0][mt] = __builtin_amdgcn_mfma_f32_16x16x32_bf16(af, bfr[0][ks], acc[0][mt], 0, 0, 0);
                    acc[1][mt] = __builtin_amdgcn_mfma_f32_16x16x32_bf16(af, bfr[1][ks], acc[1][mt], 0, 0, 0); }
#pragma unroll
            for (int mt = 0; mt < 4; ++mt)
#pragma unroll
                for (int rg = 0; rg < 4; ++rg) { const int tok = 16 * mt + 4 * fq + rg; const float xcv = XC[tok * 128 + cl];
                    const float r = sigmoidf_(acc[0][mt][rg] + ba[d]), ig = sigmoidf_(acc[1][mt][rg] + bx[d]);
                    const float la = -8.0f * r * sp[d]; const float a = __expf(la); const float x2 = 2.0f * la;
                    const float em = -x2 * (1.0f + x2 * (0.5f + x2 * (0.16666667f + x2 * (0.041666668f + x2 * (0.0083333338f + x2 * 0.0013888889f)))));
                    const float bb = sqrtf(em) * (ig * xcv);
                    SC[tok * 16 + fr] = (f32x2){a, bb}; }
            WAVE_LDS_FENCE();
            float P = 1.0f, h = 0.0f;
#pragma unroll
            for (int i = 0; i < 16; ++i) { const int tok = 16 * fq + (d == 0 ? i : 15 - i); const f32x2 ab = SC[tok * 16 + fr]; h = ab.x * h + ab.y; P *= ab.x; SC[tok * 16 + fr] = (f32x2){P, h}; }
            float As[4], Bs[4];
#pragma unroll
            for (int s = 0; s < 4; ++s) { As[s] = __shfl(P, s * 16 + fr); Bs[s] = __shfl(h, s * 16 + fr); }
            const size_t cidx_off = ((size_t)((d * 2 + b) * NCH + cidx)) * LW + cg;
            if (PASS == 1) {
                float At = 1.0f, Bt = 0.0f;
#pragma unroll
                for (int s = 0; s < 4; ++s) { const int sgi = d == 0 ? s : 3 - s; Bt = As[sgi] * Bt + Bs[sgi]; At *= As[sgi]; }
                if (fq == 0) F_CAR[cidx_off] = (f32x2){At, Bt};
            } else {
                float hin = F_HIN[cidx_off];
#pragma unroll
                for (int s = 0; s < 4; ++s) { const int sgi = d == 0 ? s : 3 - s; const bool before = d == 0 ? (sgi < fq) : (sgi > fq); if (before) hin = As[sgi] * hin + Bs[sgi]; }
#pragma unroll
                for (int i = 0; i < 16; ++i) { const int tok = 16 * fq + i; const f32x2 ph = SC[tok * 16 + fr]; SC[tok * 16 + fr] = (f32x2){ph.x, ph.y + ph.x * hin}; }
                WAVE_LDS_FENCE();
#pragma unroll
                for (int mt = 0; mt < 4; ++mt)
#pragma unroll
                    for (int rg = 0; rg < 4; ++rg) { const float hv = SC[(16 * mt + 4 * fq + rg) * 16 + fr].y; hsum[mt][rg] = d == 0 ? hv : hsum[mt][rg] + hv; }
            }
            WAVE_LDS_FENCE();
        }
        if (PASS == 2) {
            __syncthreads();
#pragma unroll
            for (int mt = 0; mt < 4; ++mt)
#pragma unroll
                for (int rg = 0; rg < 4; ++rg) { const int tok = 16 * mt + 4 * fq + rg;
                    const float y = hsum[mt][rg] * gelu_tanhf_(bf2f(U[tok * 128 + cl])); XCB[tok * 136 + cl] = (bf16)f2bf(y); }
            __syncthreads();
#pragma unroll
            for (int hh = 0; hh < 2; ++hh) { const int tok = hh * 32 + (tid >> 4); const u32x4 wv = *(const LAS u32x4*)(XCB + tok * 136 + (tid & 15) * 8);
                const size_t row = rowbase + t0 + tok; *(u32x4*)(F_MIX + row * DM + n * 128 + (tid & 15) * 8) = wv;
                float sq = (bflo(wv.x) * bflo(wv.x) + bfhi(wv.x) * bfhi(wv.x)) + (bflo(wv.y) * bflo(wv.y) + bfhi(wv.y) * bfhi(wv.y)) + (bflo(wv.z) * bflo(wv.z) + bfhi(wv.z) * bfhi(wv.z)) + (bflo(wv.w) * bflo(wv.w) + bfhi(wv.w) * bfhi(wv.w));
                sq += __shfl_xor(sq, 1); sq += __shfl_xor(sq, 2); sq += __shfl_xor(sq, 4); sq += __shfl_xor(sq, 8);
                if ((tid & 15) == 0) F_SSQ[row * 16 + n] = sq; }
        }
    }
}
__device__ __forceinline__ int gdn_row(int b, int s) {
    if (s < TCX) return ML + b * TCX + s;
    const int m = s - TCX; return b * TL + (m & 127) * 64 + (m >> 7);
}
__device__ __forceinline__ void gdn_pre(const Frame& F) {
    const int gw = F.vcu * 8 + F.wave, NGW = F.G * 8, lane = F.lane;
    const float* cw = F.in[I_GCW];
    for (int tok = gw; tok < NBATCH * SEQ_S; tok += NGW) {
        const int b = tok / SEQ_S, s = tok - b * SEQ_S;
        const int lo = s < TCX ? 0 : TCX, hi = s < TCX ? TCX : SEQ_S;
        int rows[4]; bool val[4];
#pragma unroll
        for (int j = 0; j < 4; ++j) { const int sj = s + j - 2; val[j] = sj >= lo && sj < hi; rows[j] = gdn_row(b, val[j] ? sj : s); }
        for (int h = 0; h < NH; ++h) {
            float a[3][2];
#pragma unroll
            for (int p = 0; p < 3; ++p) { a[p][0] = 0.f; a[p][1] = 0.f; }
#pragma unroll
            for (int j = 0; j < 4; ++j) {
#pragma unroll
                for (int p = 0; p < 3; ++p) { const int ch = p * GDW + h * HD + 2 * lane;
                    const unsigned xw = val[j] ? *(const unsigned*)(F_QKV + (size_t)rows[j] * 6144 + ch) : 0u;
                    const f32x2 wv = *(const f32x2*)(cw + (size_t)j * 6144 + ch);
                    a[p][0] += wv.x * bflo(xw); a[p][1] += wv.y * bfhi(xw); } }
#pragma unroll
            for (int p = 0; p < 3; ++p) { a[p][0] = siluf_(a[p][0]); a[p][1] = siluf_(a[p][1]); }
            const float rq = rsqrtf(wave_sum(a[0][0] * a[0][0] + a[0][1] * a[0][1]) + EPS), rk = rsqrtf(wave_sum(a[1][0] * a[1][0] + a[1][1] * a[1][1]) + EPS);
            const unsigned qw = pk2(a[0][0] * rq, a[0][1] * rq), kw = pk2(a[1][0] * rk, a[1][1] * rk), vw = pk2(a[2][0], a[2][1]);
            const float kq = wave_sum(bflo(qw) * bflo(kw) + bfhi(qw) * bfhi(kw));
            const size_t o = ((size_t)b * SEQ_S + s) * GDW + h * HD + 2 * lane;
            *(unsigned*)(F_QN + o) = qw; *(unsigned*)(F_KN + o) = kw; *(unsigned*)(F_VN + o) = vw;
            if (lane == 0) F_KQ[(size_t)(b * NH + h) * SEQ_S + s] = kq;
        }
        if (lane < 32) { const int d = lane >> 4, h = lane & 15; const bf16* bar = F_BA + (size_t)rows[2] * 256;
            const float pb = bf2f(bar[d * 16 + h]), pa = bf2f(bar[32 + d * 16 + h]);
            const float beta = sigmoidf_(pb), g = -__expf(F.in[I_GALOG][d * 16 + h]) * softplusf_(pa + F.in[I_GDT][d * 16 + h]);
            F_GB[(size_t)((d * 2 + b) * NH + h) * SEQ_S + s] = (f32x2){g, beta}; }
    }
}
__device__ __forceinline__ void lru_chains(const Frame& F) {
    if (F.tid < 32) {
        for (int chain = F.vcu * 32 + F.tid; chain < 2 * NBATCH * LW; chain += F.G * 32) {
            const int cg = chain & (LW - 1), b = (chain >> 11) & 1, d = chain >> 12;
            float h = 0.f;
#pragma unroll 4
            for (int step = 0; step < NCH; ++step) { const int cidx = d == 0 ? step : (step < 4 ? 3 - step : NCH - 1 - (step - 4));
                const size_t idx = ((size_t)((d * 2 + b) * NCH + cidx)) * LW + cg; const f32x2 ab = F_CAR[idx]; F_HIN[idx] = h; h = ab.x * h + ab.y; }
        }
    }
}
__device__ __forceinline__ int gdn_spos(int d, int step) { return d == 0 ? step : (step < TCX ? TCX - 1 - step : SEQ_S - 1 - (step - TCX)); }
__device__ __forceinline__ void gdn_seq(const Frame& F, int item) {
    const int sl = item & 3, d = (item >> 2) & 1, h = (item >> 3) & 15, b = item >> 7;
    LAS float* Kst = (LAS float*)F.lds;
    LAS float* Qst = Kst + 2048;
    LAS float* Vst = Qst + 2048;
    LAS float* Gst = Vst + 512;
    LAS f32x2* RED = (LAS f32x2*)(Gst + 64);
    const int tid = F.tid, v = tid & 31, kg = tid >> 5;
    float S[8];
#pragma unroll
    for (int i = 0; i < 8; ++i) S[i] = 0.f;
    const bf16* Kb = F_KN + (size_t)b * SEQ_S * GDW + h * HD + (tid & 31) * 4;
    const bf16* Qb = F_QN + (size_t)b * SEQ_S * GDW + h * HD + (tid & 31) * 4;
    const bf16* Vb = F_VN + (size_t)b * SEQ_S * GDW + h * HD + sl * 32 + (tid & 31);
    const f32x2* GBp = F_GB + (size_t)((d * 2 + b) * NH + h) * SEQ_S; const float* KQp = F_KQ + (size_t)(b * NH + h) * SEQ_S;
    float* Ob = F_O + (size_t)d * ML * GDW + h * HD + sl * 32 + v;
    u32x2 pk, pq; unsigned pv; f32x2 pgb = {0.f, 0.f}; float pkq = 0.f;
#define GDN_LOADG(g0) do { const int s_ = gdn_spos(d, (g0) + (tid >> 5)); pk = *(const u32x2*)(Kb + (size_t)s_ * GDW); pq = *(const u32x2*)(Qb + (size_t)s_ * GDW); pv = Vb[(size_t)s_ * GDW]; \
        if (tid < 16) { const int s2_ = gdn_spos(d, (g0) + tid); pgb = GBp[s2_]; pkq = KQp[s2_]; } } while (0)
    GDN_LOADG(0);
    for (int g0 = 0; g0 < SEQ_S; g0 += 16) {
        *(LAS f32x4*)(Kst + (tid >> 5) * 128 + (tid & 31) * 4) = (f32x4){bflo(pk.x), bfhi(pk.x), bflo(pk.y), bfhi(pk.y)};
        *(LAS f32x4*)(Qst + (tid >> 5) * 128 + (tid & 31) * 4) = (f32x4){bflo(pq.x), bfhi(pq.x), bflo(pq.y), bfhi(pq.y)};
        Vst[(tid >> 5) * 32 + (tid & 31)] = bf2f(pv);
        if (tid < 16) { Gst[tid] = __expf(pgb.x); Gst[16 + tid] = pgb.y; Gst[32 + tid] = pkq; }
        if (g0 + 16 < SEQ_S) GDN_LOADG(g0 + 16);
        __syncthreads();
#pragma unroll 2
        for (int j = 0; j < 16; ++j) {
            const f32x4 k0 = *(const LAS f32x4*)(Kst + j * 128 + kg * 8), k1 = *(const LAS f32x4*)(Kst + j * 128 + kg * 8 + 4);
            const f32x4 q0 = *(const LAS f32x4*)(Qst + j * 128 + kg * 8), q1 = *(const LAS f32x4*)(Qst + j * 128 + kg * 8 + 4);
            const float kk[8] = {k0.x, k0.y, k0.z, k0.w, k1.x, k1.y, k1.z, k1.w}, qq[8] = {q0.x, q0.y, q0.z, q0.w, q1.x, q1.y, q1.z, q1.w};
            const float vv = Vst[j * 32 + v], eg = Gst[j], be = Gst[16 + j], kq = Gst[32 + j];
            float pkk = 0.f, pqq = 0.f;
#pragma unroll
            for (int i = 0; i < 8; ++i) { S[i] *= eg; pkk += kk[i] * S[i]; pqq += qq[i] * S[i]; }
            RED[(j & 1) * 512 + kg * 32 + v] = (f32x2){pkk, pqq};
            __syncthreads();
            float ks = 0.f, qs = 0.f;
#pragma unroll
            for (int g = 0; g < 16; ++g) { const f32x2 r = RED[(j & 1) * 512 + g * 32 + v]; ks += r.x; qs += r.y; }
            const float delta = be * (vv - ks);
#pragma unroll
            for (int i = 0; i < 8; ++i) S[i] += kk[i] * delta;
            if (kg == 0) { const int s = gdn_spos(d, g0 + j); if (s >= TCX) Ob[(size_t)gdn_row(b, s) * GDW] = (qs + delta * kq) * 0.08838834764831845f; }
        }
    }
#undef GDN_LOADG
    __syncthreads();
}
__device__ __forceinline__ void gdn_combine(const Frame& F) {
    const int gw = F.vcu * 8 + F.wave, NGW = F.G * 8, lane = F.lane;
    const f32x2 gn = *(const f32x2*)(F.in[I_GNG] + 2 * lane);
    for (int row = gw; row < ML; row += NGW) {
#pragma unroll 4
        for (int h = 0; h < NH; ++h) { const size_t o = (size_t)row * GDW + h * HD + 2 * lane;
            const f32x2 a = *(const f32x2*)(F_O + o), c = *(const f32x2*)(F_O + (size_t)ML * GDW + o); const float o0 = a.x + c.x, o1 = a.y + c.y;
            const float rs = rsqrtf(wave_sum(o0 * o0 + o1 * o1) * (1.0f / HD) + EPS);
            const unsigned zw = *(const unsigned*)(F_Z + o);
            *(unsigned*)(F_MIX + (size_t)row * DM + LW + h * HD + 2 * lane) = pk2(o0 * rs * gn.x * siluf_(bflo(zw)), o1 * rs * gn.y * siluf_(bfhi(zw))); }
    }
}
__device__ __forceinline__ void lru_normalize(const Frame& F) {
    const int gw = F.vcu * 8 + F.wave, NGW = F.G * 8, lane = F.lane;
    for (int row = gw; row < ML; row += NGW) {
        const float p = lane < 16 ? F_SSQ[(size_t)row * 16 + lane] : 0.f;
        const float rs = rsqrtf(wave_sum(p) * (1.0f / LW) + EPS);
#pragma unroll
        for (int j = 0; j < 4; ++j) { const int c0 = (lane + 64 * j) * 8; u32x4* p4 = (u32x4*)(F_MIX + (size_t)row * DM + c0); const u32x4 w = *p4;
            const f32x4 g0 = *(const f32x4*)(F.in[I_LNG] + c0), g1 = *(const f32x4*)(F.in[I_LNG] + c0 + 4);
            u32x4 o; o.x = pk2(bflo(w.x) * rs * g0.x, bfhi(w.x) * rs * g0.y); o.y = pk2(bflo(w.y) * rs * g0.z, bfhi(w.y) * rs * g0.w);
            o.z = pk2(bflo(w.z) * rs * g1.x, bfhi(w.z) * rs * g1.y); o.w = pk2(bflo(w.w) * rs * g1.z, bfhi(w.w) * rs * g1.w); *p4 = o; }
    }
}
__device__ __forceinline__ void ph_x1(const Frame& F) {
    const int gw = F.vcu * 8 + F.wave, NGW = F.G * 8, lane = F.lane;
    const f32x4* gpm = (const f32x4*)F.in[I_GPOSTMIX]; const f32x4* gpf = (const f32x4*)F.in[I_GPREFFN];
    for (int row = gw; row < ML; row += NGW) {
        const f32x4* md = (const f32x4*)(F_mod + (size_t)(row / TL) * NADA);
        const f32x4* yr = (const f32x4*)(F_Y1 + (size_t)row * DM); const f32x4* xr = (const f32x4*)(F.in[I_X] + (size_t)row * DM); f32x4* outr = (f32x4*)(F.out + (size_t)row * DM);
        f32x4 y[16]; float ss = 0.f;
#pragma unroll
        for (int j = 0; j < 16; ++j) { y[j] = yr[lane + 64 * j]; ss += (y[j].x * y[j].x + y[j].y * y[j].y) + (y[j].z * y[j].z + y[j].w * y[j].w); }
        const float rs = rsqrtf(wave_sum(ss) * (1.0f / DM) + EPS); float s2 = 0.f;
#pragma unroll
        for (int j = 0; j < 16; ++j) { const f32x4 x1 = xr[lane + 64 * j] + md[2 * (DM / 4) + lane + 64 * j] * (y[j] * rs * gpm[lane + 64 * j]);
            outr[lane + 64 * j] = x1; y[j] = x1; s2 += (x1.x * x1.x + x1.y * x1.y) + (x1.z * x1.z + x1.w * x1.w); }
        const float r2 = rsqrtf(wave_sum(s2) * (1.0f / DM) + EPS);
        u32x2* o = (u32x2*)(F_H2 + (size_t)row * DM);
#pragma unroll
        for (int j = 0; j < 16; ++j) { const f32x4 hv = (y[j] * r2 * gpf[lane + 64 * j]) * (md[4 * (DM / 4) + lane + 64 * j] + 1.0f) + md[3 * (DM / 4) + lane + 64 * j];
            u32x2 w; w.x = pk2(hv.x, hv.y); w.y = pk2(hv.z, hv.w); o[lane + 64 * j] = w; }
    }
}
__device__ __forceinline__ void ph_final(const Frame& F) {
    const int gw = F.vcu * 8 + F.wave, NGW = F.G * 8, lane = F.lane;
    const f32x4* gpf = (const f32x4*)F.in[I_GPOSTFFN];
    for (int row = gw; row < ML; row += NGW) {
        const f32x4* md = (const f32x4*)(F_mod + (size_t)(row / TL) * NADA);
        const f32x4* yr = (const f32x4*)(F_Y2 + (size_t)row * DM); f32x4* outr = (f32x4*)(F.out + (size_t)row * DM);
        f32x4 y[16]; float ss = 0.f;
#pragma unroll
        for (int j = 0; j < 16; ++j) { y[j] = yr[lane + 64 * j]; ss += (y[j].x * y[j].x + y[j].y * y[j].y) + (y[j].z * y[j].z + y[j].w * y[j].w); }
        const float rs = rsqrtf(wave_sum(ss) * (1.0f / DM) + EPS);
#pragma unroll
        for (int j = 0; j < 16; ++j) outr[lane + 64 * j] = outr[lane + 64 * j] + md[5 * (DM / 4) + lane + 64 * j] * (y[j] * rs * gpf[lane + 64 * j]);
    }
}
__device__ __forceinline__ size_t gdn_item(int b, int h, int c, int d) { return ((size_t)((b * NH + h) * NCH + c)) * 2 + d; }
__device__ __forceinline__ void gdn_chunk_pre(const Frame& F) {
    LAS bf16* Kt_ = (LAS bf16*)(F.lds);
    LAS bf16* Qt_ = (LAS bf16*)(F.lds + 17408);
    LAS bf16* Vt_ = (LAS bf16*)(F.lds + 34816);
    LAS float* L_ = (LAS float*)(F.lds + 52224);
    LAS float* GC_ = (LAS float*)(F.lds + 84992);
    LAS float* BE_ = GC_ + 128;
    LAS float* BEG_ = GC_ + 256;
    LAS bf16* XW_ = (LAS bf16*)(F.lds + 86528);
    const int tid = F.tid, lane = F.lane, w = F.wave, fr = lane & 15, fq = lane >> 4;
    for (int it = F.vcu; it < NBATCH * NH * NCH; it += F.G) {
        const int c = it % NCH, bh = it / NCH, h = bh % NH, b = bh / NH;
        const size_t item0 = gdn_item(b, h, c, 0);
        __syncthreads();
        { const size_t gbase = ((size_t)b * SEQ_S + (size_t)c * 64) * GDW + h * HD;
#pragma unroll
          for (int r = 0; r < 2; ++r) { const int pc = tid + 512 * r, row = pc >> 4, cc = (pc & 15) * 8; const size_t g = gbase + (size_t)row * GDW + cc;
              *(LAS u32x4*)(Kt_ + row * 136 + cc) = *(const u32x4*)(F_KN + g); *(LAS u32x4*)(Qt_ + row * 136 + cc) = *(const u32x4*)(F_QN + g); *(LAS u32x4*)(Vt_ + row * 136 + cc) = *(const u32x4*)(F_VN + g); }
          if (tid < 128) { const int d = tid >> 6, p = tid & 63, i = d ? 63 - p : p;
              const f32x2 gb = F_GB[(size_t)((d * 2 + b) * NH + h) * SEQ_S + c * 64 + i];
              float gc = gb.x;
#pragma unroll
              for (int o = 1; o < 64; o <<= 1) { const float t = __shfl_up(gc, o); if (lane >= o) gc += t; }
              GC_[d * 64 + p] = gc; BE_[d * 64 + p] = gb.y; BEG_[d * 64 + p] = gb.y * __expf(gc);
              F_GSC[(item0 + d) * 128 + p] = 0.08838834764831845f * __expf(gc);
              if (p == 63) F_GSC[(item0 + d) * 128 + 64] = __expf(gc); } }
        __syncthreads();
        { const int mt = w >> 1; LAS bf16* IN_ = XW_;
          bf16x8 kA[4], qA[4];
#pragma unroll
          for (int ks = 0; ks < 4; ++ks) { kA[ks] = *(const LAS bf16x8*)(Kt_ + (16 * mt + fr) * 136 + 32 * ks + 8 * fq); qA[ks] = *(const LAS bf16x8*)(Qt_ + (16 * mt + fr) * 136 + 32 * ks + 8 * fq); }
#pragma unroll
          for (int t2 = 0; t2 < 2; ++t2) { const int nt = 2 * (w & 1) + t2;
              f32x4 aK = {0.f, 0.f, 0.f, 0.f}, aQ = aK;
#pragma unroll
              for (int ks = 0; ks < 4; ++ks) { const bf16x8 kB = *(const LAS bf16x8*)(Kt_ + (16 * nt + fr) * 136 + 32 * ks + 8 * fq);
                  aK = __builtin_amdgcn_mfma_f32_16x16x32_bf16(kA[ks], kB, aK, 0, 0, 0); aQ = __builtin_amdgcn_mfma_f32_16x16x32_bf16(qA[ks], kB, aQ, 0, 0, 0); }
              const int j = 16 * nt + fr, q1 = 63 - j; const float g0j = GC_[j], g1q = GC_[64 + q1];
#pragma unroll
              for (int rg = 0; rg < 4; ++rg) { const int i = 16 * mt + 4 * fq + rg, p1 = 63 - i;
                  const float e0 = i >= j ? __expf(GC_[i] - g0j) : 0.f, e1 = i <= j ? __expf(GC_[64 + p1] - g1q) : 0.f;
                  if (i > j) L_[i * 64 + j] = BE_[i] * aK[rg] * e0;
                  if (i < j) L_[4096 + p1 * 64 + q1] = BE_[64 + p1] * aK[rg] * e1;
                  const float y = aQ[rg] * 0.08838834764831845f;
                  IN_[i * 72 + j] = (bf16)f2bf(y * e0); IN_[64 * 72 + p1 * 72 + q1] = (bf16)f2bf(y * e1); } }
        }
        __syncthreads();
        { LAS bf16* IN_ = XW_;
#pragma unroll
          for (int r = 0; r < 2; ++r) { const int pc = tid + 512 * r, d = pc >> 9, row = (pc >> 3) & 63, cc = (pc & 7) * 8;
              *(u32x4*)(F_INTRA + (item0 + d) * 4096 + row * 64 + cc) = *(const LAS u32x4*)(IN_ + d * 64 * 72 + row * 72 + cc); } }
        { const int d = w >> 2, isw = (w >> 1) & 1, col = 64 * (w & 1) + lane;
          const LAS float* Ld = L_ + d * 4096; const LAS float* cf = (isw ? BEG_ : BE_) + d * 64; const LAS bf16* Tt = isw ? Kt_ : Vt_;
          float x[64];
#pragma unroll
          for (int p = 0; p < 64; ++p) { const int i = d ? 63 - p : p;
              float a0 = cf[p] * bf2f(Tt[i * 136 + col]), a1 = 0.f, a2 = 0.f, a3 = 0.f;
#pragma unroll
              for (int q4 = 0; q4 < p / 4; ++q4) { const f32x4 l = *(const LAS f32x4*)(Ld + p * 64 + 4 * q4); a0 -= l.x * x[4 * q4]; a1 -= l.y * x[4 * q4 + 1]; a2 -= l.z * x[4 * q4 + 2]; a3 -= l.w * x[4 * q4 + 3]; }
#pragma unroll
              for (int q = (p / 4) * 4; q < p; ++q) a0 -= Ld[p * 64 + q] * x[q];
              x[p] = (a0 + a1) + (a2 + a3); }
          __syncthreads();
          if (!isw) {
              u32x4* up = (u32x4*)(F_UT + (item0 + d) * 8192 + (size_t)col * 64); u32x4* kp = (u32x4*)(F_KT + (item0 + d) * 8192 + (size_t)col * 64);
              const float glast = GC_[d * 64 + 63];
#pragma unroll
              for (int p8 = 0; p8 < 8; ++p8) { u32x4 o; o.x = pk2(x[8 * p8], x[8 * p8 + 1]); o.y = pk2(x[8 * p8 + 2], x[8 * p8 + 3]); o.z = pk2(x[8 * p8 + 4], x[8 * p8 + 5]); o.w = pk2(x[8 * p8 + 6], x[8 * p8 + 7]); up[p8] = o;
                  float kt[8];
#pragma unroll
                  for (int e = 0; e < 8; ++e) { const int p = 8 * p8 + e, i = d ? 63 - p : p; kt[e] = bf2f(Kt_[i * 136 + col]) * __expf(glast - GC_[d * 64 + p]); }
                  u32x4 k4; k4.x = pk2(kt[0], kt[1]); k4.y = pk2(kt[2], kt[3]); k4.z = pk2(kt[4], kt[5]); k4.w = pk2(kt[6], kt[7]); kp[p8] = k4; }
          } else {
#pragma unroll
              for (int p = 0; p < 64; ++p) XW_[d * 64 * 136 + p * 136 + col] = (bf16)f2bf(x[p]);
          }
        }
        __syncthreads();
#pragma unroll
        for (int r = 0; r < 4; ++r) { const int pc = tid + 512 * r, d = pc >> 10, row = (pc >> 4) & 63, cc = (pc & 15) * 8;
            *(u32x4*)(F_W + (item0 + d) * 8192 + row * 128 + cc) = *(const LAS u32x4*)(XW_ + d * 64 * 136 + row * 136 + cc); }
    }
}
__device__ __forceinline__ void gdn_seq_chunked(const Frame& F, int item) {
    const int sl = item & 3, d = (item >> 2) & 1, h = (item >> 3) & 15, b = item >> 7;
    LAS bf16* St = (LAS bf16*)(F.lds);
    LAS bf16* Vt = (LAS bf16*)(F.lds + 8704);
    const int tid = F.tid, lane = F.lane, w = F.wave, fr = lane & 15, fq = lane >> 4;
    const int mt = w & 3, nt = w >> 2;
    for (int e = tid; e < 32 * 136 / 2; e += 512) ((LAS unsigned*)St)[e] = 0u;
    f32x4 S0 = {0.f, 0.f, 0.f, 0.f}, S1 = S0;
    const bf16* Qb = F_QN + (size_t)b * SEQ_S * GDW + h * HD + 8 * fq;
    float* Ob = F_O + (size_t)d * ML * GDW + h * HD + sl * 32 + 16 * nt + fr;
    struct Stg { bf16x8 wf[4], qf[4], inf[2], ktf[2]; u32x2 utv; f32x4 sqv; float gl; };
#define GDN_LOADC(G, step) do { const int c_ = d == 0 ? (step) : ((step) < 4 ? 3 - (step) : NCH - 1 - ((step) - 4)); const size_t it_ = gdn_item(b, h, c_, d); \
        const int prow_ = 16 * mt + fr, irow_ = d ? 63 - prow_ : prow_; \
        _Pragma("unroll") for (int ks = 0; ks < 4; ++ks) { G.wf[ks] = *(const bf16x8*)(F_W + it_ * 8192 + prow_ * 128 + 32 * ks + 8 * fq); G.qf[ks] = *(const bf16x8*)(Qb + (size_t)(c_ * 64 + irow_) * GDW + 32 * ks); } \
        _Pragma("unroll") for (int ks = 0; ks < 2; ++ks) { G.inf[ks] = *(const bf16x8*)(F_INTRA + it_ * 4096 + prow_ * 64 + 32 * ks + 8 * fq); G.ktf[ks] = *(const bf16x8*)(F_KT + it_ * 8192 + (16 * w + fr) * 64 + 32 * ks + 8 * fq); } \
        G.utv = *(const u32x2*)(F_UT + it_ * 8192 + (size_t)(32 * sl + 16 * nt + fr) * 64 + 16 * mt + 4 * fq); G.sqv = *(const f32x4*)(F_GSC + it_ * 128 + 16 * mt + 4 * fq); G.gl = F_GSC[it_ * 128 + 64]; } while (0)
#define GDN_STEP(G, step) do { const int c = d == 0 ? (step) : ((step) < 4 ? 3 - (step) : NCH - 1 - ((step) - 4)); \
        f32x4 aW = {0.f, 0.f, 0.f, 0.f}, aQ = aW; \
        _Pragma("unroll") for (int ks = 0; ks < 4; ++ks) { const bf16x8 bS = *(const LAS bf16x8*)(St + (16 * nt + fr) * 136 + 32 * ks + 8 * fq); \
            aW = __builtin_amdgcn_mfma_f32_16x16x32_bf16(G.wf[ks], bS, aW, 0, 0, 0); aQ = __builtin_amdgcn_mfma_f32_16x16x32_bf16(G.qf[ks], bS, aQ, 0, 0, 0); } \
        { const float v0 = bflo(G.utv.x) - aW[0], v1 = bfhi(G.utv.x) - aW[1], v2 = bflo(G.utv.y) - aW[2], v3 = bfhi(G.utv.y) - aW[3]; \
          u32x2 vn; vn.x = pk2(v0, v1); vn.y = pk2(v2, v3); *(LAS u32x2*)(Vt + (16 * nt + fr) * 72 + 16 * mt + 4 * fq) = vn; } \
        f32x4 o = aQ * G.sqv; \
        __syncthreads(); \
        { const bf16x8 b0 = *(const LAS bf16x8*)(Vt + (16 * nt + fr) * 72 + 8 * fq), b1 = *(const LAS bf16x8*)(Vt + (16 * nt + fr) * 72 + 32 + 8 * fq); \
          o = __builtin_amdgcn_mfma_f32_16x16x32_bf16(G.inf[0], b0, o, 0, 0, 0); o = __builtin_amdgcn_mfma_f32_16x16x32_bf16(G.inf[1], b1, o, 0, 0, 0); } \
        { const bf16x8 b00 = *(const LAS bf16x8*)(Vt + fr * 72 + 8 * fq), b01 = *(const LAS bf16x8*)(Vt + fr * 72 + 32 + 8 * fq); \
          const bf16x8 b10 = *(const LAS bf16x8*)(Vt + (16 + fr) * 72 + 8 * fq), b11 = *(const LAS bf16x8*)(Vt + (16 + fr) * 72 + 32 + 8 * fq); \
          S0 = S0 * G.gl; S1 = S1 * G.gl; \
          S0 = __builtin_amdgcn_mfma_f32_16x16x32_bf16(G.ktf[0], b00, S0, 0, 0, 0); S0 = __builtin_amdgcn_mfma_f32_16x16x32_bf16(G.ktf[1], b01, S0, 0, 0, 0); \
          S1 = __builtin_amdgcn_mfma_f32_16x16x32_bf16(G.ktf[0], b10, S1, 0, 0, 0); S1 = __builtin_amdgcn_mfma_f32_16x16x32_bf16(G.ktf[1], b11, S1, 0, 0, 0); \
          u32x2 s0; s0.x = pk2(S0[0], S0[1]); s0.y = pk2(S0[2], S0[3]); *(LAS u32x2*)(St + fr * 136 + 16 * w + 4 * fq) = s0; \
          u32x2 s1; s1.x = pk2(S1[0], S1[1]); s1.y = pk2(S1[2], S1[3]); *(LAS u32x2*)(St + (16 + fr) * 136 + 16 * w + 4 * fq) = s1; } \
        if (c >= 4) { _Pragma("unroll") for (int rg = 0; rg < 4; ++rg) { const int p = 16 * mt + 4 * fq + rg, i = d ? 63 - p : p; Ob[(size_t)gdn_row(b, c * 64 + i) * GDW] = o[rg]; } } \
        __syncthreads(); } while (0)
    Stg A, B, C;
    GDN_LOADC(A, 0); GDN_LOADC(B, 1);
    __syncthreads();
    static_assert(NCH % 3 == 0, "three-stage register pipeline");
    for (int step = 0; step < NCH; step += 3) {
        GDN_LOADC(C, step + 2); GDN_STEP(A, step);
        if (step + 3 < NCH) GDN_LOADC(A, step + 3); GDN_STEP(B, step + 1);
        if (step + 4 < NCH) GDN_LOADC(B, step + 4); GDN_STEP(C, step + 2);
    }
#undef GDN_STEP
#undef GDN_LOADC
}
#ifndef MK_N_LAUNCHES
#define MK_N_LAUNCHES 1
#endif
constexpr int N_PHASES = 14;
__global__ void __launch_bounds__(512, 2) fwd(Args args) {
    extern __shared__ __attribute__((aligned(16))) unsigned char lds[];
    Frame F;
    F.lds = (LAS unsigned char*)lds;
    F.tid = threadIdx.x; F.lane = F.tid & 63; F.wave = __builtin_amdgcn_readfirstlane(F.tid >> 6);
    F.G = gridDim.x; { const int bx = blockIdx.x; F.vcu = (F.G % 8 == 0) ? (bx % 8) * (F.G / 8) + bx / 8 : bx; }
    F.in = args.in; F.out = args.out; F.ws = args.ws;
    unsigned char* ws = args.ws;
    volatile LAS unsigned* MISC = (volatile LAS unsigned*)(F.lds + MISC_OFF);
    if (F.tid < 64) MISC[F.tid] = 0u;
    __syncthreads();
    const int lo = args.ph_lo, hi = args.ph_hi;
    XcdBarrier bar; bar.bar = (unsigned*)(ws + WS_CTL) + CW_BAR; bar.x = 0; bar.st = nullptr;
    if (hi - lo > 1) bar = xcd_barrier_post((unsigned*)(ws + WS_CTL) + CW_BAR, MISC + 8);
#ifndef PH_MASK
#define PH_MASK 0x3fff
#endif
#define IN(k) (((PH_MASK >> (k)) & 1) && lo <= (k) && (k) < hi)
#define SEAM(k) do { if (IN(k) && IN((k) + 1)) xcd_barrier(bar); } while (0)
    if (IN(0)) { ph0_prologue(F); } SEAM(0);
    if (IN(1)) { ph1_modreduce(F); } SEAM(1);
    if (IN(2)) { ph2_hrows(F); } SEAM(2);
    if (IN(3)) { pg8::Gemm g{F_H, F_Wt_in, MT, NINP, DM}; pg8::StaticOrder S; S.init(MT, NINP, F.G, (int)blockIdx.x);
        pg8::EpiProj E{F_LX, F_LG, F_QKV, F_Z, F_BA};
        pg8::gemm_phase<pg8::EpiProj, pg8::StaticOrder, true, true>(F.lds, g, S, E); } SEAM(3);
    if (IN(4)) { lru_pass<1>(F); gdn_pre(F); } SEAM(4);
    if (IN(5)) { lru_chains(F); gdn_chunk_pre(F); } SEAM(5);
    if (IN(6)) { for (int item = F.vcu; item < 256; item += F.G) gdn_seq_chunked(F, item); } SEAM(6);
    if (IN(7)) { lru_pass<2>(F); gdn_combine(F); } SEAM(7);
    if (IN(8)) { lru_normalize(F); } SEAM(8);
    if (IN(9)) { pg8::Gemm g{F_MIX, F_Wt_out, ML, DM, DM}; pg8::StaticOrder S; S.init(ML, DM, F.G, (int)blockIdx.x);
        pg8::EpiF32 E{F_Y1, DM};
        pg8::gemm_phase<pg8::EpiF32, pg8::StaticOrder, true, true>(F.lds, g, S, E); } SEAM(9);
    if (IN(10)) { ph_x1(F); } SEAM(10);
    if (IN(11)) { pg8::Gemm g{F_H2, F_Wt_gu, ML, 2 * DFF, DM}; pg8::StaticOrder S; S.init(ML, 2 * DFF, F.G, (int)blockIdx.x);
        pg8::EpiSwiGLU E{F_ACT, DFF};
        pg8::gemm_phase<pg8::EpiSwiGLU, pg8::StaticOrder, true, true>(F.lds, g, S, E); } SEAM(11);
    if (IN(12)) { pg8::Gemm g{F_ACT, F_Wt_dn, ML, DM, DFF}; pg8::StaticOrder S; S.init(ML, DM, F.G, (int)blockIdx.x);
        pg8::EpiF32 E{F_Y2, DM};
        pg8::gemm_phase<pg8::EpiF32, pg8::StaticOrder, true, true>(F.lds, g, S, E); } SEAM(12);
    if (IN(13)) { ph_final(F); }
#undef IN
#undef SEAM
}

extern "C" void kernel_launch(void* const* d_in, const int* in_sizes, int n_in, void* d_out, int out_size, void* d_ws, size_t ws_size, hipStream_t stream) {
    static int grid = 0;
    if (grid == 0) {
        if (n_in != N_INPUTS || in_sizes[0] != ML * DM || out_size != ML * DM || ws_size < WS_END) { fprintf(stderr, "kernel_launch: unexpected problem shape (n_in %d, in0 %d, out %d, ws %zu): nothing launched\n", n_in, n_in > 0 ? in_sizes[0] : -1, out_size, ws_size); grid = -1; return; }
        int dev = 0, cus = 0;
        if (hipGetDevice(&dev) != hipSuccess || hipDeviceGetAttribute(&cus, hipDeviceAttributeMultiprocessorCount, dev) != hipSuccess) { grid = -1; return; }
        if (hipFuncSetAttribute((const void*)fwd, hipFuncAttributeMaxDynamicSharedMemorySize, LDS_BYTES) != hipSuccess) { fprintf(stderr, "kernel_launch: hipFuncSetAttribute failed\n"); grid = -1; return; }
        (void)hipGetLastError();
        grid = cus >= 256 ? 256 : (cus / 16) * 16;
        if (grid < 16) { grid = -1; return; }
    }
    if (grid < 0) return;
    (void)hipMemsetAsync((char*)d_ws + WS_CTL, 0, CTL_ZERO_BYTES, stream);
    Args a{};
    for (int i = 0; i < N_INPUTS; ++i) a.in[i] = (const float*)d_in[i];
    a.out = (float*)d_out; a.ws = (unsigned char*)d_ws;
#if MK_N_LAUNCHES == 1
    a.ph_lo = 0; a.ph_hi = N_PHASES;
    hipLaunchKernelGGL(fwd, dim3(grid), dim3(512), LDS_BYTES, stream, a);
#else
#ifndef PROBE_REPEAT_MASK
#define PROBE_REPEAT_MASK 0
#endif
    for (int p = 0; p < N_PHASES; ++p) { a.ph_lo = p; a.ph_hi = p + 1; hipLaunchKernelGGL(fwd, dim3(grid), dim3(512), LDS_BYTES, stream, a);
        if ((PROBE_REPEAT_MASK >> p) & 1) hipLaunchKernelGGL(fwd, dim3(grid), dim3(512), LDS_BYTES, stream, a); }
#endif
}
```

```cpp
#include <hip/hip_runtime.h>
#include <cstdio>
#include <cstdint>
namespace pg8 {
#define PG8_LAS __attribute__((address_space(3)))
typedef unsigned short bf16_t;
typedef short bf16x8 __attribute__((ext_vector_type(8)));
typedef float f32x4 __attribute__((ext_vector_type(4)));
typedef unsigned u32x4 __attribute__((ext_vector_type(4)));
constexpr int BM = 256, BK = 64, HALF = 128, HTB = HALF * BK * 2  , STAGE_BYTES = 8 * HTB, NXCD = 8, WGM = 8;

__host__ __device__ __forceinline__ int lds_byte(int r, int c) { const int st = (r >> 4) * 2 + (c >> 5), rr = r & 15, cc = c & 31, ob = rr * 64 + cc * 2; return st * 1024 + (ob ^ (((ob >> 9) & 1) << 5)); }
__host__ __device__ __forceinline__ void stage_rc(int b, int& R, int& C) { const int st = b / 1024, sb = b % 1024, swz = sb ^ (((sb >> 9) & 1) << 5); R = (st >> 1) * 16 + swz / 64; C = (st & 1) * 32 + (swz % 64) / 2; }
__host__ __device__ __forceinline__ int perm32(int rho) { const int n = rho >> 4, i = rho & 15; return 8 * (i >> 2) + 4 * n + (i & 3); }

struct Unit { int pm, pn; };
struct Gemm { const bf16_t* A; const bf16_t* Bt; int M, N, K; };

struct StaticOrder {
    int nM, nN, nwg, G, c;
    __host__ __device__ void init(int M, int N, int G_, int c_) { nM = M / BM; nN = N / BM; nwg = nM * nN; G = G_; c = c_; }
    __host__ __device__ bool next(int i, Unit& u) const {
        const long L = (long)i * G + c; if (L >= nwg) return false;
        int wgid = (int)L; { const int q = nwg / NXCD, r = nwg % NXCD, xcd = wgid % NXCD, off = wgid / NXCD; wgid = (xcd < r ? xcd * (q + 1) : r * (q + 1) + (xcd - r) * q) + off; }
        const int nig = WGM * nN, gid = wgid / nig, fm = gid * WGM, gsz = (nM - fm) < WGM ? (nM - fm) : WGM;
        u.pm = fm + ((wgid % nig) % gsz); u.pn = (wgid % nig) / gsz; return true;
    }
    __device__ __forceinline__ void a_ready(const Unit&) const {}
    __device__ __forceinline__ void done(const Unit&) const {}
};
__device__ __forceinline__ unsigned cvt_pk_bf16(float lo, float hi) { unsigned r; asm volatile("v_cvt_pk_bf16_f32 %0, %1, %2" : "=v"(r) : "v"(lo), "v"(hi)); return r; }
struct EpiF32 {
    static constexpr bool PERM = false, AFTER_DRAIN = false;
    float* C; int ldc;
    __device__ __forceinline__ void operator()(const f32x4 (&acc)[2][2][4][2], const Unit& u, int wr, int wc, int fr, int fq) const {
        const int row0 = u.pm * BM + wr * 64 + fr, col0 = u.pn * BM + wc * 32 + 4 * fq;
#pragma unroll
        for (int ai = 0; ai < 2; ++ai)
#pragma unroll
            for (int m = 0; m < 4; ++m) { float* rowp = C + (size_t)(row0 + ai * HALF + m * 16) * ldc + col0;
#pragma unroll
                for (int bj = 0; bj < 2; ++bj)
#pragma unroll
                    for (int n = 0; n < 2; ++n) *(f32x4*)(rowp + bj * HALF + n * 16) = acc[ai][bj][m][n]; }
    }
};
struct EpiProj {
    static constexpr bool PERM = true, AFTER_DRAIN = false;
    bf16_t *lx, *lg, *qkv, *z, *ba;
    __device__ __forceinline__ void operator()(const f32x4 (&acc)[2][2][4][2], const Unit& u, int wr, int wc, int fr, int fq) const {
        const int pn = u.pn; bf16_t* base; int ld, colt;
        if (pn < 8) { base = lx; ld = 2048; colt = pn * BM; }
        else if (pn < 16) { base = lg; ld = 2048; colt = (pn - 8) * BM; }
        else if (pn < 40) { base = qkv; ld = 6144; colt = (pn - 16) * BM; }
        else if (pn < 48) { base = z; ld = 2048; colt = (pn - 40) * BM; }
        else { base = ba; ld = 256; colt = 0; }
        const int row0 = u.pm * BM + wr * 64 + fr, col0 = colt + wc * 32 + 8 * fq;
#pragma unroll
        for (int ai = 0; ai < 2; ++ai)
#pragma unroll
            for (int m = 0; m < 4; ++m) { bf16_t* rowp = base + (size_t)(row0 + ai * HALF + m * 16) * ld + col0;
#pragma unroll
                for (int bj = 0; bj < 2; ++bj) { const f32x4 v0 = acc[ai][bj][m][0], v1 = acc[ai][bj][m][1];
                    u32x4 w; w.x = cvt_pk_bf16(v0[0], v0[1]); w.y = cvt_pk_bf16(v0[2], v0[3]); w.z = cvt_pk_bf16(v1[0], v1[1]); w.w = cvt_pk_bf16(v1[2], v1[3]);
                    *(u32x4*)(rowp + bj * HALF) = w; } }
    }
};
struct EpiSwiGLU {
    static constexpr bool PERM = true, AFTER_DRAIN = false;
    bf16_t* O; int ldc;
    __device__ __forceinline__ void operator()(const f32x4 (&acc)[2][2][4][2], const Unit& u, int wr, int wc, int fr, int fq) const {
        const int row0 = u.pm * BM + wr * 64 + fr, col0 = u.pn * HALF + wc * 32 + 8 * fq;
#pragma unroll
        for (int ai = 0; ai < 2; ++ai)
#pragma unroll
            for (int m = 0; m < 4; ++m) { bf16_t* rowp = O + (size_t)(row0 + ai * HALF + m * 16) * ldc + col0;
                float r[8];
#pragma unroll
                for (int n = 0; n < 2; ++n)
#pragma unroll
                    for (int j = 0; j < 4; ++j) { const float g = acc[ai][0][m][n][j], up = acc[ai][1][m][n][j]; r[4 * n + j] = g * __builtin_amdgcn_rcpf(1.0f + __expf(-g)) * up; }
                u32x4 w; w.x = cvt_pk_bf16(r[0], r[1]); w.y = cvt_pk_bf16(r[2], r[3]); w.z = cvt_pk_bf16(r[4], r[5]); w.w = cvt_pk_bf16(r[6], r[7]);
                *(u32x4*)rowp = w; }
    }
};

template <class Epi, class Sched, bool ALIGN_EPI = false, bool SP2 = false>
__device__ __forceinline__ void gemm_phase(PG8_LAS unsigned char* lds, const Gemm g, const Sched& S, const Epi& E) {
    const int tid = threadIdx.x, wid = __builtin_amdgcn_readfirstlane(tid >> 6), lane = tid & 63, wr = wid >> 2, wc = wid & 3, fr = lane & 15, fq = lane >> 4;
    const int K = g.K, nt = K / BK;
    unsigned voffA[2], voffB[2];
#pragma unroll
    for (int i = 0; i < 2; ++i) { int R, C; stage_rc(tid * 16 + i * 8192, R, C); const int Rb = Epi::PERM ? ((R & ~31) + perm32(R & 31)) : R;
        voffA[i] = (unsigned)(R * K + C) * 2u; voffB[i] = (unsigned)(Rb * K + C) * 2u; }
    const size_t kstep = (size_t)(BK * 2);
    const size_t hstep = (size_t)HALF * K * 2;
    const size_t tstep = 2 * hstep;
    const unsigned ldsw = (unsigned)wid * 1024u;
    const int aoff = lds_byte(wr * 64 + fr, fq * 8), boff = lds_byte(wc * 32 + fr, fq * 8);
#define PG8_SA(b, h) (((b) * 2 + (h)) * HTB)
#define PG8_SB(b, h) ((4 + (b) * 2 + (h)) * HTB)
#define PG8_STAGE(bufoff, gbase, voff) do { _Pragma("unroll") for (int _i = 0; _i < 2; ++_i) \
        __builtin_amdgcn_global_load_lds((const unsigned*)((const char*)(gbase) + (voff)[_i]), (PG8_LAS unsigned*)(lds + (bufoff) + ldsw + _i * 8192), 16, 0, 0); } while (0)
#define PG8_LDA(dst, b, h) do { _Pragma("unroll") for (int m = 0; m < 4; ++m) _Pragma("unroll") for (int k = 0; k < 2; ++k) dst[m][k] = *(const PG8_LAS bf16x8*)(lds + PG8_SA(b, h) + aoff + m * 2048 + k * 1024); } while (0)
#define PG8_LDB(dst, b, h) do { _Pragma("unroll") for (int n = 0; n < 2; ++n) _Pragma("unroll") for (int k = 0; k < 2; ++k) dst[n][k] = *(const PG8_LAS bf16x8*)(lds + PG8_SB(b, h) + boff + n * 2048 + k * 1024); } while (0)
#define PG8_MMA(ai, bj, At, Bt) do { __builtin_amdgcn_s_setprio(1); _Pragma("unroll") for (int m = 0; m < 4; ++m) _Pragma("unroll") for (int n = 0; n < 2; ++n) _Pragma("unroll") for (int k = 0; k < 2; ++k) \
        acc[ai][bj][m][n] = __builtin_amdgcn_mfma_f32_16x16x32_bf16(Bt[n][k], At[m][k], acc[ai][bj][m][n], 0, 0, 0); __builtin_amdgcn_s_setprio(0); } while (0)
#define PG8_WAIT_V(n) asm volatile("s_waitcnt vmcnt(" #n ")" ::: "memory")
#define PG8_WAIT_L(n) asm volatile("s_waitcnt lgkmcnt(" #n ")" ::: "memory")
#define PG8_BAR __builtin_amdgcn_s_barrier()
#define PG8_SCHED __builtin_amdgcn_sched_barrier(0)
    Unit cur, nxt; int ui = 0;
    if (!S.next(0, cur)) return;
    f32x4 acc[2][2][4][2];
#pragma unroll
    for (int a = 0; a < 2; ++a)
#pragma unroll
        for (int b = 0; b < 2; ++b)
#pragma unroll
            for (int m = 0; m < 4; ++m)
#pragma unroll
                for (int n = 0; n < 2; ++n) acc[a][b][m][n] = (f32x4){0.f, 0.f, 0.f, 0.f};
    bf16x8 At[4][2], B0[2][2], B1[2][2];
    const char* cA = (const char*)g.A + (size_t)cur.pm * tstep; const char* cB = (const char*)g.Bt + (size_t)cur.pn * tstep;
    S.a_ready(cur);
    if constexpr (SP2) {
        PG8_STAGE(PG8_SB(0, 0), cB, voffB); PG8_STAGE(PG8_SB(0, 1), cB + hstep, voffB); PG8_STAGE(PG8_SA(0, 0), cA, voffA); PG8_STAGE(PG8_SA(0, 1), cA + hstep, voffA);
        if (wr == 1) PG8_BAR;
        PG8_WAIT_V(2); PG8_BAR;
        PG8_STAGE(PG8_SB(1, 0), cB + kstep, voffB); PG8_STAGE(PG8_SA(1, 0), cA + kstep, voffA); PG8_STAGE(PG8_SB(1, 1), cB + hstep + kstep, voffB);
        PG8_WAIT_V(6); PG8_BAR;
    } else {
        PG8_STAGE(PG8_SB(0, 0), cB, voffB); PG8_STAGE(PG8_SA(0, 0), cA, voffA); PG8_STAGE(PG8_SB(0, 1), cB + hstep, voffB); PG8_STAGE(PG8_SA(0, 1), cA + hstep, voffA);
        if (wr == 1) PG8_BAR;
        PG8_WAIT_V(4); PG8_BAR;
        PG8_STAGE(PG8_SB(1, 0), cB + kstep, voffB); PG8_STAGE(PG8_SA(1, 0), cA + kstep, voffA); PG8_STAGE(PG8_SB(1, 1), cB + hstep + kstep, voffB);
        PG8_WAIT_V(6); PG8_BAR;
    }
    for (;;) {
        const bool has_next = S.next(ui + 1, nxt);
        const char* nA = has_next ? (const char*)g.A + (size_t)nxt.pm * tstep : cA; const char* nB = has_next ? (const char*)g.Bt + (size_t)nxt.pn * tstep : cB;
        for (int t = 0; t < nt; t += 2) {
            const bool last = (t == nt - 2);
            const char* a1 = cA + (size_t)(t + 1) * kstep;
            const char* a2 = last ? nA : cA + (size_t)(t + 2) * kstep; const char* b2 = last ? nB : cB + (size_t)(t + 2) * kstep;
            const char* a3 = a2 + kstep; const char* b3 = b2 + kstep;
            if (last && has_next) S.a_ready(nxt);
            if constexpr (SP2) {
            PG8_LDB(B0, 0, 0); PG8_LDB(B1, 0, 1); PG8_SCHED; PG8_LDA(At, 0, 0); PG8_STAGE(PG8_SA(1, 1), a1 + hstep, voffA);
            PG8_WAIT_V(8); PG8_WAIT_L(0); PG8_BAR; PG8_MMA(0, 0, At, B0); PG8_MMA(0, 1, At, B1); PG8_BAR; PG8_SCHED;
            PG8_LDA(At, 0, 1); PG8_STAGE(PG8_SB(0, 0), b2, voffB); PG8_STAGE(PG8_SB(0, 1), b2 + hstep, voffB); PG8_STAGE(PG8_SA(0, 0), a2, voffA);
            PG8_WAIT_V(8); PG8_WAIT_L(0); PG8_BAR; PG8_MMA(1, 0, At, B0); PG8_MMA(1, 1, At, B1); PG8_BAR; PG8_SCHED;
            PG8_LDB(B0, 1, 0); PG8_LDB(B1, 1, 1); PG8_SCHED; PG8_LDA(At, 1, 0); PG8_STAGE(PG8_SA(0, 1), a2 + hstep, voffA);
            PG8_WAIT_V(8); PG8_WAIT_L(0); PG8_BAR; PG8_MMA(0, 0, At, B0); PG8_MMA(0, 1, At, B1); PG8_BAR; PG8_SCHED;
            PG8_LDA(At, 1, 1); PG8_STAGE(PG8_SB(1, 0), b3, voffB); PG8_STAGE(PG8_SB(1, 1), b3 + hstep, voffB); PG8_STAGE(PG8_SA(1, 0), a3, voffA);
            PG8_WAIT_V(8); PG8_WAIT_L(0); PG8_BAR; PG8_MMA(1, 0, At, B0); PG8_MMA(1, 1, At, B1); PG8_BAR; PG8_SCHED;
            } else {
            PG8_LDB(B0, 0, 0); PG8_SCHED; PG8_LDA(At, 0, 0); PG8_STAGE(PG8_SA(1, 1), a1 + hstep, voffA);
            PG8_WAIT_L(8); PG8_BAR; PG8_WAIT_L(0); PG8_MMA(0, 0, At, B0); PG8_BAR; PG8_SCHED;
            PG8_LDB(B1, 0, 1); PG8_STAGE(PG8_SB(0, 0), b2, voffB);
            PG8_BAR; PG8_WAIT_L(0); PG8_MMA(0, 1, At, B1); PG8_BAR;
            PG8_LDA(At, 0, 1); PG8_STAGE(PG8_SA(0, 0), a2, voffA);
            PG8_BAR; PG8_WAIT_L(0); PG8_MMA(1, 0, At, B0); PG8_BAR; PG8_SCHED;
            PG8_STAGE(PG8_SB(0, 1), b2 + hstep, voffB);
            PG8_WAIT_V(6); PG8_BAR; PG8_MMA(1, 1, At, B1); PG8_BAR;
            PG8_LDB(B0, 1, 0); PG8_SCHED; PG8_LDA(At, 1, 0); PG8_STAGE(PG8_SA(0, 1), a2 + hstep, voffA);
            PG8_WAIT_L(8); PG8_BAR; PG8_WAIT_L(0); PG8_MMA(0, 0, At, B0); PG8_BAR; PG8_SCHED;
            PG8_LDB(B1, 1, 1); PG8_STAGE(PG8_SB(1, 0), b3, voffB);
            PG8_BAR; PG8_WAIT_L(0); PG8_MMA(0, 1, At, B1); PG8_BAR;
            PG8_LDA(At, 1, 1); PG8_STAGE(PG8_SA(1, 0), a3, voffA);
            PG8_BAR; PG8_WAIT_L(0); PG8_MMA(1, 0, At, B0); PG8_BAR; PG8_SCHED;
            PG8_STAGE(PG8_SB(1, 1), b3 + hstep, voffB);
            PG8_WAIT_V(6); PG8_BAR; PG8_MMA(1, 1, At, B1); PG8_BAR;
            }
        }
        if constexpr (ALIGN_EPI) { if (wr == 0) PG8_BAR; }
        if constexpr (!Epi::AFTER_DRAIN) { E(acc, cur, wr, wc, fr, fq); S.done(cur); }
        if (!has_next) break;
#pragma unroll
        for (int a = 0; a < 2; ++a)
#pragma unroll
            for (int b = 0; b < 2; ++b)
#pragma unroll
                for (int m = 0; m < 4; ++m)
#pragma unroll
                    for (int n = 0; n < 2; ++n) acc[a][b][m][n] = (f32x4){0.f, 0.f, 0.f, 0.f};
        cur = nxt; cA = nA; cB = nB; ++ui;
        if constexpr (ALIGN_EPI) { if (wr == 1) PG8_BAR; }
    }
    PG8_WAIT_V(0);
    if constexpr (!ALIGN_EPI) { if (wr == 0) PG8_BAR; }
    PG8_BAR;
    if constexpr (Epi::AFTER_DRAIN) { E.fused(acc, cur, wr, wc, fr, fq, lds, wid, lane); S.done(cur); }
#undef PG8_SA
#undef PG8_SB
#undef PG8_STAGE
#undef PG8_LDA
#undef PG8_LDB
#undef PG8_MMA
#undef PG8_WAIT_V
#undef PG8_WAIT_L
#undef PG8_BAR
#undef PG8_SCHED
}
}
constexpr int DM = 4096, NBATCH = 2, TL = 8192, TCX = 256, ML = NBATCH * TL, MC = NBATCH * TCX, MT = ML + MC;
constexpr int LW = 2048, GDW = 2048, NH = 16, HD = 128, DFF = 11008, NIN = 12352, NINP = 12544, NADA = 6 * DM;
constexpr int SEQ_S = TCX + TL;
constexpr int NCH = 132;
constexpr float EPS = 1e-6f;
enum { I_X = 0, I_C, I_CTX, I_CCTX, I_WADA, I_BADA, I_GPREMIX, I_GPOSTMIX, I_GPREFFN, I_GPOSTFFN, I_WIN, I_LCW, I_LCB, I_LWA, I_LBA, I_LWX, I_LBX, I_LLAM, I_LNG, I_GCW, I_GALOG, I_GDT, I_GNG, I_WOUT, I_WG, I_WU, I_WD, N_INPUTS };

constexpr size_t MiB = 1u << 20;
constexpr size_t WS_CTL = 0, CTL_ZERO_BYTES = 1 * MiB;
constexpr size_t WS_MODP = 1 * MiB, WS_MOD = 11 * MiB, WS_WL = 12 * MiB, WS_CAR = 14 * MiB, WS_HIN = 23 * MiB, WS_GB = 28 * MiB, WS_KQ = 33 * MiB, WS_SSQ = 35 * MiB;
constexpr size_t WS_WOUT = 44 * MiB, WS_WGU = 76 * MiB, WS_WDN = 248 * MiB;
constexpr size_t WS_R2 = 334 * MiB;
constexpr size_t WS_WIN = WS_R2, WS_H = WS_R2 + 98 * MiB;
constexpr size_t WS_QN = WS_R2, WS_KN = WS_R2 + 66 * MiB, WS_VN = WS_R2 + 132 * MiB;
constexpr size_t WS_H2 = WS_R2, WS_Y2 = WS_R2;
constexpr size_t WS_R3 = 590 * MiB;
constexpr size_t WS_LX = WS_R3, WS_LG = WS_R3 + 66 * MiB, WS_QKV = WS_R3 + 132 * MiB, WS_Z = WS_R3 + 330 * MiB, WS_BA = WS_R3 + 396 * MiB;
constexpr size_t WS_Y1 = WS_R3, WS_ACT = WS_R3;
constexpr size_t WS_MIX = 995 * MiB;
constexpr size_t WS_UT = 1123 * MiB, WS_W = 1255 * MiB, WS_INTRA = 1387 * MiB, WS_END = 1453 * MiB;
constexpr size_t WS_KT = WS_QKV, WS_GSC = 37 * MiB;
static_assert(WS_SSQ + (size_t)ML * 16 * 4 <= WS_WOUT && WS_WOUT + (size_t)DM * DM * 2 <= WS_WGU && WS_WGU + (size_t)2 * DFF * DM * 2 <= WS_WDN && WS_WDN + (size_t)DM * DFF * 2 <= WS_R2, "ws map 1");
static_assert(WS_WIN + (size_t)NINP * DM * 2 <= WS_H && WS_H + (size_t)MT * DM * 2 <= WS_R3 && WS_VN + (size_t)NBATCH * SEQ_S * 2048 * 2 <= WS_R3 && WS_Y2 + (size_t)ML * DM * 4 <= WS_R3, "ws map 2");
static_assert((size_t)MT * 2048 * 2 <= 66 * MiB && (size_t)MT * 6144 * 2 <= 198 * MiB && WS_BA + (size_t)MT * 256 * 2 <= WS_MIX && WS_ACT + (size_t)ML * DFF * 2 <= WS_MIX && WS_MIX + (size_t)ML * DM * 2 <= WS_UT, "ws map 3");
static_assert((size_t)NBATCH * NH * NCH * 2 * 8192 * 2 == 132 * MiB && WS_KT + 132 * MiB <= WS_Z && WS_GSC + (size_t)NBATCH * NH * NCH * 2 * 128 * 4 <= WS_WOUT && WS_SSQ + (size_t)ML * 16 * 4 <= WS_GSC, "ws map 4");
constexpr int CW_BAR = 4096;

constexpr int LDS_BYTES = 147456;
constexpr int MISC_OFF = LDS_BYTES - 256;

#define GAS __attribute__((address_space(1)))
#define LAS __attribute__((address_space(3)))
typedef unsigned short bf16;
typedef unsigned u32x4 __attribute__((ext_vector_type(4)));
typedef unsigned u32x2 __attribute__((ext_vector_type(2)));
typedef float f32x4 __attribute__((ext_vector_type(4)));
typedef float f32x2 __attribute__((ext_vector_type(2)));
typedef short bf16x8 __attribute__((ext_vector_type(8)));
#define LDS_WAIT() asm volatile("s_waitcnt lgkmcnt(0)" ::: "memory")
#define WAVE_LDS_FENCE() do { asm volatile("s_waitcnt lgkmcnt(0)" ::: "memory"); __builtin_amdgcn_wave_barrier(); } while (0)
__device__ __forceinline__ unsigned f2bf(float f) { unsigned u = __builtin_bit_cast(unsigned, f); return (u + 0x7fffu + ((u >> 16) & 1u)) >> 16; }
__device__ __forceinline__ unsigned pk2(float lo, float hi) { return f2bf(lo) | (f2bf(hi) << 16); }
__device__ __forceinline__ float bf2f(unsigned h) { return __builtin_bit_cast(float, h << 16); }
__device__ __forceinline__ float bflo(unsigned w) { return __builtin_bit_cast(float, w << 16); }
__device__ __forceinline__ float bfhi(unsigned w) { return __builtin_bit_cast(float, w & 0xffff0000u); }
__device__ __forceinline__ float wave_sum(float v) {
#pragma unroll
    for (int o = 1; o < 64; o <<= 1) v += __shfl_xor(v, o);
    return v;
}
__device__ __forceinline__ float sigmoidf_(float x) { return __builtin_amdgcn_rcpf(1.0f + __expf(-x)); }
__device__ __forceinline__ float siluf_(float x) { return x * sigmoidf_(x); }
__device__ __forceinline__ float softplusf_(float x) { return x > 20.f ? x : log1pf(__expf(x)); }
__device__ __forceinline__ float gelu_tanhf_(float x) { const float u = 0.7978845608028654f * (x + 0.044715f * x * x * x); const float t = 1.0f - 2.0f * __builtin_amdgcn_rcpf(__expf(2.0f * u) + 1.0f); return 0.5f * x * (1.0f + t); }
__device__ __forceinline__ float rdlane(float x, int l) { return __builtin_bit_cast(float, __builtin_amdgcn_readlane(__builtin_bit_cast(int, x), l)); }

#define XB_TMO      128
#define XB_XCNT(j)  (256  + 64 * (j))
#define XB_XSUB(j)  (1280 + 64 * (j))
#define XB_XGEN(j)  (2304 + 64 * (j))
#define XB_TOP      3328
#define XB_TOPGEN   3392
#define XCD_BAR_WORDS 3456
#define XB_SPIN_CAP (1u << 22)
__device__ __forceinline__ unsigned xb_ld(unsigned* p)              { return __hip_atomic_load(p, __ATOMIC_RELAXED, __HIP_MEMORY_SCOPE_AGENT); }
__device__ __forceinline__ unsigned xb_add(unsigned* p, unsigned v) { return __hip_atomic_fetch_add(p, v, __ATOMIC_RELAXED, __HIP_MEMORY_SCOPE_AGENT); }
__device__ __forceinline__ unsigned xb_xcc_id() { return (unsigned)__builtin_amdgcn_s_getreg((3 << 11) | 20) & 0xFu; }
#define XB_SPIN(cond, bar) do { unsigned _sp = 0; while (cond) { __builtin_amdgcn_s_sleep(1); \
    if ((++_sp & 255u) == 0u) { if (xb_ld(&(bar)[XB_TMO])) break; if (_sp > XB_SPIN_CAP) { atomicAdd(&(bar)[XB_TMO], 1u); break; } } } } while (0)
struct XcdBarrier { unsigned* bar; unsigned x; volatile LAS unsigned* st; };
__device__ __forceinline__ XcdBarrier xcd_barrier_post(unsigned* bar, volatile LAS unsigned* st) {
    XcdBarrier b; b.bar = bar; b.x = xb_xcc_id(); b.st = st;
    if (threadIdx.x == 0) (void)xb_add(&bar[XB_XCNT(b.x)], 1u);
    return b;
}
__device__ __forceinline__ void xcd_barrier_complete(unsigned* bar, unsigned x, unsigned& nloc, unsigned& nx) {
    const unsigned G = gridDim.x * gridDim.y * gridDim.z;
    unsigned sum, cnt, mine, sp = 0u;
    for (;;) {
        sum = 0u; cnt = 0u; mine = 0u;
#pragma unroll
        for (unsigned j = 0; j < 16; ++j) { const unsigned c = xb_ld(&bar[XB_XCNT(j)]); sum += c; cnt += (c > 0u) ? 1u : 0u; mine = (j == x) ? c : mine; }
        if (sum == G) break;
        __builtin_amdgcn_s_sleep(1);
        if ((++sp & 255u) == 0u) { if (xb_ld(&bar[XB_TMO])) break; if (sp > XB_SPIN_CAP) { atomicAdd(&bar[XB_TMO], 1u); break; } }
    }
    nloc = mine > 0u ? mine : 1u; nx = cnt > 0u ? cnt : 1u;
}
__device__ __forceinline__ void xcd_barrier(const XcdBarrier& b) {
    asm volatile("s_waitcnt vmcnt(0)" ::: "memory");
    __syncthreads();
    if (threadIdx.x == 0) {
        unsigned* bar = b.bar;
        __builtin_amdgcn_s_waitcnt(0);
        unsigned nloc = b.st[0], nx = b.st[1];
        if (nloc == 0u) { xcd_barrier_complete(bar, b.x, nloc, nx); b.st[0] = nloc; b.st[1] = nx; }
        const unsigned old = xb_add(&bar[XB_XSUB(b.x)], 1u);
        const unsigned gen = old / nloc;
        if (old + 1u == (gen + 1u) * nloc) {
            __builtin_amdgcn_fence(__ATOMIC_RELEASE, "agent");
            asm volatile("s_waitcnt vmcnt(0)" ::: "memory");
            const unsigned og = xb_add(&bar[XB_TOP], 1u);
            const unsigned tg = og / nx;
            if (og + 1u == (tg + 1u) * nx) xb_add(&bar[XB_TOPGEN], 1u);
            else XB_SPIN(xb_ld(&bar[XB_TOPGEN]) == tg, bar);
            __builtin_amdgcn_fence(__ATOMIC_ACQUIRE, "agent");
            xb_add(&bar[XB_XGEN(b.x)], 1u);
            asm volatile("s_waitcnt vmcnt(0)" ::: "memory");
        } else {
            XB_SPIN(xb_ld(&bar[XB_XGEN(b.x)]) == gen, bar);
            __builtin_amdgcn_fence(__ATOMIC_ACQUIRE, "agent");
            asm volatile("s_waitcnt vmcnt(0)" ::: "memory");
        }
    }
    __syncthreads();
}

struct Args { const float* in[N_INPUTS]; float* out; unsigned char* ws; int ph_lo, ph_hi; };
struct Frame {
    LAS unsigned char* lds;
    int tid, lane, wave, vcu, G;
    const float* const* in;
    float* out; unsigned char* ws;
};
#define F_modp ((float*)(F.ws + WS_MODP))
#define F_mod ((float*)(F.ws + WS_MOD))
#define F_WL ((bf16*)(F.ws + WS_WL))
#define F_CAR ((f32x2*)(F.ws + WS_CAR))
#define F_HIN ((float*)(F.ws + WS_HIN))
#define F_GB ((f32x2*)(F.ws + WS_GB))
#define F_KQ ((float*)(F.ws + WS_KQ))
#define F_SSQ ((float*)(F.ws + WS_SSQ))
#define F_Wt_out ((bf16*)(F.ws + WS_WOUT))
#define F_Wt_gu ((bf16*)(F.ws + WS_WGU))
#define F_Wt_dn ((bf16*)(F.ws + WS_WDN))
#define F_Wt_in ((bf16*)(F.ws + WS_WIN))
#define F_H ((bf16*)(F.ws + WS_H))
#define F_QN ((bf16*)(F.ws + WS_QN))
#define F_KN ((bf16*)(F.ws + WS_KN))
#define F_VN ((bf16*)(F.ws + WS_VN))
#define F_H2 ((bf16*)(F.ws + WS_H2))
#define F_LX ((bf16*)(F.ws + WS_LX))
#define F_LG ((bf16*)(F.ws + WS_LG))
#define F_QKV ((bf16*)(F.ws + WS_QKV))
#define F_Z ((bf16*)(F.ws + WS_Z))
#define F_BA ((bf16*)(F.ws + WS_BA))
#define F_ACT ((bf16*)(F.ws + WS_ACT))
#define F_MIX ((bf16*)(F.ws + WS_MIX))
#define F_Y1 ((float*)(F.ws + WS_Y1))
#define F_Y2 ((float*)(F.ws + WS_Y2))
#define F_O (F.out)
#define F_UT ((bf16*)(F.ws + WS_UT))
#define F_W ((bf16*)(F.ws + WS_W))
#define F_INTRA ((bf16*)(F.ws + WS_INTRA))
#define F_KT ((bf16*)(F.ws + WS_KT))
#define F_GSC ((float*)(F.ws + WS_GSC))
__device__ __forceinline__ void transpose_item(const float* W, int N, bf16* WT, int Kp, int k0, int n0, int drow0, LAS float* scr, int lane) {
#pragma unroll 8
    for (int i = 0; i < 32; ++i) { const int kk = 2 * i + (lane >> 5); scr[kk * 33 + (lane & 31)] = W[(size_t)(k0 + kk) * N + n0 + (lane & 31)]; }
    LDS_WAIT(); asm volatile("" ::: "memory");
    const int c = lane & 7;
#pragma unroll
    for (int j = 0; j < 4; ++j) { const int n = (lane >> 3) + 8 * j; const LAS float* s = scr + (8 * c) * 33 + n;
        u32x4 o; o.x = pk2(s[0 * 33], s[1 * 33]); o.y = pk2(s[2 * 33], s[3 * 33]); o.z = pk2(s[4 * 33], s[5 * 33]); o.w = pk2(s[6 * 33], s[7 * 33]);
        *(u32x4*)(WT + (size_t)(drow0 + n) * Kp + k0 + 8 * c) = o; }
    LDS_WAIT(); asm volatile("" ::: "memory");
}

__device__ __forceinline__ void ph0_prologue(const Frame& F) {
    const int gw = F.vcu * 8 + F.wave, NGW = F.G * 8, lane = F.lane;
    {
        const float* W = F.in[I_WADA]; const float* c = F.in[I_C]; const float* cc = F.in[I_CCTX];
        for (int it = gw; it < 96 * 32; it += NGW) {
            const int cg = it % 96, kc = it / 96;
            float sv[3][2];
#pragma unroll
            for (int h = 0; h < 2; ++h) { const int k = kc * 128 + h * 64 + lane; sv[0][h] = siluf_(c[k]); sv[1][h] = siluf_(c[DM + k]); sv[2][h] = siluf_(cc[k]); }
            f32x4 a0 = {0.f, 0.f, 0.f, 0.f}, a1 = a0, a2 = a0;
            const f32x4* wp = (const f32x4*)(W + (size_t)kc * 128 * NADA + cg * 256) + lane;
#pragma unroll
            for (int h = 0; h < 2; ++h) {
#pragma unroll 8
                for (int kk = 0; kk < 64; ++kk) { const f32x4 w = wp[(size_t)(h * 64 + kk) * (NADA / 4)];
                    const float s0 = rdlane(sv[0][h], kk), s1 = rdlane(sv[1][h], kk), s2 = rdlane(sv[2][h], kk);
                    a0 += w * s0; a1 += w * s1; a2 += w * s2; } }
            float* mp = F_modp + (size_t)(kc * 3) * NADA + cg * 256;
            ((f32x4*)mp)[lane] = a0; ((f32x4*)(mp + NADA))[lane] = a1; ((f32x4*)(mp + 2 * NADA))[lane] = a2;
        }
    }
    {
        LAS float* scr = (LAS float*)(F.lds + F.wave * 16384);
        constexpr int IT_IN = 64 * (NIN / 32), IT_OUT = 64 * (DM / 32), IT_G = 64 * (DFF / 32), IT_D = (DFF / 64) * (DM / 32), IT_L = 64 * 8;
        constexpr int NITEMS = IT_IN + IT_OUT + 2 * IT_G + IT_D + IT_L;
        for (int it = gw; it < NITEMS; it += NGW) {
            int r = it;
            if (r < IT_IN) { const int kb = r / (NIN / 32), nb = r % (NIN / 32); transpose_item(F.in[I_WIN], NIN, F_Wt_in, DM, 64 * kb, 32 * nb, 32 * nb, scr, lane); continue; } r -= IT_IN;
            if (r < IT_OUT) { const int kb = r / (DM / 32), nb = r % (DM / 32); transpose_item(F.in[I_WOUT], DM, F_Wt_out, DM, 64 * kb, 32 * nb, 32 * nb, scr, lane); continue; } r -= IT_OUT;
            if (r < 2 * IT_G) { const int up = r >= IT_G; if (up) r -= IT_G; const int kb = r / (DFF / 32), nb = r % (DFF / 32), n0 = 32 * nb;
                transpose_item(F.in[up ? I_WU : I_WG], DFF, F_Wt_gu, DM, 64 * kb, n0, 256 * (n0 >> 7) + (n0 & 127) + (up ? 128 : 0), scr, lane); continue; } r -= 2 * IT_G;
            if (r < IT_D) { const int kb = r / (DM / 32), nb = r % (DM / 32); transpose_item(F.in[I_WD], DM, F_Wt_dn, DFF, 64 * kb, 32 * nb, 32 * nb, scr, lane); continue; } r -= IT_D;
            { const int mi = r >> 3, sub = r & 7, kb = sub >> 2, nb = sub & 3, d = mi >> 5, kind = (mi >> 4) & 1, n = mi & 15;
              transpose_item(F.in[kind ? I_LWX : I_LWA] + (size_t)(d * 16 + n) * 16384, 128, F_WL + (size_t)((d * 2 + kind) * 16 + n) * 16384, 128, 64 * kb, 32 * nb, 32 * nb, scr, lane); }
        }
    }
    {
        u32x4* p = (u32x4*)(F_Wt_in + (size_t)NIN * DM); const u32x4 z = {0u, 0u, 0u, 0u};
        for (int i = F.vcu * 512 + F.tid; i < (NINP - NIN) * DM / 8; i += F.G * 512) p[i] = z;
    }
}
__device__ __forceinline__ void ph1_modreduce(const Frame& F) {
    const float* ba = F.in[I_BADA];
    for (int i = F.vcu * 512 + F.tid; i < 3 * NADA; i += F.G * 512) { const int r = i / NADA, col = i - r * NADA; float s = ba[col];
#pragma unroll 8
        for (int kc = 0; kc < 32; ++kc) s += F_modp[(size_t)(kc * 3 + r) * NADA + col];
        F_mod[i] = s; }
}
__device__ __forceinline__ void ph2_hrows(const Frame& F) {
    const int gw = F.vcu * 8 + F.wave, NGW = F.G * 8, lane = F.lane;
    const f32x4* g4 = (const f32x4*)F.in[I_GPREMIX];
    for (int row = gw; row < MT; row += NGW) {
        const float* xr = row < ML ? F.in[I_X] + (size_t)row * DM : F.in[I_CTX] + (size_t)(row - ML) * DM;
        const int mr = row < ML ? row / TL : 2;
        const f32x4* sh4 = (const f32x4*)(F_mod + (size_t)mr * NADA); const f32x4* sc4 = sh4 + DM / 4;
        f32x4 v[16]; float ss = 0.f;
#pragma unroll
        for (int j = 0; j < 16; ++j) { v[j] = ((const f32x4*)xr)[lane + 64 * j]; ss += (v[j].x * v[j].x + v[j].y * v[j].y) + (v[j].z * v[j].z + v[j].w * v[j].w); }
        const float rs = rsqrtf(wave_sum(ss) * (1.0f / DM) + EPS);
        u32x2* o = (u32x2*)(F_H + (size_t)row * DM);
#pragma unroll
        for (int j = 0; j < 16; ++j) { const f32x4 g = g4[lane + 64 * j], sh = sh4[lane + 64 * j], sc = sc4[lane + 64 * j];
            const f32x4 y = (v[j] * rs * g) * (sc + 1.0f) + sh; u32x2 w; w.x = pk2(y.x, y.y); w.y = pk2(y.z, y.w); o[lane + 64 * j] = w; }
    }
}

template <int PASS>
__device__ __forceinline__ void lru_pass(const Frame& F) {
    LAS bf16* U = (LAS bf16*)(F.lds);
    LAS float* XC = (LAS float*)(F.lds + 17408);
    LAS bf16* XCB = (LAS bf16*)(F.lds + 17408 + 32768);
    LAS f32x2* SC = (LAS f32x2*)(F.lds + 17408 + 32768 + 17408 + F.wave * 8192);
    const int tid = F.tid, lane = F.lane, w = F.wave, fr = lane & 15, fq = lane >> 4;
    const int n = F.vcu & 15;
    const int cl = 16 * w + fr, cg = n * 128 + cl;
    float ba[2], bx[2], sp[2];
#pragma unroll
    for (int d = 0; d < 2; ++d) { ba[d] = F.in[I_LBA][d * LW + cg]; bx[d] = F.in[I_LBX][d * LW + cg]; sp[d] = softplusf_(-F.in[I_LLAM][d * LW + cg]); }
    const int cc = tid & 127, tg = tid >> 7;
    float cw[4];
#pragma unroll
    for (int j = 0; j < 4; ++j) cw[j] = F.in[I_LCW][j * LW + n * 128 + cc];
    const float cb = F.in[I_LCB][n * 128 + cc];
    for (int q = F.vcu >> 4; q < NBATCH * NCH; q += F.G >> 4) {
        const int b = q / NCH, cidx = q - b * NCH;
        if (PASS == 2 && cidx < 4) continue;
        const bool isctx = cidx < 4; const int t0 = isctx ? cidx * 64 : (cidx - 4) * 64, Tseq = isctx ? TCX : TL;
        const size_t rowbase = isctx ? (size_t)ML + (size_t)b * TCX : (size_t)b * TL;
        __syncthreads();
        for (int rr = tid >> 4; rr < 67; rr += 32) { const int t = t0 - 2 + rr; u32x4 v = {0u, 0u, 0u, 0u};
            if (t >= 0 && t < Tseq) v = *(const u32x4*)(F_LX + (rowbase + t) * LW + n * 128 + (tid & 15) * 8);
            *(LAS u32x4*)(U + rr * 128 + (tid & 15) * 8) = v; }
        u32x4 gt0 = {0u, 0u, 0u, 0u}, gt1 = gt0;
        if (PASS == 2) { gt0 = *(const u32x4*)(F_LG + (rowbase + t0 + (tid >> 4)) * LW + n * 128 + (tid & 15) * 8); gt1 = *(const u32x4*)(F_LG + (rowbase + t0 + 32 + (tid >> 4)) * LW + n * 128 + (tid & 15) * 8); }
        __syncthreads();
        { float x0 = bf2f(U[(tg * 16 + 0) * 128 + cc]), x1 = bf2f(U[(tg * 16 + 1) * 128 + cc]), x2 = bf2f(U[(tg * 16 + 2) * 128 + cc]);
#pragma unroll
          for (int i = 0; i < 16; ++i) { const int tt = tg * 16 + i; const float x3 = bf2f(U[(tt + 3) * 128 + cc]);
              const float y = cb + cw[0] * x0 + cw[1] * x1 + cw[2] * x2 + cw[3] * x3; XC[tt * 128 + cc] = y; XCB[tt * 136 + cc] = (bf16)f2bf(y); x0 = x1; x1 = x2; x2 = x3; } }
        __syncthreads();
        if (PASS == 2) { *(LAS u32x4*)(U + (tid >> 4) * 128 + (tid & 15) * 8) = gt0; *(LAS u32x4*)(U + (32 + (tid >> 4)) * 128 + (tid & 15) * 8) = gt1; }
        float hsum[4][4];
#pragma unroll
        for (int d = 0; d < 2; ++d) {
            bf16x8 bfr[2][4];
#pragma unroll
            for (int mat = 0; mat < 2; ++mat)
#pragma unroll
                for (int ks = 0; ks < 4; ++ks) bfr[mat][ks] = *(const bf16x8*)(F_WL + ((size_t)((2 * d + mat) * 16 + n) * 128 + cl) * 128 + 32 * ks + 8 * fq);
            f32x4 acc[2][4];
#pragma unroll
            for (int mat = 0; mat < 2; ++mat)
#pragma unroll
                for (int mt = 0; mt < 4; ++mt) acc[mat][mt] = (f32x4){0.f, 0.f, 0.f, 0.f};
#pragma unroll
            for (int mt = 0; mt < 4; ++mt)
#pragma unroll
                for (int ks = 0; ks < 4; ++ks) { const bf16x8 af = *(const LAS bf16x8*)(XCB + (16 * mt + fr) * 136 + 32 * ks + 8 * fq);
                    acc[0][mt] = __builtin_amdgcn_mfma_f32_16x16x32_bf16(af, bfr[0][ks], acc[0][mt], 0, 0, 0);
                    acc[1][mt] = __builtin_amdgcn_mfma_f32_16x16x32_bf16(af, bfr[1][ks], acc[1][mt], 0, 0, 0); }
#pragma unroll
            for (int mt = 0; mt < 4; ++mt)
#pragma unroll
                for (int rg = 0; rg < 4; ++rg) { const int tok = 16 * mt + 4 * fq + rg; const float xcv = XC[tok * 128 + cl];
                    const float r = sigmoidf_(acc[0][mt][rg] + ba[d]), ig = sigmoidf_(acc[1][mt][rg] + bx[d]);
                    const float la = -8.0f * r * sp[d]; const float a = __expf(la); const float x2 = 2.0f * la;
                    const float em = -x2 * (1.0f + x2 * (0.5f + x2 * (0.16666667f + x2 * (0.041666668f + x2 * (0.0083333338f + x2 * 0.0013888889f)))));
                    const float bb = sqrtf(em) * (ig * xcv);
                    SC[tok * 16 + fr] = (f32x2){a, bb}; }
            WAVE_LDS_FENCE();
            float P = 1.0f, h = 0.0f;
#pragma unroll
            for (int i = 0; i < 16; ++i) { const int tok = 16 * fq + (d == 0 ? i : 15 - i); const f32x2 ab = SC[tok * 16 + fr]; h = ab.x * h + ab.y; P *= ab.x; SC[tok * 16 + fr] = (f32x2){P, h}; }
            float As[4], Bs[4];
#pragma unroll
            for (int s = 0; s < 4; ++s) { As[s] = __shfl(P, s * 16 + fr); Bs[s] = __shfl(h, s * 16 + fr); }
            const size_t cidx_off = ((size_t)((d * 2 + b) * NCH + cidx)) * LW + cg;
            if (PASS == 1) {
                float At = 1.0f, Bt = 0.0f;
#pragma unroll
                for (int s = 0; s < 4; ++s) { const int sgi = d == 0 ? s : 3 - s; Bt = As[sgi] * Bt + Bs[sgi]; At *= As[sgi]; }
                if (fq == 0) F_CAR[cidx_off] = (f32x2){At, Bt};
            } else {
                float hin = F_HIN[cidx_off];
#pragma unroll
                for (int s = 0; s < 4; ++s) { const int sgi = d == 0 ? s : 3 - s; const bool before = d == 0 ? (sgi < fq) : (sgi > fq); if (before) hin = As[sgi] * hin + Bs[sgi]; }
#pragma unroll
                for (int i = 0; i < 16; ++i) { const int tok = 16 * fq + i; const f32x2 ph = SC[tok * 16 + fr]; SC[tok * 16 + fr] = (f32x2){ph.x, ph.y + ph.x * hin}; }
                WAVE_LDS_FENCE();
#pragma unroll
                for (int mt = 0; mt < 4; ++mt)
#pragma unroll
                    for (int rg = 0; rg < 4; ++rg) { const float hv = SC[(16 * mt + 4 * fq + rg) * 16 + fr].y; hsum[mt][rg] = d == 0 ? hv : hsum[mt][rg] + hv; }
            }
            WAVE_LDS_FENCE();
        }
        if (PASS == 2) {
            __syncthreads();
#pragma unroll
            for (int mt = 0; mt < 4; ++mt)
#pragma unroll
                for (int rg = 0; rg < 4; ++rg) { const int tok = 16 * mt + 4 * fq + rg;
                    const float y = hsum[mt][rg] * gelu_tanhf_(bf2f(U[tok * 128 + cl])); XCB[tok * 136 + cl] = (bf16)f2bf(y); }
            __syncthreads();
#pragma unroll
            for (int hh = 0; hh < 2; ++hh) { const int tok = hh * 32 + (tid >> 4); const u32x4 wv = *(const LAS u32x4*)(XCB + tok * 136 + (tid & 15) * 8);
                const size_t row = rowbase + t0 + tok; *(u32x4*)(F_MIX + row * DM + n * 128 + (tid & 15) * 8) = wv;
                float sq = (bflo(wv.x) * bflo(wv.x) + bfhi(wv.x) * bfhi(wv.x)) + (bflo(wv.y) * bflo(wv.y) + bfhi(wv.y) * bfhi(wv.y)) + (bflo(wv.z) * bflo(wv.z) + bfhi(wv.z) * bfhi(wv.z)) + (bflo(wv.w) * bflo(wv.w) + bfhi(wv.w) * bfhi(wv.w));
                sq += __shfl_xor(sq, 1); sq += __shfl_xor(sq, 2); sq += __shfl_xor(sq, 4); sq += __shfl_xor(sq, 8);
                if ((tid & 15) == 0) F_SSQ[row * 16 + n] = sq; }
        }
    }
}
__device__ __forceinline__ int gdn_row(int b, int s) {
    if (s < TCX) return ML + b * TCX + s;
    const int m = s - TCX; return b * TL + (m & 127) * 64 + (m >> 7);
}
__device__ __forceinline__ void gdn_pre(const Frame& F) {
    const int gw = F.vcu * 8 + F.wave, NGW = F.G * 8, lane = F.lane;
    const float* cw = F.in[I_GCW];
    for (int tok = gw; tok < NBATCH * SEQ_S; tok += NGW) {
        const int b = tok / SEQ_S, s = tok - b * SEQ_S;
        const int lo = s < TCX ? 0 : TCX, hi = s < TCX ? TCX : SEQ_S;
        int rows[4]; bool val[4];
#pragma unroll
        for (int j = 0; j < 4; ++j) { const int sj = s + j - 2; val[j] = sj >= lo && sj < hi; rows[j] = gdn_row(b, val[j] ? sj : s); }
        for (int h = 0; h < NH; ++h) {
            float a[3][2];
#pragma unroll
            for (int p = 0; p < 3; ++p) { a[p][0] = 0.f; a[p][1] = 0.f; }
#pragma unroll
            for (int j = 0; j < 4; ++j) {
#pragma unroll
                for (int p = 0; p < 3; ++p) { const int ch = p * GDW + h * HD + 2 * lane;
                    const unsigned xw = val[j] ? *(const unsigned*)(F_QKV + (size_t)rows[j] * 6144 + ch) : 0u;
                    const f32x2 wv = *(const f32x2*)(cw + (size_t)j * 6144 + ch);
                    a[p][0] += wv.x * bflo(xw); a[p][1] += wv.y * bfhi(xw); } }
#pragma unroll
            for (int p = 0; p < 3; ++p) { a[p][0] = siluf_(a[p][0]); a[p][1] = siluf_(a[p][1]); }
            const float rq = rsqrtf(wave_sum(a[0][0] * a[0][0] + a[0][1] * a[0][1]) + EPS), rk = rsqrtf(wave_sum(a[1][0] * a[1][0] + a[1][1] * a[1][1]) + EPS);
            const unsigned qw = pk2(a[0][0] * rq, a[0][1] * rq), kw = pk2(a[1][0] * rk, a[1][1] * rk), vw = pk2(a[2][0], a[2][1]);
            const float kq = wave_sum(bflo(qw) * bflo(kw) + bfhi(qw) * bfhi(kw));
            const size_t o = ((size_t)b * SEQ_S + s) * GDW + h * HD + 2 * lane;
            *(unsigned*)(F_QN + o) = qw; *(unsigned*)(F_KN + o) = kw; *(unsigned*)(F_VN + o) = vw;
            if (lane == 0) F_KQ[(size_t)(b * NH + h) * SEQ_S + s] = kq;
        }
        if (lane < 32) { const int d = lane >> 4, h = lane & 15; const bf16* bar = F_BA + (size_t)rows[2] * 256;
            const float pb = bf2f(bar[d * 16 + h]), pa = bf2f(bar[32 + d * 16 + h]);
            const float beta = sigmoidf_(pb), g = -__expf(F.in[I_GALOG][d * 16 + h]) * softplusf_(pa + F.in[I_GDT][d * 16 + h]);
            F_GB[(size_t)((d * 2 + b) * NH + h) * SEQ_S + s] = (f32x2){g, beta}; }
    }
}
__device__ __forceinline__ void lru_chains(const Frame& F) {
    if (F.tid < 32) {
        for (int chain = F.vcu * 32 + F.tid; chain < 2 * NBATCH * LW; chain += F.G * 32) {
            const int cg = chain & (LW - 1), b = (chain >> 11) & 1, d = chain >> 12;
            float h = 0.f;
#pragma unroll 4
            for (int step = 0; step < NCH; ++step) { const int cidx = d == 0 ? step : (step < 4 ? 3 - step : NCH - 1 - (step - 4));
                const size_t idx = ((size_t)((d * 2 + b) * NCH + cidx)) * LW + cg; const f32x2 ab = F_CAR[idx]; F_HIN[idx] = h; h = ab.x * h + ab.y; }
        }
    }
}
__device__ __forceinline__ int gdn_spos(int d, int step) { return d == 0 ? step : (step < TCX ? TCX - 1 - step : SEQ_S - 1 - (step - TCX)); }
__device__ __forceinline__ void gdn_seq(const Frame& F, int item) {
    const int sl = item & 3, d = (item >> 2) & 1, h = (item >> 3) & 15, b = item >> 7;
    LAS float* Kst = (LAS float*)F.lds;
    LAS float* Qst = Kst + 2048;
    LAS float* Vst = Qst + 2048;
    LAS float* Gst = Vst + 512;
    LAS f32x2* RED = (LAS f32x2*)(Gst + 64);
    const int tid = F.tid, v = tid & 31, kg = tid >> 5;
    float S[8];
#pragma unroll
    for (int i = 0; i < 8; ++i) S[i] = 0.f;
    const bf16* Kb = F_KN + (size_t)b * SEQ_S * GDW + h * HD + (tid & 31) * 4;
    const bf16* Qb = F_QN + (size_t)b * SEQ_S * GDW + h * HD + (tid & 31) * 4;
    const bf16* Vb = F_VN + (size_t)b * SEQ_S * GDW + h * HD + sl * 32 + (tid & 31);
    const f32x2* GBp = F_GB + (size_t)((d * 2 + b) * NH + h) * SEQ_S; const float* KQp = F_KQ + (size_t)(b * NH + h) * SEQ_S;
    float* Ob = F_O + (size_t)d * ML * GDW + h * HD + sl * 32 + v;
    u32x2 pk, pq; unsigned pv; f32x2 pgb = {0.f, 0.f}; float pkq = 0.f;
#define GDN_LOADG(g0) do { const int s_ = gdn_spos(d, (g0) + (tid >> 5)); pk = *(const u32x2*)(Kb + (size_t)s_ * GDW); pq = *(const u32x2*)(Qb + (size_t)s_ * GDW); pv = Vb[(size_t)s_ * GDW]; \
        if (tid < 16) { const int s2_ = gdn_spos(d, (g0) + tid); pgb = GBp[s2_]; pkq = KQp[s2_]; } } while (0)
    GDN_LOADG(0);
    for (int g0 = 0; g0 < SEQ_S; g0 += 16) {
        *(LAS f32x4*)(Kst + (tid >> 5) * 128 + (tid & 31) * 4) = (f32x4){bflo(pk.x), bfhi(pk.x), bflo(pk.y), bfhi(pk.y)};
        *(LAS f32x4*)(Qst + (tid >> 5) * 128 + (tid & 31) * 4) = (f32x4){bflo(pq.x), bfhi(pq.x), bflo(pq.y), bfhi(pq.y)};
        Vst[(tid >> 5) * 32 + (tid & 31)] = bf2f(pv);
        if (tid < 16) { Gst[tid] = __expf(pgb.x); Gst[16 + tid] = pgb.y; Gst[32 + tid] = pkq; }
        if (g0 + 16 < SEQ_S) GDN_LOADG(g0 + 16);
        __syncthreads();
#pragma unroll 2
        for (int j = 0; j < 16; ++j) {
            const f32x4 k0 = *(const LAS f32x4*)(Kst + j * 128 + kg * 8), k1 = *(const LAS f32x4*)(Kst + j * 128 + kg * 8 + 4);
            const f32x4 q0 = *(const LAS f32x4*)(Qst + j * 128 + kg * 8), q1 = *(const LAS f32x4*)(Qst + j * 128 + kg * 8 + 4);
            const float kk[8] = {k0.x, k0.y, k0.z, k0.w, k1.x, k1.y, k1.z, k1.w}, qq[8] = {q0.x, q0.y, q0.z, q0.w, q1.x, q1.y, q1.z, q1.w};
            const float vv = Vst[j * 32 + v], eg = Gst[j], be = Gst[16 + j], kq = Gst[32 + j];
            float pkk = 0.f, pqq = 0.f;
#pragma unroll
            for (int i = 0; i < 8; ++i) { S[i] *= eg; pkk += kk[i] * S[i]; pqq += qq[i] * S[i]; }
            RED[(j & 1) * 512 + kg * 32 + v] = (f32x2){pkk, pqq};
            __syncthreads();
            float ks = 0.f, qs = 0.f;
#pragma unroll
            for (int g = 0; g < 16; ++g) { const f32x2 r = RED[(j & 1) * 512 + g * 32 + v]; ks += r.x; qs += r.y; }
            const float delta = be * (vv - ks);
#pragma unroll
            for (int i = 0; i < 8; ++i) S[i] += kk[i] * delta;
            if (kg == 0) { const int s = gdn_spos(d, g0 + j); if (s >= TCX) Ob[(size_t)gdn_row(b, s) * GDW] = (qs + delta * kq) * 0.08838834764831845f; }
        }
    }
#undef GDN_LOADG
    __syncthreads();
}
__device__ __forceinline__ void gdn_combine(const Frame& F) {
    const int gw = F.vcu * 8 + F.wave, NGW = F.G * 8, lane = F.lane;
    const f32x2 gn = *(const f32x2*)(F.in[I_GNG] + 2 * lane);
    for (int row = gw; row < ML; row += NGW) {
        const int b = row / TL, t = row - b * TL, m = (t & 63) * 128 + (t >> 6), cl = m >> 6, i = m & 63;
#pragma unroll 4
        for (int hh = 0; hh < NH; ++hh) { const int h = (hh + gw) & 15;
            const size_t it0 = ((size_t)((b * NH + h) * 128 + cl)) * 2;
            const f32x2 a = *(const f32x2*)(F_O + it0 * 8192 + i * 128 + 2 * lane), c = *(const f32x2*)(F_O + (it0 + 1) * 8192 + (63 - i) * 128 + 2 * lane); const float o0 = a.x + c.x, o1 = a.y + c.y;
            const float rs = rsqrtf(wave_sum(o0 * o0 + o1 * o1) * (1.0f / HD) + EPS);
            const unsigned zw = *(const unsigned*)(F_Z + (size_t)row * GDW + h * HD + 2 * lane);
            *(unsigned*)(F_MIX + (size_t)row * DM + LW + h * HD + 2 * lane) = pk2(o0 * rs * gn.x * siluf_(bflo(zw)), o1 * rs * gn.y * siluf_(bfhi(zw))); }
    }
}
__device__ __forceinline__ void lru_normalize(const Frame& F) {
    const int gw = F.vcu * 8 + F.wave, NGW = F.G * 8, lane = F.lane;
    for (int row = gw; row < ML; row += NGW) {
        const float p = lane < 16 ? F_SSQ[(size_t)row * 16 + lane] : 0.f;
        const float rs = rsqrtf(wave_sum(p) * (1.0f / LW) + EPS);
#pragma unroll
        for (int j = 0; j < 4; ++j) { const int c0 = (lane + 64 * j) * 8; u32x4* p4 = (u32x4*)(F_MIX + (size_t)row * DM + c0); const u32x4 w = *p4;
            const f32x4 g0 = *(const f32x4*)(F.in[I_LNG] + c0), g1 = *(const f32x4*)(F.in[I_LNG] + c0 + 4);
            u32x4 o; o.x = pk2(bflo(w.x) * rs * g0.x, bfhi(w.x) * rs * g0.y); o.y = pk2(bflo(w.y) * rs * g0.z, bfhi(w.y) * rs * g0.w);
            o.z = pk2(bflo(w.z) * rs * g1.x, bfhi(w.z) * rs * g1.y); o.w = pk2(bflo(w.w) * rs * g1.z, bfhi(w.w) * rs * g1.w); *p4 = o; }
    }
}
__device__ __forceinline__ void ph_x1(const Frame& F) {
    const int gw = F.vcu * 8 + F.wave, NGW = F.G * 8, lane = F.lane;
    const f32x4* gpm = (const f32x4*)F.in[I_GPOSTMIX]; const f32x4* gpf = (const f32x4*)F.in[I_GPREFFN];
    for (int row = gw; row < ML; row += NGW) {
        const f32x4* md = (const f32x4*)(F_mod + (size_t)(row / TL) * NADA);
        const f32x4* yr = (const f32x4*)(F_Y1 + (size_t)row * DM); const f32x4* xr = (const f32x4*)(F.in[I_X] + (size_t)row * DM); f32x4* outr = (f32x4*)(F.out + (size_t)row * DM);
        f32x4 y[16]; float ss = 0.f;
#pragma unroll
        for (int j = 0; j < 16; ++j) { y[j] = yr[lane + 64 * j]; ss += (y[j].x * y[j].x + y[j].y * y[j].y) + (y[j].z * y[j].z + y[j].w * y[j].w); }
        const float rs = rsqrtf(wave_sum(ss) * (1.0f / DM) + EPS); float s2 = 0.f;
#pragma unroll
        for (int j = 0; j < 16; ++j) { const f32x4 x1 = xr[lane + 64 * j] + md[2 * (DM / 4) + lane + 64 * j] * (y[j] * rs * gpm[lane + 64 * j]);
            outr[lane + 64 * j] = x1; y[j] = x1; s2 += (x1.x * x1.x + x1.y * x1.y) + (x1.z * x1.z + x1.w * x1.w); }
        const float r2 = rsqrtf(wave_sum(s2) * (1.0f / DM) + EPS);
        u32x2* o = (u32x2*)(F_H2 + (size_t)row * DM);
#pragma unroll
        for (int j = 0; j < 16; ++j) { const f32x4 hv = (y[j] * r2 * gpf[lane + 64 * j]) * (md[4 * (DM / 4) + lane + 64 * j] + 1.0f) + md[3 * (DM / 4) + lane + 64 * j];
            u32x2 w; w.x = pk2(hv.x, hv.y); w.y = pk2(hv.z, hv.w); o[lane + 64 * j] = w; }
    }
}
__device__ __forceinline__ void ph_final(const Frame& F) {
    const int gw = F.vcu * 8 + F.wave, NGW = F.G * 8, lane = F.lane;
    const f32x4* gpf = (const f32x4*)F.in[I_GPOSTFFN];
    for (int row = gw; row < ML; row += NGW) {
        const f32x4* md = (const f32x4*)(F_mod + (size_t)(row / TL) * NADA);
        const f32x4* yr = (const f32x4*)(F_Y2 + (size_t)row * DM); f32x4* outr = (f32x4*)(F.out + (size_t)row * DM);
        f32x4 y[16]; float ss = 0.f;
#pragma unroll
        for (int j = 0; j < 16; ++j) { y[j] = yr[lane + 64 * j]; ss += (y[j].x * y[j].x + y[j].y * y[j].y) + (y[j].z * y[j].z + y[j].w * y[j].w); }
        const float rs = rsqrtf(wave_sum(ss) * (1.0f / DM) + EPS);
#pragma unroll
        for (int j = 0; j < 16; ++j) outr[lane + 64 * j] = outr[lane + 64 * j] + md[5 * (DM / 4) + lane + 64 * j] * (y[j] * rs * gpf[lane + 64 * j]);
    }
}
__device__ __forceinline__ size_t gdn_item(int b, int h, int c, int d) { return ((size_t)((b * NH + h) * NCH + c)) * 2 + d; }
__device__ __forceinline__ void gdn_chunk_pre(const Frame& F) {
    LAS bf16* Kt_ = (LAS bf16*)(F.lds);
    LAS bf16* Qt_ = (LAS bf16*)(F.lds + 17408);
    LAS bf16* Vt_ = (LAS bf16*)(F.lds + 34816);
    LAS float* L_ = (LAS float*)(F.lds + 52224);
    LAS float* GC_ = (LAS float*)(F.lds + 84992);
    LAS float* BE_ = GC_ + 128;
    LAS float* BEG_ = GC_ + 256;
    LAS bf16* XW_ = (LAS bf16*)(F.lds + 86528);
    const int tid = F.tid, lane = F.lane, w = F.wave, fr = lane & 15, fq = lane >> 4;
    for (int it = F.vcu; it < NBATCH * NH * NCH; it += F.G) {
        const int c = it % NCH, bh = it / NCH, h = bh % NH, b = bh / NH;
        const size_t item0 = gdn_item(b, h, c, 0);
        __syncthreads();
        { const size_t gbase = ((size_t)b * SEQ_S + (size_t)c * 64) * GDW + h * HD;
#pragma unroll
          for (int r = 0; r < 2; ++r) { const int pc = tid + 512 * r, row = pc >> 4, cc = (pc & 15) * 8; const size_t g = gbase + (size_t)row * GDW + cc;
              *(LAS u32x4*)(Kt_ + row * 136 + cc) = *(const u32x4*)(F_KN + g); *(LAS u32x4*)(Qt_ + row * 136 + cc) = *(const u32x4*)(F_QN + g); *(LAS u32x4*)(Vt_ + row * 136 + cc) = *(const u32x4*)(F_VN + g); }
          if (tid < 128) { const int d = tid >> 6, p = tid & 63, i = d ? 63 - p : p;
              const f32x2 gb = F_GB[(size_t)((d * 2 + b) * NH + h) * SEQ_S + c * 64 + i];
              float gc = gb.x;
#pragma unroll
              for (int o = 1; o < 64; o <<= 1) { const float t = __shfl_up(gc, o); if (lane >= o) gc += t; }
              GC_[d * 64 + p] = gc; BE_[d * 64 + p] = gb.y; BEG_[d * 64 + p] = gb.y * __expf(gc);
              F_GSC[(item0 + d) * 128 + p] = 0.08838834764831845f * __expf(gc);
              if (p == 63) F_GSC[(item0 + d) * 128 + 64] = __expf(gc); } }
        __syncthreads();
        { const int mt = w >> 1; LAS bf16* IN_ = XW_;
          bf16x8 kA[4], qA[4];
#pragma unroll
          for (int ks = 0; ks < 4; ++ks) { kA[ks] = *(const LAS bf16x8*)(Kt_ + (16 * mt + fr) * 136 + 32 * ks + 8 * fq); qA[ks] = *(const LAS bf16x8*)(Qt_ + (16 * mt + fr) * 136 + 32 * ks + 8 * fq); }
#pragma unroll
          for (int t2 = 0; t2 < 2; ++t2) { const int nt = 2 * (w & 1) + t2;
              f32x4 aK = {0.f, 0.f, 0.f, 0.f}, aQ = aK;
#pragma unroll
              for (int ks = 0; ks < 4; ++ks) { const bf16x8 kB = *(const LAS bf16x8*)(Kt_ + (16 * nt + fr) * 136 + 32 * ks + 8 * fq);
                  aK = __builtin_amdgcn_mfma_f32_16x16x32_bf16(kA[ks], kB, aK, 0, 0, 0); aQ = __builtin_amdgcn_mfma_f32_16x16x32_bf16(qA[ks], kB, aQ, 0, 0, 0); }
              const int j = 16 * nt + fr, q1 = 63 - j; const float g0j = GC_[j], g1q = GC_[64 + q1];
#pragma unroll
              for (int rg = 0; rg < 4; ++rg) { const int i = 16 * mt + 4 * fq + rg, p1 = 63 - i;
                  const float e0 = i >= j ? __expf(GC_[i] - g0j) : 0.f, e1 = i <= j ? __expf(GC_[64 + p1] - g1q) : 0.f;
                  if (i > j) L_[i * 64 + j] = BE_[i] * aK[rg] * e0;
                  if (i < j) L_[4096 + p1 * 64 + q1] = BE_[64 + p1] * aK[rg] * e1;
                  const float y = aQ[rg] * 0.08838834764831845f;
                  IN_[i * 72 + j] = (bf16)f2bf(y * e0); IN_[64 * 72 + p1 * 72 + q1] = (bf16)f2bf(y * e1); } }
        }
        __syncthreads();
        { LAS bf16* IN_ = XW_;
#pragma unroll
          for (int r = 0; r < 2; ++r) { const int pc = tid + 512 * r, d = pc >> 9, row = (pc >> 3) & 63, cc = (pc & 7) * 8;
              *(u32x4*)(F_INTRA + (item0 + d) * 4096 + row * 64 + cc) = *(const LAS u32x4*)(IN_ + d * 64 * 72 + row * 72 + cc); } }
        { const int d = w >> 2, isw = (w >> 1) & 1, col = 64 * (w & 1) + lane;
          const LAS float* Ld = L_ + d * 4096; const LAS float* cf = (isw ? BEG_ : BE_) + d * 64; const LAS bf16* Tt = isw ? Kt_ : Vt_;
          float x[64];
#pragma unroll
          for (int p = 0; p < 64; ++p) { const int i = d ? 63 - p : p;
              float a0 = cf[p] * bf2f(Tt[i * 136 + col]), a1 = 0.f, a2 = 0.f, a3 = 0.f;
#pragma unroll
              for (int q4 = 0; q4 < p / 4; ++q4) { const f32x4 l = *(const LAS f32x4*)(Ld + p * 64 + 4 * q4); a0 -= l.x * x[4 * q4]; a1 -= l.y * x[4 * q4 + 1]; a2 -= l.z * x[4 * q4 + 2]; a3 -= l.w * x[4 * q4 + 3]; }
#pragma unroll
              for (int q = (p / 4) * 4; q < p; ++q) a0 -= Ld[p * 64 + q] * x[q];
              x[p] = (a0 + a1) + (a2 + a3); }
          __syncthreads();
          if (!isw) {
              u32x4* up = (u32x4*)(F_UT + (item0 + d) * 8192 + (size_t)col * 64); u32x4* kp = (u32x4*)(F_KT + (item0 + d) * 8192 + (size_t)col * 64);
              const float glast = GC_[d * 64 + 63];
#pragma unroll
              for (int p8 = 0; p8 < 8; ++p8) { u32x4 o; o.x = pk2(x[8 * p8], x[8 * p8 + 1]); o.y = pk2(x[8 * p8 + 2], x[8 * p8 + 3]); o.z = pk2(x[8 * p8 + 4], x[8 * p8 + 5]); o.w = pk2(x[8 * p8 + 6], x[8 * p8 + 7]); up[p8] = o;
                  float kt[8];
#pragma unroll
                  for (int e = 0; e < 8; ++e) { const int p = 8 * p8 + e, i = d ? 63 - p : p; kt[e] = bf2f(Kt_[i * 136 + col]) * __expf(glast - GC_[d * 64 + p]); }
                  u32x4 k4; k4.x = pk2(kt[0], kt[1]); k4.y = pk2(kt[2], kt[3]); k4.z = pk2(kt[4], kt[5]); k4.w = pk2(kt[6], kt[7]); kp[p8] = k4; }
          } else {
#pragma unroll
              for (int p = 0; p < 64; ++p) XW_[d * 64 * 136 + p * 136 + col] = (bf16)f2bf(x[p]);
          }
        }
        __syncthreads();
#pragma unroll
        for (int r = 0; r < 4; ++r) { const int pc = tid + 512 * r, d = pc >> 10, row = (pc >> 4) & 63, cc = (pc & 15) * 8;
            *(u32x4*)(F_W + (item0 + d) * 8192 + row * 128 + cc) = *(const LAS u32x4*)(XW_ + d * 64 * 136 + row * 136 + cc); }
    }
}
__device__ __forceinline__ void gdn_seq_chunked(const Frame& F, int item) {
    const int sl = item & 3, d = (item >> 2) & 1, h = (item >> 3) & 15, b = item >> 7;
    LAS bf16* St = (LAS bf16*)(F.lds);
    LAS bf16* Vt = (LAS bf16*)(F.lds + 8704);
    const int tid = F.tid, lane = F.lane, w = F.wave, fr = lane & 15, fq = lane >> 4;
    const int mt = w & 3, nt = w >> 2;
    for (int e = tid; e < 32 * 136 / 2; e += 512) ((LAS unsigned*)St)[e] = 0u;
    f32x4 S0 = {0.f, 0.f, 0.f, 0.f}, S1 = S0;
    const bf16* Qb = F_QN + (size_t)b * SEQ_S * GDW + h * HD + 8 * fq;
    float* Ob = F_O + (size_t)(b * NH + h) * 128 * 2 * 8192 + (size_t)d * 8192 + sl * 32 + 16 * nt + fr;
    struct Stg { bf16x8 wf[4], qf[4], inf[2], ktf[2]; u32x2 utv; f32x4 sqv; float gl; };
#define GDN_LOADC(G, step) do { const int c_ = d == 0 ? (step) : ((step) < 4 ? 3 - (step) : NCH - 1 - ((step) - 4)); const size_t it_ = gdn_item(b, h, c_, d); \
        const int prow_ = 16 * mt + fr, irow_ = d ? 63 - prow_ : prow_; \
        _Pragma("unroll") for (int ks = 0; ks < 4; ++ks) { G.wf[ks] = *(const bf16x8*)(F_W + it_ * 8192 + prow_ * 128 + 32 * ks + 8 * fq); G.qf[ks] = *(const bf16x8*)(Qb + (size_t)(c_ * 64 + irow_) * GDW + 32 * ks); } \
        _Pragma("unroll") for (int ks = 0; ks < 2; ++ks) { G.inf[ks] = *(const bf16x8*)(F_INTRA + it_ * 4096 + prow_ * 64 + 32 * ks + 8 * fq); G.ktf[ks] = *(const bf16x8*)(F_KT + it_ * 8192 + (16 * w + fr) * 64 + 32 * ks + 8 * fq); } \
        G.utv = *(const u32x2*)(F_UT + it_ * 8192 + (size_t)(32 * sl + 16 * nt + fr) * 64 + 16 * mt + 4 * fq); G.sqv = *(const f32x4*)(F_GSC + it_ * 128 + 16 * mt + 4 * fq); G.gl = F_GSC[it_ * 128 + 64]; } while (0)
#define GDN_STEP(G, step) do { const int c = d == 0 ? (step) : ((step) < 4 ? 3 - (step) : NCH - 1 - ((step) - 4)); \
        f32x4 aW = {0.f, 0.f, 0.f, 0.f}, aQ = aW; \
        _Pragma("unroll") for (int ks = 0; ks < 4; ++ks) { const bf16x8 bS = *(const LAS bf16x8*)(St + (16 * nt + fr) * 136 + 32 * ks + 8 * fq); \
            aW = __builtin_amdgcn_mfma_f32_16x16x32_bf16(G.wf[ks], bS, aW, 0, 0, 0); aQ = __builtin_amdgcn_mfma_f32_16x16x32_bf16(G.qf[ks], bS, aQ, 0, 0, 0); } \
        { const float v0 = bflo(G.utv.x) - aW[0], v1 = bfhi(G.utv.x) - aW[1], v2 = bflo(G.utv.y) - aW[2], v3 = bfhi(G.utv.y) - aW[3]; \
          u32x2 vn; vn.x = pk2(v0, v1); vn.y = pk2(v2, v3); *(LAS u32x2*)(Vt + (16 * nt + fr) * 72 + 16 * mt + 4 * fq) = vn; } \
        f32x4 o = aQ * G.sqv; \
        __syncthreads(); \
        { const bf16x8 b0 = *(const LAS bf16x8*)(Vt + (16 * nt + fr) * 72 + 8 * fq), b1 = *(const LAS bf16x8*)(Vt + (16 * nt + fr) * 72 + 32 + 8 * fq); \
          o = __builtin_amdgcn_mfma_f32_16x16x32_bf16(G.inf[0], b0, o, 0, 0, 0); o = __builtin_amdgcn_mfma_f32_16x16x32_bf16(G.inf[1], b1, o, 0, 0, 0); } \
        { const bf16x8 b00 = *(const LAS bf16x8*)(Vt + fr * 72 + 8 * fq), b01 = *(const LAS bf16x8*)(Vt + fr * 72 + 32 + 8 * fq); \
          const bf16x8 b10 = *(const LAS bf16x8*)(Vt + (16 + fr) * 72 + 8 * fq), b11 = *(const LAS bf16x8*)(Vt + (16 + fr) * 72 + 32 + 8 * fq); \
          S0 = S0 * G.gl; S1 = S1 * G.gl; \
          S0 = __builtin_amdgcn_mfma_f32_16x16x32_bf16(G.ktf[0], b00, S0, 0, 0, 0); S0 = __builtin_amdgcn_mfma_f32_16x16x32_bf16(G.ktf[1], b01, S0, 0, 0, 0); \
          S1 = __builtin_amdgcn_mfma_f32_16x16x32_bf16(G.ktf[0], b10, S1, 0, 0, 0); S1 = __builtin_amdgcn_mfma_f32_16x16x32_bf16(G.ktf[1], b11, S1, 0, 0, 0); \
          u32x2 s0; s0.x = pk2(S0[0], S0[1]); s0.y = pk2(S0[2], S0[3]); *(LAS u32x2*)(St + fr * 136 + 16 * w + 4 * fq) = s0; \
          u32x2 s1; s1.x = pk2(S1[0], S1[1]); s1.y = pk2(S1[2], S1[3]); *(LAS u32x2*)(St + (16 + fr) * 136 + 16 * w + 4 * fq) = s1; } \
        if (c >= 4) { _Pragma("unroll") for (int rg = 0; rg < 4; ++rg) Ob[(size_t)(c - 4) * 16384 + (16 * mt + 4 * fq + rg) * 128] = o[rg]; } \
        __syncthreads(); } while (0)
    Stg A, B, C;
    GDN_LOADC(A, 0); GDN_LOADC(B, 1);
    __syncthreads();
    static_assert(NCH % 3 == 0, "three-stage register pipeline");
    for (int step = 0; step < NCH; step += 3) {
        GDN_LOADC(C, step + 2); GDN_STEP(A, step);
        if (step + 3 < NCH) GDN_LOADC(A, step + 3); GDN_STEP(B, step + 1);
        if (step + 4 < NCH) GDN_LOADC(B, step + 4); GDN_STEP(C, step + 2);
    }
#undef GDN_STEP
#undef GDN_LOADC
}
#ifndef MK_N_LAUNCHES
#define MK_N_LAUNCHES 1
#endif
constexpr int N_PHASES = 14;
__global__ void __launch_bounds__(512, 2) fwd(Args args) {
    extern __shared__ __attribute__((aligned(16))) unsigned char lds[];
    Frame F;
    F.lds = (LAS unsigned char*)lds;
    F.tid = threadIdx.x; F.lane = F.tid & 63; F.wave = __builtin_amdgcn_readfirstlane(F.tid >> 6);
    F.G = gridDim.x; { const int bx = blockIdx.x; F.vcu = (F.G % 8 == 0) ? (bx % 8) * (F.G / 8) + bx / 8 : bx; }
    F.in = args.in; F.out = args.out; F.ws = args.ws;
    unsigned char* ws = args.ws;
    volatile LAS unsigned* MISC = (volatile LAS unsigned*)(F.lds + MISC_OFF);
    if (F.tid < 64) MISC[F.tid] = 0u;
    __syncthreads();
    const int lo = args.ph_lo, hi = args.ph_hi;
    XcdBarrier bar; bar.bar = (unsigned*)(ws + WS_CTL) + CW_BAR; bar.x = 0; bar.st = nullptr;
    if (hi - lo > 1) bar = xcd_barrier_post((unsigned*)(ws + WS_CTL) + CW_BAR, MISC + 8);
#ifndef PH_MASK
#define PH_MASK 0x3fff
#endif
#define IN(k) (((PH_MASK >> (k)) & 1) && lo <= (k) && (k) < hi)
#define SEAM(k) do { if (IN(k) && IN((k) + 1)) xcd_barrier(bar); } while (0)
    if (IN(0)) { ph0_prologue(F); } SEAM(0);
    if (IN(1)) { ph1_modreduce(F); } SEAM(1);
    if (IN(2)) { ph2_hrows(F); } SEAM(2);
    if (IN(3)) { pg8::Gemm g{F_H, F_Wt_in, MT, NINP, DM}; pg8::StaticOrder S; S.init(MT, NINP, F.G, (int)blockIdx.x);
        pg8::EpiProj E{F_LX, F_LG, F_QKV, F_Z, F_BA};
        pg8::gemm_phase<pg8::EpiProj, pg8::StaticOrder, true, true>(F.lds, g, S, E); } SEAM(3);
    if (IN(4)) { lru_pass<1>(F); gdn_pre(F); } SEAM(4);
    if (IN(5)) { lru_chains(F); gdn_chunk_pre(F); } SEAM(5);
    if (IN(6)) { for (int item = F.vcu; item < 256; item += F.G) gdn_seq_chunked(F, item); } SEAM(6);
    if (IN(7)) { lru_pass<2>(F); gdn_combine(F); } SEAM(7);
    if (IN(8)) { lru_normalize(F); } SEAM(8);
    if (IN(9)) { pg8::Gemm g{F_MIX, F_Wt_out, ML, DM, DM}; pg8::StaticOrder S; S.init(ML, DM, F.G, (int)blockIdx.x);
        pg8::EpiF32 E{F_Y1, DM};
        pg8::gemm_phase<pg8::EpiF32, pg8::StaticOrder, true, true>(F.lds, g, S, E); } SEAM(9);
    if (IN(10)) { ph_x1(F); } SEAM(10);
    if (IN(11)) { pg8::Gemm g{F_H2, F_Wt_gu, ML, 2 * DFF, DM}; pg8::StaticOrder S; S.init(ML, 2 * DFF, F.G, (int)blockIdx.x);
        pg8::EpiSwiGLU E{F_ACT, DFF};
        pg8::gemm_phase<pg8::EpiSwiGLU, pg8::StaticOrder, true, true>(F.lds, g, S, E); } SEAM(11);
    if (IN(12)) { pg8::Gemm g{F_ACT, F_Wt_dn, ML, DM, DFF}; pg8::StaticOrder S; S.init(ML, DM, F.G, (int)blockIdx.x);
        pg8::EpiF32 E{F_Y2, DM};
        pg8::gemm_phase<pg8::EpiF32, pg8::StaticOrder, true, true>(F.lds, g, S, E); } SEAM(12);
    if (IN(13)) { ph_final(F); }
#undef IN
#undef SEAM
}

extern "C" void kernel_launch(void* const* d_in, const int* in_sizes, int n_in, void* d_out, int out_size, void* d_ws, size_t ws_size, hipStream_t stream) {
    static int grid = 0;
    if (grid == 0) {
        if (n_in != N_INPUTS || in_sizes[0] != ML * DM || out_size != ML * DM || ws_size < WS_END) { fprintf(stderr, "kernel_launch: unexpected problem shape (n_in %d, in0 %d, out %d, ws %zu): nothing launched\n", n_in, n_in > 0 ? in_sizes[0] : -1, out_size, ws_size); grid = -1; return; }
        int dev = 0, cus = 0;
        if (hipGetDevice(&dev) != hipSuccess || hipDeviceGetAttribute(&cus, hipDeviceAttributeMultiprocessorCount, dev) != hipSuccess) { grid = -1; return; }
        if (hipFuncSetAttribute((const void*)fwd, hipFuncAttributeMaxDynamicSharedMemorySize, LDS_BYTES) != hipSuccess) { fprintf(stderr, "kernel_launch: hipFuncSetAttribute failed\n"); grid = -1; return; }
        (void)hipGetLastError();
        grid = cus >= 256 ? 256 : (cus / 16) * 16;
        if (grid < 16) { grid = -1; return; }
    }
    if (grid < 0) return;
    (void)hipMemsetAsync((char*)d_ws + WS_CTL, 0, CTL_ZERO_BYTES, stream);
    Args a{};
    for (int i = 0; i < N_INPUTS; ++i) a.in[i] = (const float*)d_in[i];
    a.out = (float*)d_out; a.ws = (unsigned char*)d_ws;
#if MK_N_LAUNCHES == 1
    a.ph_lo = 0; a.ph_hi = N_PHASES;
    hipLaunchKernelGGL(fwd, dim3(grid), dim3(512), LDS_BYTES, stream, a);
#else
#ifndef PROBE_REPEAT_MASK
#define PROBE_REPEAT_MASK 0
#endif
    for (int p = 0; p < N_PHASES; ++p) { a.ph_lo = p; a.ph_hi = p + 1; hipLaunchKernelGGL(fwd, dim3(grid), dim3(512), LDS_BYTES, stream, a);
        if ((PROBE_REPEAT_MASK >> p) & 1) hipLaunchKernelGGL(fwd, dim3(grid), dim3(512), LDS_BYTES, stream, a); }
#endif
}
```

```cpp
#include <hip/hip_runtime.h>
#include <cstdio>
#include <cstdint>
namespace pg8 {
#define PG8_LAS __attribute__((address_space(3)))
typedef unsigned short bf16_t;
typedef short bf16x8 __attribute__((ext_vector_type(8)));
typedef float f32x4 __attribute__((ext_vector_type(4)));
typedef unsigned u32x4 __attribute__((ext_vector_type(4)));
constexpr int BM = 256, BK = 64, HALF = 128, HTB = HALF * BK * 2  , STAGE_BYTES = 8 * HTB, NXCD = 8, WGM = 8;

__host__ __device__ __forceinline__ int lds_byte(int r, int c) { const int st = (r >> 4) * 2 + (c >> 5), rr = r & 15, cc = c & 31, ob = rr * 64 + cc * 2; return st * 1024 + (ob ^ (((ob >> 9) & 1) << 5)); }
__host__ __device__ __forceinline__ void stage_rc(int b, int& R, int& C) { const int st = b / 1024, sb = b % 1024, swz = sb ^ (((sb >> 9) & 1) << 5); R = (st >> 1) * 16 + swz / 64; C = (st & 1) * 32 + (swz % 64) / 2; }
__host__ __device__ __forceinline__ int perm32(int rho) { const int n = rho >> 4, i = rho & 15; return 8 * (i >> 2) + 4 * n + (i & 3); }

struct Unit { int pm, pn; };
struct Gemm { const bf16_t* A; const bf16_t* Bt; int M, N, K; };

struct StaticOrder {
    int nM, nN, nwg, G, c;
    __host__ __device__ void init(int M, int N, int G_, int c_) { nM = M / BM; nN = N / BM; nwg = nM * nN; G = G_; c = c_; }
    __host__ __device__ bool next(int i, Unit& u) const {
        const long L = (long)i * G + c; if (L >= nwg) return false;
        int wgid = (int)L; { const int q = nwg / NXCD, r = nwg % NXCD, xcd = wgid % NXCD, off = wgid / NXCD; wgid = (xcd < r ? xcd * (q + 1) : r * (q + 1) + (xcd - r) * q) + off; }
        const int nig = WGM * nN, gid = wgid / nig, fm = gid * WGM, gsz = (nM - fm) < WGM ? (nM - fm) : WGM;
        u.pm = fm + ((wgid % nig) % gsz); u.pn = (wgid % nig) / gsz; return true;
    }
    __device__ __forceinline__ void a_ready(const Unit&) const {}
    __device__ __forceinline__ void done(const Unit&) const {}
};
__device__ __forceinline__ unsigned cvt_pk_bf16(float lo, float hi) { unsigned r; asm volatile("v_cvt_pk_bf16_f32 %0, %1, %2" : "=v"(r) : "v"(lo), "v"(hi)); return r; }
struct EpiF32 {
    static constexpr bool PERM = false, AFTER_DRAIN = false;
    float* C; int ldc;
    __device__ __forceinline__ void operator()(const f32x4 (&acc)[2][2][4][2], const Unit& u, int wr, int wc, int fr, int fq) const {
        const int row0 = u.pm * BM + wr * 64 + fr, col0 = u.pn * BM + wc * 32 + 4 * fq;
#pragma unroll
        for (int ai = 0; ai < 2; ++ai)
#pragma unroll
            for (int m = 0; m < 4; ++m) { float* rowp = C + (size_t)(row0 + ai * HALF + m * 16) * ldc + col0;
#pragma unroll
                for (int bj = 0; bj < 2; ++bj)
#pragma unroll
                    for (int n = 0; n < 2; ++n) *(f32x4*)(rowp + bj * HALF + n * 16) = acc[ai][bj][m][n]; }
    }
};
struct EpiProj {
    static constexpr bool PERM = true, AFTER_DRAIN = false;
    bf16_t *lx, *lg, *qkv, *z, *ba;
    __device__ __forceinline__ void operator()(const f32x4 (&acc)[2][2][4][2], const Unit& u, int wr, int wc, int fr, int fq) const {
        const int pn = u.pn; bf16_t* base; int ld, colt;
        if (pn < 8) { base = lx; ld = 2048; colt = pn * BM; }
        else if (pn < 16) { base = lg; ld = 2048; colt = (pn - 8) * BM; }
        else if (pn < 40) { base = qkv; ld = 6144; colt = (pn - 16) * BM; }
        else if (pn < 48) { base = z; ld = 2048; colt = (pn - 40) * BM; }
        else { base = ba; ld = 256; colt = 0; }
        const int row0 = u.pm * BM + wr * 64 + fr, col0 = colt + wc * 32 + 8 * fq;
#pragma unroll
        for (int ai = 0; ai < 2; ++ai)
#pragma unroll
            for (int m = 0; m < 4; ++m) { bf16_t* rowp = base + (size_t)(row0 + ai * HALF + m * 16) * ld + col0;
#pragma unroll
                for (int bj = 0; bj < 2; ++bj) { const f32x4 v0 = acc[ai][bj][m][0], v1 = acc[ai][bj][m][1];
                    u32x4 w; w.x = cvt_pk_bf16(v0[0], v0[1]); w.y = cvt_pk_bf16(v0[2], v0[3]); w.z = cvt_pk_bf16(v1[0], v1[1]); w.w = cvt_pk_bf16(v1[2], v1[3]);
                    *(u32x4*)(rowp + bj * HALF) = w; } }
    }
};
struct EpiSwiGLU {
    static constexpr bool PERM = true, AFTER_DRAIN = false;
    bf16_t* O; int ldc;
    __device__ __forceinline__ void operator()(const f32x4 (&acc)[2][2][4][2], const Unit& u, int wr, int wc, int fr, int fq) const {
        const int row0 = u.pm * BM + wr * 64 + fr, col0 = u.pn * HALF + wc * 32 + 8 * fq;
#pragma unroll
        for (int ai = 0; ai < 2; ++ai)
#pragma unroll
            for (int m = 0; m < 4; ++m) { bf16_t* rowp = O + (size_t)(row0 + ai * HALF + m * 16) * ldc + col0;
                float r[8];
#pragma unroll
                for (int n = 0; n < 2; ++n)
#pragma unroll
                    for (int j = 0; j < 4; ++j) { const float g = acc[ai][0][m][n][j], up = acc[ai][1][m][n][j]; r[4 * n + j] = g * __builtin_amdgcn_rcpf(1.0f + __expf(-g)) * up; }
                u32x4 w; w.x = cvt_pk_bf16(r[0], r[1]); w.y = cvt_pk_bf16(r[2], r[3]); w.z = cvt_pk_bf16(r[4], r[5]); w.w = cvt_pk_bf16(r[6], r[7]);
                *(u32x4*)rowp = w; }
    }
};

template <class Epi, class Sched, bool ALIGN_EPI = false, bool SP2 = false>
__device__ __forceinline__ void gemm_phase(PG8_LAS unsigned char* lds, const Gemm g, const Sched& S, const Epi& E) {
    const int tid = threadIdx.x, wid = __builtin_amdgcn_readfirstlane(tid >> 6), lane = tid & 63, wr = wid >> 2, wc = wid & 3, fr = lane & 15, fq = lane >> 4;
    const int K = g.K, nt = K / BK;
    unsigned voffA[2], voffB[2];
#pragma unroll
    for (int i = 0; i < 2; ++i) { int R, C; stage_rc(tid * 16 + i * 8192, R, C); const int Rb = Epi::PERM ? ((R & ~31) + perm32(R & 31)) : R;
        voffA[i] = (unsigned)(R * K + C) * 2u; voffB[i] = (unsigned)(Rb * K + C) * 2u; }
    const size_t kstep = (size_t)(BK * 2);
    const size_t hstep = (size_t)HALF * K * 2;
    const size_t tstep = 2 * hstep;
    const unsigned ldsw = (unsigned)wid * 1024u;
    const int aoff = lds_byte(wr * 64 + fr, fq * 8), boff = lds_byte(wc * 32 + fr, fq * 8);
#define PG8_SA(b, h) (((b) * 2 + (h)) * HTB)
#define PG8_SB(b, h) ((4 + (b) * 2 + (h)) * HTB)
#define PG8_STAGE(bufoff, gbase, voff) do { _Pragma("unroll") for (int _i = 0; _i < 2; ++_i) \
        __builtin_amdgcn_global_load_lds((const unsigned*)((const char*)(gbase) + (voff)[_i]), (PG8_LAS unsigned*)(lds + (bufoff) + ldsw + _i * 8192), 16, 0, 0); } while (0)
#define PG8_LDA(dst, b, h) do { _Pragma("unroll") for (int m = 0; m < 4; ++m) _Pragma("unroll") for (int k = 0; k < 2; ++k) dst[m][k] = *(const PG8_LAS bf16x8*)(lds + PG8_SA(b, h) + aoff + m * 2048 + k * 1024); } while (0)
#define PG8_LDB(dst, b, h) do { _Pragma("unroll") for (int n = 0; n < 2; ++n) _Pragma("unroll") for (int k = 0; k < 2; ++k) dst[n][k] = *(const PG8_LAS bf16x8*)(lds + PG8_SB(b, h) + boff + n * 2048 + k * 1024); } while (0)
#define PG8_MMA(ai, bj, At, Bt) do { __builtin_amdgcn_s_setprio(1); _Pragma("unroll") for (int m = 0; m < 4; ++m) _Pragma("unroll") for (int n = 0; n < 2; ++n) _Pragma("unroll") for (int k = 0; k < 2; ++k) \
        acc[ai][bj][m][n] = __builtin_amdgcn_mfma_f32_16x16x32_bf16(Bt[n][k], At[m][k], acc[ai][bj][m][n], 0, 0, 0); __builtin_amdgcn_s_setprio(0); } while (0)
#define PG8_WAIT_V(n) asm volatile("s_waitcnt vmcnt(" #n ")" ::: "memory")
#define PG8_WAIT_L(n) asm volatile("s_waitcnt lgkmcnt(" #n ")" ::: "memory")
#define PG8_BAR __builtin_amdgcn_s_barrier()
#define PG8_SCHED __builtin_amdgcn_sched_barrier(0)
    Unit cur, nxt; int ui = 0;
    if (!S.next(0, cur)) return;
    f32x4 acc[2][2][4][2];
#pragma unroll
    for (int a = 0; a < 2; ++a)
#pragma unroll
        for (int b = 0; b < 2; ++b)
#pragma unroll
            for (int m = 0; m < 4; ++m)
#pragma unroll
                for (int n = 0; n < 2; ++n) acc[a][b][m][n] = (f32x4){0.f, 0.f, 0.f, 0.f};
    bf16x8 At[4][2], B0[2][2], B1[2][2];
    const char* cA = (const char*)g.A + (size_t)cur.pm * tstep; const char* cB = (const char*)g.Bt + (size_t)cur.pn * tstep;
    S.a_ready(cur);
    if constexpr (SP2) {
        PG8_STAGE(PG8_SB(0, 0), cB, voffB); PG8_STAGE(PG8_SB(0, 1), cB + hstep, voffB); PG8_STAGE(PG8_SA(0, 0), cA, voffA); PG8_STAGE(PG8_SA(0, 1), cA + hstep, voffA);
        if (wr == 1) PG8_BAR;
        PG8_WAIT_V(2); PG8_BAR;
        PG8_STAGE(PG8_SB(1, 0), cB + kstep, voffB); PG8_STAGE(PG8_SA(1, 0), cA + kstep, voffA); PG8_STAGE(PG8_SB(1, 1), cB + hstep + kstep, voffB);
        PG8_WAIT_V(6); PG8_BAR;
    } else {
        PG8_STAGE(PG8_SB(0, 0), cB, voffB); PG8_STAGE(PG8_SA(0, 0), cA, voffA); PG8_STAGE(PG8_SB(0, 1), cB + hstep, voffB); PG8_STAGE(PG8_SA(0, 1), cA + hstep, voffA);
        if (wr == 1) PG8_BAR;
        PG8_WAIT_V(4); PG8_BAR;
        PG8_STAGE(PG8_SB(1, 0), cB + kstep, voffB); PG8_STAGE(PG8_SA(1, 0), cA + kstep, voffA); PG8_STAGE(PG8_SB(1, 1), cB + hstep + kstep, voffB);
        PG8_WAIT_V(6); PG8_BAR;
    }
    for (;;) {
        const bool has_next = S.next(ui + 1, nxt);
        const char* nA = has_next ? (const char*)g.A + (size_t)nxt.pm * tstep : cA; const char* nB = has_next ? (const char*)g.Bt + (size_t)nxt.pn * tstep : cB;
        for (int t = 0; t < nt; t += 2) {
            const bool last = (t == nt - 2);
            const char* a1 = cA + (size_t)(t + 1) * kstep;
            const char* a2 = last ? nA : cA + (size_t)(t + 2) * kstep; const char* b2 = last ? nB : cB + (size_t)(t + 2) * kstep;
            const char* a3 = a2 + kstep; const char* b3 = b2 + kstep;
            if (last && has_next) S.a_ready(nxt);
            if constexpr (SP2) {
            PG8_LDB(B0, 0, 0); PG8_LDB(B1, 0, 1); PG8_SCHED; PG8_LDA(At, 0, 0); PG8_STAGE(PG8_SA(1, 1), a1 + hstep, voffA);
            PG8_WAIT_V(8); PG8_WAIT_L(0); PG8_BAR; PG8_MMA(0, 0, At, B0); PG8_MMA(0, 1, At, B1); PG8_BAR; PG8_SCHED;
            PG8_LDA(At, 0, 1); PG8_STAGE(PG8_SB(0, 0), b2, voffB); PG8_STAGE(PG8_SB(0, 1), b2 + hstep, voffB); PG8_STAGE(PG8_SA(0, 0), a2, voffA);
            PG8_WAIT_V(8); PG8_WAIT_L(0); PG8_BAR; PG8_MMA(1, 0, At, B0); PG8_MMA(1, 1, At, B1); PG8_BAR; PG8_SCHED;
            PG8_LDB(B0, 1, 0); PG8_LDB(B1, 1, 1); PG8_SCHED; PG8_LDA(At, 1, 0); PG8_STAGE(PG8_SA(0, 1), a2 + hstep, voffA);
            PG8_WAIT_V(8); PG8_WAIT_L(0); PG8_BAR; PG8_MMA(0, 0, At, B0); PG8_MMA(0, 1, At, B1); PG8_BAR; PG8_SCHED;
            PG8_LDA(At, 1, 1); PG8_STAGE(PG8_SB(1, 0), b3, voffB); PG8_STAGE(PG8_SB(1, 1), b3 + hstep, voffB); PG8_STAGE(PG8_SA(1, 0), a3, voffA);
            PG8_WAIT_V(8); PG8_WAIT_L(0); PG8_BAR; PG8_MMA(1, 0, At, B0); PG8_MMA(1, 1, At, B1); PG8_BAR; PG8_SCHED;
            } else {
            PG8_LDB(B0, 0, 0); PG8_SCHED; PG8_LDA(At, 0, 0); PG8_STAGE(PG8_SA(1, 1), a1 + hstep, voffA);
            PG8_WAIT_L(8); PG8_BAR; PG8_WAIT_L(0); PG8_MMA(0, 0, At, B0); PG8_BAR; PG8_SCHED;
            PG8_LDB(B1, 0, 1); PG8_STAGE(PG8_SB(0, 0), b2, voffB);
            PG8_BAR; PG8_WAIT_L(0); PG8_MMA(0, 1, At, B1); PG8_BAR;
            PG8_LDA(At, 0, 1); PG8_STAGE(PG8_SA(0, 0), a2, voffA);
            PG8_BAR; PG8_WAIT_L(0); PG8_MMA(1, 0, At, B0); PG8_BAR; PG8_SCHED;
            PG8_STAGE(PG8_SB(0, 1), b2 + hstep, voffB);
            PG8_WAIT_V(6); PG8_BAR; PG8_MMA(1, 1, At, B1); PG8_BAR;
            PG8_LDB(B0, 1, 0); PG8_SCHED; PG8_LDA(At, 1, 0); PG8_STAGE(PG8_SA(0, 1), a2 + hstep, voffA);
            PG8_WAIT_L(8); PG8_BAR; PG8_WAIT_L(0); PG8_MMA(0, 0, At, B0); PG8_BAR; PG8_SCHED;
            PG8_LDB(B1, 1, 1); PG8_STAGE(PG8_SB(1, 0), b3, voffB);
            PG8_BAR; PG8_WAIT_L(0); PG8_MMA(0, 1, At, B1); PG8_BAR;
            PG8_LDA(At, 1, 1); PG8_STAGE(PG8_SA(1, 0), a3, voffA);
            PG8_BAR; PG8_WAIT_L(0); PG8_MMA(1, 0, At, B0); PG8_BAR; PG8_SCHED;
            PG8_STAGE(PG8_SB(1, 1), b3 + hstep, voffB);
            PG8_WAIT_V(6); PG8_BAR; PG8_MMA(1, 1, At, B1); PG8_BAR;
            }
        }
        if constexpr (ALIGN_EPI) { if (wr == 0) PG8_BAR; }
        if constexpr (!Epi::AFTER_DRAIN) { E(acc, cur, wr, wc, fr, fq); S.done(cur); }
        if (!has_next) break;
#pragma unroll
        for (int a = 0; a < 2; ++a)
#pragma unroll
            for (int b = 0; b < 2; ++b)
#pragma unroll
                for (int m = 0; m < 4; ++m)
#pragma unroll
                    for (int n = 0; n < 2; ++n) acc[a][b][m][n] = (f32x4){0.f, 0.f, 0.f, 0.f};
        cur = nxt; cA = nA; cB = nB; ++ui;
        if constexpr (ALIGN_EPI) { if (wr == 1) PG8_BAR; }
    }
    PG8_WAIT_V(0);
    if constexpr (!ALIGN_EPI) { if (wr == 0) PG8_BAR; }
    PG8_BAR;
    if constexpr (Epi::AFTER_DRAIN) { E.fused(acc, cur, wr, wc, fr, fq, lds, wid, lane); S.done(cur); }
#undef PG8_SA
#undef PG8_SB
#undef PG8_STAGE
#undef PG8_LDA
#undef PG8_LDB
#undef PG8_MMA
#undef PG8_WAIT_V
#undef PG8_WAIT_L
#undef PG8_BAR
#undef PG8_SCHED
}
}
constexpr int DM = 4096, NBATCH = 2, TL = 8192, TCX = 256, ML = NBATCH * TL, MC = NBATCH * TCX, MT = ML + MC;
constexpr int LW = 2048, GDW = 2048, NH = 16, HD = 128, DFF = 11008, NIN = 12352, NINP = 12544, NADA = 6 * DM;
constexpr int SEQ_S = TCX + TL;
constexpr int NCH = 132;
constexpr float EPS = 1e-6f;
enum { I_X = 0, I_C, I_CTX, I_CCTX, I_WADA, I_BADA, I_GPREMIX, I_GPOSTMIX, I_GPREFFN, I_GPOSTFFN, I_WIN, I_LCW, I_LCB, I_LWA, I_LBA, I_LWX, I_LBX, I_LLAM, I_LNG, I_GCW, I_GALOG, I_GDT, I_GNG, I_WOUT, I_WG, I_WU, I_WD, N_INPUTS };

constexpr size_t MiB = 1u << 20;
constexpr size_t WS_CTL = 0, CTL_ZERO_BYTES = 1 * MiB;
constexpr size_t WS_MODP = 1 * MiB, WS_MOD = 11 * MiB, WS_WL = 12 * MiB, WS_CAR = 14 * MiB, WS_HIN = 23 * MiB, WS_GB = 28 * MiB, WS_KQ = 33 * MiB, WS_SSQ = 35 * MiB;
constexpr size_t WS_WOUT = 44 * MiB, WS_WGU = 76 * MiB, WS_WDN = 248 * MiB;
constexpr size_t WS_R2 = 334 * MiB;
constexpr size_t WS_WIN = WS_R2, WS_H = WS_R2 + 98 * MiB;
constexpr size_t WS_QN = WS_R2, WS_KN = WS_R2 + 66 * MiB, WS_VN = WS_R2 + 132 * MiB;
constexpr size_t WS_H2 = WS_R2, WS_Y2 = WS_R2;
constexpr size_t WS_R3 = 590 * MiB;
constexpr size_t WS_LX = WS_R3, WS_LG = WS_R3 + 66 * MiB, WS_QKV = WS_R3 + 132 * MiB, WS_Z = WS_R3 + 330 * MiB, WS_BA = WS_R3 + 396 * MiB;
constexpr size_t WS_Y1 = WS_R3, WS_ACT = WS_R3;
constexpr size_t WS_MIX = 995 * MiB;
constexpr size_t WS_UT = 1123 * MiB, WS_W = 1255 * MiB, WS_INTRA = 1387 * MiB, WS_QC = 1453 * MiB, WS_END = 1519 * MiB;
constexpr size_t WS_KT = WS_QKV, WS_GSC = 37 * MiB;
static_assert(WS_SSQ + (size_t)ML * 16 * 4 <= WS_WOUT && WS_WOUT + (size_t)DM * DM * 2 <= WS_WGU && WS_WGU + (size_t)2 * DFF * DM * 2 <= WS_WDN && WS_WDN + (size_t)DM * DFF * 2 <= WS_R2, "ws map 1");
static_assert(WS_WIN + (size_t)NINP * DM * 2 <= WS_H && WS_H + (size_t)MT * DM * 2 <= WS_R3 && WS_VN + (size_t)NBATCH * SEQ_S * 2048 * 2 <= WS_R3 && WS_Y2 + (size_t)ML * DM * 4 <= WS_R3, "ws map 2");
static_assert((size_t)MT * 2048 * 2 <= 66 * MiB && (size_t)MT * 6144 * 2 <= 198 * MiB && WS_BA + (size_t)MT * 256 * 2 <= WS_MIX && WS_ACT + (size_t)ML * DFF * 2 <= WS_MIX && WS_MIX + (size_t)ML * DM * 2 <= WS_UT, "ws map 3");
static_assert((size_t)NBATCH * NH * NCH * 2 * 8192 * 2 == 132 * MiB && WS_KT + 132 * MiB <= WS_Z && WS_GSC + (size_t)NBATCH * NH * NCH * 2 * 128 * 4 <= WS_WOUT && WS_SSQ + (size_t)ML * 16 * 4 <= WS_GSC, "ws map 4");
constexpr int CW_BAR = 4096;

constexpr int LDS_BYTES = 147456;
constexpr int MISC_OFF = LDS_BYTES - 256;

#define GAS __attribute__((address_space(1)))
#define LAS __attribute__((address_space(3)))
typedef unsigned short bf16;
typedef unsigned u32x4 __attribute__((ext_vector_type(4)));
typedef unsigned u32x2 __attribute__((ext_vector_type(2)));
typedef float f32x4 __attribute__((ext_vector_type(4)));
typedef float f32x2 __attribute__((ext_vector_type(2)));
typedef short bf16x8 __attribute__((ext_vector_type(8)));
#define LDS_WAIT() asm volatile("s_waitcnt lgkmcnt(0)" ::: "memory")
#define WAVE_LDS_FENCE() do { asm volatile("s_waitcnt lgkmcnt(0)" ::: "memory"); __builtin_amdgcn_wave_barrier(); } while (0)
__device__ __forceinline__ unsigned f2bf(float f) { unsigned u = __builtin_bit_cast(unsigned, f); return (u + 0x7fffu + ((u >> 16) & 1u)) >> 16; }
__device__ __forceinline__ unsigned pk2(float lo, float hi) { return f2bf(lo) | (f2bf(hi) << 16); }
__device__ __forceinline__ float bf2f(unsigned h) { return __builtin_bit_cast(float, h << 16); }
__device__ __forceinline__ float bflo(unsigned w) { return __builtin_bit_cast(float, w << 16); }
__device__ __forceinline__ float bfhi(unsigned w) { return __builtin_bit_cast(float, w & 0xffff0000u); }
__device__ __forceinline__ float wave_sum(float v) {
#pragma unroll
    for (int o = 1; o < 64; o <<= 1) v += __shfl_xor(v, o);
    return v;
}
__device__ __forceinline__ float sigmoidf_(float x) { return __builtin_amdgcn_rcpf(1.0f + __expf(-x)); }
__device__ __forceinline__ float siluf_(float x) { return x * sigmoidf_(x); }
__device__ __forceinline__ float softplusf_(float x) { return x > 20.f ? x : log1pf(__expf(x)); }
__device__ __forceinline__ float gelu_tanhf_(float x) { const float u = 0.7978845608028654f * (x + 0.044715f * x * x * x); const float t = 1.0f - 2.0f * __builtin_amdgcn_rcpf(__expf(2.0f * u) + 1.0f); return 0.5f * x * (1.0f + t); }
__device__ __forceinline__ float rdlane(float x, int l) { return __builtin_bit_cast(float, __builtin_amdgcn_readlane(__builtin_bit_cast(int, x), l)); }

#define XB_TMO      128
#define XB_XCNT(j)  (256  + 64 * (j))
#define XB_XSUB(j)  (1280 + 64 * (j))
#define XB_XGEN(j)  (2304 + 64 * (j))
#define XB_TOP      3328
#define XB_TOPGEN   3392
#define XCD_BAR_WORDS 3456
#define XB_SPIN_CAP (1u << 22)
__device__ __forceinline__ unsigned xb_ld(unsigned* p)              { return __hip_atomic_load(p, __ATOMIC_RELAXED, __HIP_MEMORY_SCOPE_AGENT); }
__device__ __forceinline__ unsigned xb_add(unsigned* p, unsigned v) { return __hip_atomic_fetch_add(p, v, __ATOMIC_RELAXED, __HIP_MEMORY_SCOPE_AGENT); }
__device__ __forceinline__ unsigned xb_xcc_id() { return (unsigned)__builtin_amdgcn_s_getreg((3 << 11) | 20) & 0xFu; }
#define XB_SPIN(cond, bar) do { unsigned _sp = 0; while (cond) { __builtin_amdgcn_s_sleep(1); \
    if ((++_sp & 255u) == 0u) { if (xb_ld(&(bar)[XB_TMO])) break; if (_sp > XB_SPIN_CAP) { atomicAdd(&(bar)[XB_TMO], 1u); break; } } } } while (0)
struct XcdBarrier { unsigned* bar; unsigned x; volatile LAS unsigned* st; };
__device__ __forceinline__ XcdBarrier xcd_barrier_post(unsigned* bar, volatile LAS unsigned* st) {
    XcdBarrier b; b.bar = bar; b.x = xb_xcc_id(); b.st = st;
    if (threadIdx.x == 0) (void)xb_add(&bar[XB_XCNT(b.x)], 1u);
    return b;
}
__device__ __forceinline__ void xcd_barrier_complete(unsigned* bar, unsigned x, unsigned& nloc, unsigned& nx) {
    const unsigned G = gridDim.x * gridDim.y * gridDim.z;
    unsigned sum, cnt, mine, sp = 0u;
    for (;;) {
        sum = 0u; cnt = 0u; mine = 0u;
#pragma unroll
        for (unsigned j = 0; j < 16; ++j) { const unsigned c = xb_ld(&bar[XB_XCNT(j)]); sum += c; cnt += (c > 0u) ? 1u : 0u; mine = (j == x) ? c : mine; }
        if (sum == G) break;
        __builtin_amdgcn_s_sleep(1);
        if ((++sp & 255u) == 0u) { if (xb_ld(&bar[XB_TMO])) break; if (sp > XB_SPIN_CAP) { atomicAdd(&bar[XB_TMO], 1u); break; } }
    }
    nloc = mine > 0u ? mine : 1u; nx = cnt > 0u ? cnt : 1u;
}
__device__ __forceinline__ void xcd_barrier(const XcdBarrier& b) {
    asm volatile("s_waitcnt vmcnt(0)" ::: "memory");
    __syncthreads();
    if (threadIdx.x == 0) {
        unsigned* bar = b.bar;
        __builtin_amdgcn_s_waitcnt(0);
        unsigned nloc = b.st[0], nx = b.st[1];
        if (nloc == 0u) { xcd_barrier_complete(bar, b.x, nloc, nx); b.st[0] = nloc; b.st[1] = nx; }
        const unsigned old = xb_add(&bar[XB_XSUB(b.x)], 1u);
        const unsigned gen = old / nloc;
        if (old + 1u == (gen + 1u) * nloc) {
            __builtin_amdgcn_fence(__ATOMIC_RELEASE, "agent");
            asm volatile("s_waitcnt vmcnt(0)" ::: "memory");
            const unsigned og = xb_add(&bar[XB_TOP], 1u);
            const unsigned tg = og / nx;
            if (og + 1u == (tg + 1u) * nx) xb_add(&bar[XB_TOPGEN], 1u);
            else XB_SPIN(xb_ld(&bar[XB_TOPGEN]) == tg, bar);
            __builtin_amdgcn_fence(__ATOMIC_ACQUIRE, "agent");
            xb_add(&bar[XB_XGEN(b.x)], 1u);
            asm volatile("s_waitcnt vmcnt(0)" ::: "memory");
        } else {
            XB_SPIN(xb_ld(&bar[XB_XGEN(b.x)]) == gen, bar);
            __builtin_amdgcn_fence(__ATOMIC_ACQUIRE, "agent");
            asm volatile("s_waitcnt vmcnt(0)" ::: "memory");
        }
    }
    __syncthreads();
}

struct Args { const float* in[N_INPUTS]; float* out; unsigned char* ws; int ph_lo, ph_hi; };
struct Frame {
    LAS unsigned char* lds;
    int tid, lane, wave, vcu, G;
    const float* const* in;
    float* out; unsigned char* ws;
};
#define F_modp ((float*)(F.ws + WS_MODP))
#define F_mod ((float*)(F.ws + WS_MOD))
#define F_WL ((bf16*)(F.ws + WS_WL))
#define F_CAR ((f32x2*)(F.ws + WS_CAR))
#define F_HIN ((float*)(F.ws + WS_HIN))
#define F_GB ((f32x2*)(F.ws + WS_GB))
#define F_KQ ((float*)(F.ws + WS_KQ))
#define F_SSQ ((float*)(F.ws + WS_SSQ))
#define F_Wt_out ((bf16*)(F.ws + WS_WOUT))
#define F_Wt_gu ((bf16*)(F.ws + WS_WGU))
#define F_Wt_dn ((bf16*)(F.ws + WS_WDN))
#define F_Wt_in ((bf16*)(F.ws + WS_WIN))
#define F_H ((bf16*)(F.ws + WS_H))
#define F_QN ((bf16*)(F.ws + WS_QN))
#define F_KN ((bf16*)(F.ws + WS_KN))
#define F_VN ((bf16*)(F.ws + WS_VN))
#define F_H2 ((bf16*)(F.ws + WS_H2))
#define F_LX ((bf16*)(F.ws + WS_LX))
#define F_LG ((bf16*)(F.ws + WS_LG))
#define F_QKV ((bf16*)(F.ws + WS_QKV))
#define F_Z ((bf16*)(F.ws + WS_Z))
#define F_BA ((bf16*)(F.ws + WS_BA))
#define F_ACT ((bf16*)(F.ws + WS_ACT))
#define F_MIX ((bf16*)(F.ws + WS_MIX))
#define F_Y1 ((float*)(F.ws + WS_Y1))
#define F_Y2 ((float*)(F.ws + WS_Y2))
#define F_O (F.out)
#define F_UT ((bf16*)(F.ws + WS_UT))
#define F_W ((bf16*)(F.ws + WS_W))
#define F_INTRA ((bf16*)(F.ws + WS_INTRA))
#define F_KT ((bf16*)(F.ws + WS_KT))
#define F_GSC ((float*)(F.ws + WS_GSC))
#define F_QC ((bf16*)(F.ws + WS_QC))
__device__ __forceinline__ void transpose_item(const float* W, int N, bf16* WT, int Kp, int k0, int n0, int drow0, LAS float* scr, int lane) {
#pragma unroll 8
    for (int i = 0; i < 32; ++i) { const int kk = 2 * i + (lane >> 5); scr[kk * 33 + (lane & 31)] = W[(size_t)(k0 + kk) * N + n0 + (lane & 31)]; }
    LDS_WAIT(); asm volatile("" ::: "memory");
    const int c = lane & 7;
#pragma unroll
    for (int j = 0; j < 4; ++j) { const int n = (lane >> 3) + 8 * j; const LAS float* s = scr + (8 * c) * 33 + n;
        u32x4 o; o.x = pk2(s[0 * 33], s[1 * 33]); o.y = pk2(s[2 * 33], s[3 * 33]); o.z = pk2(s[4 * 33], s[5 * 33]); o.w = pk2(s[6 * 33], s[7 * 33]);
        *(u32x4*)(WT + (size_t)(drow0 + n) * Kp + k0 + 8 * c) = o; }
    LDS_WAIT(); asm volatile("" ::: "memory");
}

__device__ __forceinline__ void ph0_prologue(const Frame& F) {
    const int gw = F.vcu * 8 + F.wave, NGW = F.G * 8, lane = F.lane;
    {
        const float* W = F.in[I_WADA]; const float* c = F.in[I_C]; const float* cc = F.in[I_CCTX];
        for (int it = gw; it < 96 * 32; it += NGW) {
            const int cg = it % 96, kc = it / 96;
            float sv[3][2];
#pragma unroll
            for (int h = 0; h < 2; ++h) { const int k = kc * 128 + h * 64 + lane; sv[0][h] = siluf_(c[k]); sv[1][h] = siluf_(c[DM + k]); sv[2][h] = siluf_(cc[k]); }
            f32x4 a0 = {0.f, 0.f, 0.f, 0.f}, a1 = a0, a2 = a0;
            const f32x4* wp = (const f32x4*)(W + (size_t)kc * 128 * NADA + cg * 256) + lane;
#pragma unroll
            for (int h = 0; h < 2; ++h) {
#pragma unroll 8
                for (int kk = 0; kk < 64; ++kk) { const f32x4 w = wp[(size_t)(h * 64 + kk) * (NADA / 4)];
                    const float s0 = rdlane(sv[0][h], kk), s1 = rdlane(sv[1][h], kk), s2 = rdlane(sv[2][h], kk);
                    a0 += w * s0; a1 += w * s1; a2 += w * s2; } }
            float* mp = F_modp + (size_t)(kc * 3) * NADA + cg * 256;
            ((f32x4*)mp)[lane] = a0; ((f32x4*)(mp + NADA))[lane] = a1; ((f32x4*)(mp + 2 * NADA))[lane] = a2;
        }
    }
    {
        LAS float* scr = (LAS float*)(F.lds + F.wave * 16384);
        constexpr int IT_IN = 64 * (NIN / 32), IT_OUT = 64 * (DM / 32), IT_G = 64 * (DFF / 32), IT_D = (DFF / 64) * (DM / 32), IT_L = 64 * 8;
        constexpr int NITEMS = IT_IN + IT_OUT + 2 * IT_G + IT_D + IT_L;
        for (int it = gw; it < NITEMS; it += NGW) {
            int r = it;
            if (r < IT_IN) { const int kb = r / (NIN / 32), nb = r % (NIN / 32); transpose_item(F.in[I_WIN], NIN, F_Wt_in, DM, 64 * kb, 32 * nb, 32 * nb, scr, lane); continue; } r -= IT_IN;
            if (r < IT_OUT) { const int kb = r / (DM / 32), nb = r % (DM / 32); transpose_item(F.in[I_WOUT], DM, F_Wt_out, DM, 64 * kb, 32 * nb, 32 * nb, scr, lane); continue; } r -= IT_OUT;
            if (r < 2 * IT_G) { const int up = r >= IT_G; if (up) r -= IT_G; const int kb = r / (DFF / 32), nb = r % (DFF / 32), n0 = 32 * nb;
                transpose_item(F.in[up ? I_WU : I_WG], DFF, F_Wt_gu, DM, 64 * kb, n0, 256 * (n0 >> 7) + (n0 & 127) + (up ? 128 : 0), scr, lane); continue; } r -= 2 * IT_G;
            if (r < IT_D) { const int kb = r / (DM / 32), nb = r % (DM / 32); transpose_item(F.in[I_WD], DM, F_Wt_dn, DFF, 64 * kb, 32 * nb, 32 * nb, scr, lane); continue; } r -= IT_D;
            { const int mi = r >> 3, sub = r & 7, kb = sub >> 2, nb = sub & 3, d = mi >> 5, kind = (mi >> 4) & 1, n = mi & 15;
              transpose_item(F.in[kind ? I_LWX : I_LWA] + (size_t)(d * 16 + n) * 16384, 128, F_WL + (size_t)((d * 2 + kind) * 16 + n) * 16384, 128, 64 * kb, 32 * nb, 32 * nb, scr, lane); }
        }
    }
    {
        u32x4* p = (u32x4*)(F_Wt_in + (size_t)NIN * DM); const u32x4 z = {0u, 0u, 0u, 0u};
        for (int i = F.vcu * 512 + F.tid; i < (NINP - NIN) * DM / 8; i += F.G * 512) p[i] = z;
    }
}
__device__ __forceinline__ void ph1_modreduce(const Frame& F) {
    const float* ba = F.in[I_BADA];
    for (int i = F.vcu * 512 + F.tid; i < 3 * NADA; i += F.G * 512) { const int r = i / NADA, col = i - r * NADA; float s = ba[col];
#pragma unroll 8
        for (int kc = 0; kc < 32; ++kc) s += F_modp[(size_t)(kc * 3 + r) * NADA + col];
        F_mod[i] = s; }
}
__device__ __forceinline__ void ph2_hrows(const Frame& F) {
    const int gw = F.vcu * 8 + F.wave, NGW = F.G * 8, lane = F.lane;
    const f32x4* g4 = (const f32x4*)F.in[I_GPREMIX];
    for (int row = gw; row < MT; row += NGW) {
        const float* xr = row < ML ? F.in[I_X] + (size_t)row * DM : F.in[I_CTX] + (size_t)(row - ML) * DM;
        const int mr = row < ML ? row / TL : 2;
        const f32x4* sh4 = (const f32x4*)(F_mod + (size_t)mr * NADA); const f32x4* sc4 = sh4 + DM / 4;
        f32x4 v[16]; float ss = 0.f;
#pragma unroll
        for (int j = 0; j < 16; ++j) { v[j] = ((const f32x4*)xr)[lane + 64 * j]; ss += (v[j].x * v[j].x + v[j].y * v[j].y) + (v[j].z * v[j].z + v[j].w * v[j].w); }
        const float rs = rsqrtf(wave_sum(ss) * (1.0f / DM) + EPS);
        u32x2* o = (u32x2*)(F_H + (size_t)row * DM);
#pragma unroll
        for (int j = 0; j < 16; ++j) { const f32x4 g = g4[lane + 64 * j], sh = sh4[lane + 64 * j], sc = sc4[lane + 64 * j];
            const f32x4 y = (v[j] * rs * g) * (sc + 1.0f) + sh; u32x2 w; w.x = pk2(y.x, y.y); w.y = pk2(y.z, y.w); o[lane + 64 * j] = w; }
    }
}

template <int PASS>
__device__ __forceinline__ void lru_pass(const Frame& F) {
    LAS bf16* U = (LAS bf16*)(F.lds);
    LAS float* XC = (LAS float*)(F.lds + 17408);
    LAS bf16* XCB = (LAS bf16*)(F.lds + 17408 + 32768);
    LAS f32x2* SC = (LAS f32x2*)(F.lds + 17408 + 32768 + 17408 + F.wave * 8192);
    const int tid = F.tid, lane = F.lane, w = F.wave, fr = lane & 15, fq = lane >> 4;
    const int n = F.vcu & 15;
    const int cl = 16 * w + fr, cg = n * 128 + cl;
    float ba[2], bx[2], sp[2];
#pragma unroll
    for (int d = 0; d < 2; ++d) { ba[d] = F.in[I_LBA][d * LW + cg]; bx[d] = F.in[I_LBX][d * LW + cg]; sp[d] = softplusf_(-F.in[I_LLAM][d * LW + cg]); }
    const int cc = tid & 127, tg = tid >> 7;
    float cw[4];
#pragma unroll
    for (int j = 0; j < 4; ++j) cw[j] = F.in[I_LCW][j * LW + n * 128 + cc];
    const float cb = F.in[I_LCB][n * 128 + cc];
    for (int q = F.vcu >> 4; q < NBATCH * NCH; q += F.G >> 4) {
        const int b = q / NCH, cidx = q - b * NCH;
        if (PASS == 2 && cidx < 4) continue;
        const bool isctx = cidx < 4; const int t0 = isctx ? cidx * 64 : (cidx - 4) * 64, Tseq = isctx ? TCX : TL;
        const size_t rowbase = isctx ? (size_t)ML + (size_t)b * TCX : (size_t)b * TL;
        __syncthreads();
        for (int rr = tid >> 4; rr < 67; rr += 32) { const int t = t0 - 2 + rr; u32x4 v = {0u, 0u, 0u, 0u};
            if (t >= 0 && t < Tseq) v = *(const u32x4*)(F_LX + (rowbase + t) * LW + n * 128 + (tid & 15) * 8);
            *(LAS u32x4*)(U + rr * 128 + (tid & 15) * 8) = v; }
        u32x4 gt0 = {0u, 0u, 0u, 0u}, gt1 = gt0;
        if (PASS == 2) { gt0 = *(const u32x4*)(F_LG + (rowbase + t0 + (tid >> 4)) * LW + n * 128 + (tid & 15) * 8); gt1 = *(const u32x4*)(F_LG + (rowbase + t0 + 32 + (tid >> 4)) * LW + n * 128 + (tid & 15) * 8); }
        __syncthreads();
        { float x0 = bf2f(U[(tg * 16 + 0) * 128 + cc]), x1 = bf2f(U[(tg * 16 + 1) * 128 + cc]), x2 = bf2f(U[(tg * 16 + 2) * 128 + cc]);
#pragma unroll
          for (int i = 0; i < 16; ++i) { const int tt = tg * 16 + i; const float x3 = bf2f(U[(tt + 3) * 128 + cc]);
              const float y = cb + cw[0] * x0 + cw[1] * x1 + cw[2] * x2 + cw[3] * x3; XC[tt * 128 + cc] = y; XCB[tt * 136 + cc] = (bf16)f2bf(y); x0 = x1; x1 = x2; x2 = x3; } }
        __syncthreads();
        if (PASS == 2) { *(LAS u32x4*)(U + (tid >> 4) * 128 + (tid & 15) * 8) = gt0; *(LAS u32x4*)(U + (32 + (tid >> 4)) * 128 + (tid & 15) * 8) = gt1; }
        float hsum[4][4];
#pragma unroll
        for (int d = 0; d < 2; ++d) {
            bf16x8 bfr[2][4];
#pragma unroll
            for (int mat = 0; mat < 2; ++mat)
#pragma unroll
                for (int ks = 0; ks < 4; ++ks) bfr[mat][ks] = *(const bf16x8*)(F_WL + ((size_t)((2 * d + mat) * 16 + n) * 128 + cl) * 128 + 32 * ks + 8 * fq);
            f32x4 acc[2][4];
#pragma unroll
            for (int mat = 0; mat < 2; ++mat)
#pragma unroll
                for (int mt = 0; mt < 4; ++mt) acc[mat][mt] = (f32x4){0.f, 0.f, 0.f, 0.f};
#pragma unroll
            for (int mt = 0; mt < 4; ++mt)
#pragma unroll
                for (int ks = 0; ks < 4; ++ks) { const bf16x8 af = *(const LAS bf16x8*)(XCB + (16 * mt + fr) * 136 + 32 * ks + 8 * fq);
                    acc[0][mt] = __builtin_amdgcn_mfma_f32_16x16x32_bf16(af, bfr[0][ks], acc[0][mt], 0, 0, 0);
                    acc[1][mt] = __builtin_amdgcn_mfma_f32_16x16x32_bf16(af, bfr[1][ks], acc[1][mt], 0, 0, 0); }
#pragma unroll
            for (int mt = 0; mt < 4; ++mt)
#pragma unroll
                for (int rg = 0; rg < 4; ++rg) { const int tok = 16 * mt + 4 * fq + rg; const float xcv = XC[tok * 128 + cl];
                    const float r = sigmoidf_(acc[0][mt][rg] + ba[d]), ig = sigmoidf_(acc[1][mt][rg] + bx[d]);
                    const float la = -8.0f * r * sp[d]; const float a = __expf(la); const float x2 = 2.0f * la;
                    const float em = -x2 * (1.0f + x2 * (0.5f + x2 * (0.16666667f + x2 * (0.041666668f + x2 * (0.0083333338f + x2 * 0.0013888889f)))));
                    const float bb = sqrtf(em) * (ig * xcv);
                    SC[tok * 16 + fr] = (f32x2){a, bb}; }
            WAVE_LDS_FENCE();
            float P = 1.0f, h = 0.0f;
#pragma unroll
            for (int i = 0; i < 16; ++i) { const int tok = 16 * fq + (d == 0 ? i : 15 - i); const f32x2 ab = SC[tok * 16 + fr]; h = ab.x * h + ab.y; P *= ab.x; SC[tok * 16 + fr] = (f32x2){P, h}; }
            float As[4], Bs[4];
#pragma unroll
            for (int s = 0; s < 4; ++s) { As[s] = __shfl(P, s * 16 + fr); Bs[s] = __shfl(h, s * 16 + fr); }
            const size_t cidx_off = ((size_t)((d * 2 + b) * NCH + cidx)) * LW + cg;
            if (PASS == 1) {
                float At = 1.0f, Bt = 0.0f;
#pragma unroll
                for (int s = 0; s < 4; ++s) { const int sgi = d == 0 ? s : 3 - s; Bt = As[sgi] * Bt + Bs[sgi]; At *= As[sgi]; }
                if (fq == 0) F_CAR[cidx_off] = (f32x2){At, Bt};
            } else {
                float hin = F_HIN[cidx_off];
#pragma unroll
                for (int s = 0; s < 4; ++s) { const int sgi = d == 0 ? s : 3 - s; const bool before = d == 0 ? (sgi < fq) : (sgi > fq); if (before) hin = As[sgi] * hin + Bs[sgi]; }
#pragma unroll
                for (int i = 0; i < 16; ++i) { const int tok = 16 * fq + i; const f32x2 ph = SC[tok * 16 + fr]; SC[tok * 16 + fr] = (f32x2){ph.x, ph.y + ph.x * hin}; }
                WAVE_LDS_FENCE();
#pragma unroll
                for (int mt = 0; mt < 4; ++mt)
#pragma unroll
                    for (int rg = 0; rg < 4; ++rg) { const float hv = SC[(16 * mt + 4 * fq + rg) * 16 + fr].y; hsum[mt][rg] = d == 0 ? hv : hsum[mt][rg] + hv; }
            }
            WAVE_LDS_FENCE();
        }
        if (PASS == 2) {
            __syncthreads();
#pragma unroll
            for (int mt = 0; mt < 4; ++mt)
#pragma unroll
                for (int rg = 0; rg < 4; ++rg) { const int tok = 16 * mt + 4 * fq + rg;
                    const float y = hsum[mt][rg] * gelu_tanhf_(bf2f(U[tok * 128 + cl])); XCB[tok * 136 + cl] = (bf16)f2bf(y); }
            __syncthreads();
#pragma unroll
            for (int hh = 0; hh < 2; ++hh) { const int tok = hh * 32 + (tid >> 4); const u32x4 wv = *(const LAS u32x4*)(XCB + tok * 136 + (tid & 15) * 8);
                const size_t row = rowbase + t0 + tok; *(u32x4*)(F_MIX + row * DM + n * 128 + (tid & 15) * 8) = wv;
                float sq = (bflo(wv.x) * bflo(wv.x) + bfhi(wv.x) * bfhi(wv.x)) + (bflo(wv.y) * bflo(wv.y) + bfhi(wv.y) * bfhi(wv.y)) + (bflo(wv.z) * bflo(wv.z) + bfhi(wv.z) * bfhi(wv.z)) + (bflo(wv.w) * bflo(wv.w) + bfhi(wv.w) * bfhi(wv.w));
                sq += __shfl_xor(sq, 1); sq += __shfl_xor(sq, 2); sq += __shfl_xor(sq, 4); sq += __shfl_xor(sq, 8);
                if ((tid & 15) == 0) F_SSQ[row * 16 + n] = sq; }
        }
    }
}
__device__ __forceinline__ int gdn_row(int b, int s) {
    if (s < TCX) return ML + b * TCX + s;
    const int m = s - TCX; return b * TL + (m & 127) * 64 + (m >> 7);
}
__device__ __forceinline__ void gdn_pre(const Frame& F) {
    const int gw = F.vcu * 8 + F.wave, NGW = F.G * 8, lane = F.lane;
    const float* cw = F.in[I_GCW];
    for (int tok = gw; tok < NBATCH * SEQ_S; tok += NGW) {
        const int b = tok / SEQ_S, s = tok - b * SEQ_S;
        const int lo = s < TCX ? 0 : TCX, hi = s < TCX ? TCX : SEQ_S;
        int rows[4]; bool val[4];
#pragma unroll
        for (int j = 0; j < 4; ++j) { const int sj = s + j - 2; val[j] = sj >= lo && sj < hi; rows[j] = gdn_row(b, val[j] ? sj : s); }
        for (int h = 0; h < NH; ++h) {
            float a[3][2];
#pragma unroll
            for (int p = 0; p < 3; ++p) { a[p][0] = 0.f; a[p][1] = 0.f; }
#pragma unroll
            for (int j = 0; j < 4; ++j) {
#pragma unroll
                for (int p = 0; p < 3; ++p) { const int ch = p * GDW + h * HD + 2 * lane;
                    const unsigned xw = val[j] ? *(const unsigned*)(F_QKV + (size_t)rows[j] * 6144 + ch) : 0u;
                    const f32x2 wv = *(const f32x2*)(cw + (size_t)j * 6144 + ch);
                    a[p][0] += wv.x * bflo(xw); a[p][1] += wv.y * bfhi(xw); } }
#pragma unroll
            for (int p = 0; p < 3; ++p) { a[p][0] = siluf_(a[p][0]); a[p][1] = siluf_(a[p][1]); }
            const float rq = rsqrtf(wave_sum(a[0][0] * a[0][0] + a[0][1] * a[0][1]) + EPS), rk = rsqrtf(wave_sum(a[1][0] * a[1][0] + a[1][1] * a[1][1]) + EPS);
            const unsigned qw = pk2(a[0][0] * rq, a[0][1] * rq), kw = pk2(a[1][0] * rk, a[1][1] * rk), vw = pk2(a[2][0], a[2][1]);
            const float kq = wave_sum(bflo(qw) * bflo(kw) + bfhi(qw) * bfhi(kw));
            const size_t o = ((size_t)b * SEQ_S + s) * GDW + h * HD + 2 * lane;
            *(unsigned*)(F_QN + o) = qw; *(unsigned*)(F_KN + o) = kw; *(unsigned*)(F_VN + o) = vw;
            if (lane == 0) F_KQ[(size_t)(b * NH + h) * SEQ_S + s] = kq;
        }
        if (lane < 32) { const int d = lane >> 4, h = lane & 15; const bf16* bar = F_BA + (size_t)rows[2] * 256;
            const float pb = bf2f(bar[d * 16 + h]), pa = bf2f(bar[32 + d * 16 + h]);
            const float beta = sigmoidf_(pb), g = -__expf(F.in[I_GALOG][d * 16 + h]) * softplusf_(pa + F.in[I_GDT][d * 16 + h]);
            F_GB[(size_t)((d * 2 + b) * NH + h) * SEQ_S + s] = (f32x2){g, beta}; }
    }
}
__device__ __forceinline__ void lru_chains(const Frame& F) {
    if (F.tid < 32) {
        for (int chain = F.vcu * 32 + F.tid; chain < 2 * NBATCH * LW; chain += F.G * 32) {
            const int cg = chain & (LW - 1), b = (chain >> 11) & 1, d = chain >> 12;
            float h = 0.f;
#pragma unroll 4
            for (int step = 0; step < NCH; ++step) { const int cidx = d == 0 ? step : (step < 4 ? 3 - step : NCH - 1 - (step - 4));
                const size_t idx = ((size_t)((d * 2 + b) * NCH + cidx)) * LW + cg; const f32x2 ab = F_CAR[idx]; F_HIN[idx] = h; h = ab.x * h + ab.y; }
        }
    }
}
__device__ __forceinline__ int gdn_spos(int d, int step) { return d == 0 ? step : (step < TCX ? TCX - 1 - step : SEQ_S - 1 - (step - TCX)); }
__device__ __forceinline__ void gdn_seq(const Frame& F, int item) {
    const int sl = item & 3, d = (item >> 2) & 1, h = (item >> 3) & 15, b = item >> 7;
    LAS float* Kst = (LAS float*)F.lds;
    LAS float* Qst = Kst + 2048;
    LAS float* Vst = Qst + 2048;
    LAS float* Gst = Vst + 512;
    LAS f32x2* RED = (LAS f32x2*)(Gst + 64);
    const int tid = F.tid, v = tid & 31, kg = tid >> 5;
    float S[8];
#pragma unroll
    for (int i = 0; i < 8; ++i) S[i] = 0.f;
    const bf16* Kb = F_KN + (size_t)b * SEQ_S * GDW + h * HD + (tid & 31) * 4;
    const bf16* Qb = F_QN + (size_t)b * SEQ_S * GDW + h * HD + (tid & 31) * 4;
    const bf16* Vb = F_VN + (size_t)b * SEQ_S * GDW + h * HD + sl * 32 + (tid & 31);
    const f32x2* GBp = F_GB + (size_t)((d * 2 + b) * NH + h) * SEQ_S; const float* KQp = F_KQ + (size_t)(b * NH + h) * SEQ_S;
    float* Ob = F_O + (size_t)d * ML * GDW + h * HD + sl * 32 + v;
    u32x2 pk, pq; unsigned pv; f32x2 pgb = {0.f, 0.f}; float pkq = 0.f;
#define GDN_LOADG(g0) do { const int s_ = gdn_spos(d, (g0) + (tid >> 5)); pk = *(const u32x2*)(Kb + (size_t)s_ * GDW); pq = *(const u32x2*)(Qb + (size_t)s_ * GDW); pv = Vb[(size_t)s_ * GDW]; \
        if (tid < 16) { const int s2_ = gdn_spos(d, (g0) + tid); pgb = GBp[s2_]; pkq = KQp[s2_]; } } while (0)
    GDN_LOADG(0);
    for (int g0 = 0; g0 < SEQ_S; g0 += 16) {
        *(LAS f32x4*)(Kst + (tid >> 5) * 128 + (tid & 31) * 4) = (f32x4){bflo(pk.x), bfhi(pk.x), bflo(pk.y), bfhi(pk.y)};
        *(LAS f32x4*)(Qst + (tid >> 5) * 128 + (tid & 31) * 4) = (f32x4){bflo(pq.x), bfhi(pq.x), bflo(pq.y), bfhi(pq.y)};
        Vst[(tid >> 5) * 32 + (tid & 31)] = bf2f(pv);
        if (tid < 16) { Gst[tid] = __expf(pgb.x); Gst[16 + tid] = pgb.y; Gst[32 + tid] = pkq; }
        if (g0 + 16 < SEQ_S) GDN_LOADG(g0 + 16);
        __syncthreads();
#pragma unroll 2
        for (int j = 0; j < 16; ++j) {
            const f32x4 k0 = *(const LAS f32x4*)(Kst + j * 128 + kg * 8), k1 = *(const LAS f32x4*)(Kst + j * 128 + kg * 8 + 4);
            const f32x4 q0 = *(const LAS f32x4*)(Qst + j * 128 + kg * 8), q1 = *(const LAS f32x4*)(Qst + j * 128 + kg * 8 + 4);
            const float kk[8] = {k0.x, k0.y, k0.z, k0.w, k1.x, k1.y, k1.z, k1.w}, qq[8] = {q0.x, q0.y, q0.z, q0.w, q1.x, q1.y, q1.z, q1.w};
            const float vv = Vst[j * 32 + v], eg = Gst[j], be = Gst[16 + j], kq = Gst[32 + j];
            float pkk = 0.f, pqq = 0.f;
#pragma unroll
            for (int i = 0; i < 8; ++i) { S[i] *= eg; pkk += kk[i] * S[i]; pqq += qq[i] * S[i]; }
            RED[(j & 1) * 512 + kg * 32 + v] = (f32x2){pkk, pqq};
            __syncthreads();
            float ks = 0.f, qs = 0.f;
#pragma unroll
            for (int g = 0; g < 16; ++g) { const f32x2 r = RED[(j & 1) * 512 + g * 32 + v]; ks += r.x; qs += r.y; }
            const float delta = be * (vv - ks);
#pragma unroll
            for (int i = 0; i < 8; ++i) S[i] += kk[i] * delta;
            if (kg == 0) { const int s = gdn_spos(d, g0 + j); if (s >= TCX) Ob[(size_t)gdn_row(b, s) * GDW] = (qs + delta * kq) * 0.08838834764831845f; }
        }
    }
#undef GDN_LOADG
    __syncthreads();
}
__device__ __forceinline__ void gdn_combine(const Frame& F) {
    const int gw = F.vcu * 8 + F.wave, NGW = F.G * 8, lane = F.lane;
    const f32x2 gn = *(const f32x2*)(F.in[I_GNG] + 2 * lane);
    for (int row = gw; row < ML; row += NGW) {
        const int b = row / TL, t = row - b * TL, m = (t & 63) * 128 + (t >> 6), cl = m >> 6, i = m & 63;
#pragma unroll 4
        for (int hh = 0; hh < NH; ++hh) { const int h = (hh + gw) & 15;
            const size_t it0 = ((size_t)((b * NH + h) * 128 + cl)) * 2;
            const f32x2 a = *(const f32x2*)(F_O + it0 * 8192 + i * 128 + 2 * lane), c = *(const f32x2*)(F_O + (it0 + 1) * 8192 + (63 - i) * 128 + 2 * lane); const float o0 = a.x + c.x, o1 = a.y + c.y;
            const float rs = rsqrtf(wave_sum(o0 * o0 + o1 * o1) * (1.0f / HD) + EPS);
            const unsigned zw = *(const unsigned*)(F_Z + (size_t)row * GDW + h * HD + 2 * lane);
            *(unsigned*)(F_MIX + (size_t)row * DM + LW + h * HD + 2 * lane) = pk2(o0 * rs * gn.x * siluf_(bflo(zw)), o1 * rs * gn.y * siluf_(bfhi(zw))); }
    }
}
__device__ __forceinline__ void lru_normalize(const Frame& F) {
    const int gw = F.vcu * 8 + F.wave, NGW = F.G * 8, lane = F.lane;
    for (int row = gw; row < ML; row += NGW) {
        const float p = lane < 16 ? F_SSQ[(size_t)row * 16 + lane] : 0.f;
        const float rs = rsqrtf(wave_sum(p) * (1.0f / LW) + EPS);
#pragma unroll
        for (int j = 0; j < 4; ++j) { const int c0 = (lane + 64 * j) * 8; u32x4* p4 = (u32x4*)(F_MIX + (size_t)row * DM + c0); const u32x4 w = *p4;
            const f32x4 g0 = *(const f32x4*)(F.in[I_LNG] + c0), g1 = *(const f32x4*)(F.in[I_LNG] + c0 + 4);
            u32x4 o; o.x = pk2(bflo(w.x) * rs * g0.x, bfhi(w.x) * rs * g0.y); o.y = pk2(bflo(w.y) * rs * g0.z, bfhi(w.y) * rs * g0.w);
            o.z = pk2(bflo(w.z) * rs * g1.x, bfhi(w.z) * rs * g1.y); o.w = pk2(bflo(w.w) * rs * g1.z, bfhi(w.w) * rs * g1.w); *p4 = o; }
    }
}
__device__ __forceinline__ void ph_x1(const Frame& F) {
    const int gw = F.vcu * 8 + F.wave, NGW = F.G * 8, lane = F.lane;
    const f32x4* gpm = (const f32x4*)F.in[I_GPOSTMIX]; const f32x4* gpf = (const f32x4*)F.in[I_GPREFFN];
    for (int row = gw; row < ML; row += NGW) {
        const f32x4* md = (const f32x4*)(F_mod + (size_t)(row / TL) * NADA);
        const f32x4* yr = (const f32x4*)(F_Y1 + (size_t)row * DM); const f32x4* xr = (const f32x4*)(F.in[I_X] + (size_t)row * DM); f32x4* outr = (f32x4*)(F.out + (size_t)row * DM);
        f32x4 y[16]; float ss = 0.f;
#pragma unroll
        for (int j = 0; j < 16; ++j) { y[j] = yr[lane + 64 * j]; ss += (y[j].x * y[j].x + y[j].y * y[j].y) + (y[j].z * y[j].z + y[j].w * y[j].w); }
        const float rs = rsqrtf(wave_sum(ss) * (1.0f / DM) + EPS); float s2 = 0.f;
#pragma unroll
        for (int j = 0; j < 16; ++j) { const f32x4 x1 = xr[lane + 64 * j] + md[2 * (DM / 4) + lane + 64 * j] * (y[j] * rs * gpm[lane + 64 * j]);
            outr[lane + 64 * j] = x1; y[j] = x1; s2 += (x1.x * x1.x + x1.y * x1.y) + (x1.z * x1.z + x1.w * x1.w); }
        const float r2 = rsqrtf(wave_sum(s2) * (1.0f / DM) + EPS);
        u32x2* o = (u32x2*)(F_H2 + (size_t)row * DM);
#pragma unroll
        for (int j = 0; j < 16; ++j) { const f32x4 hv = (y[j] * r2 * gpf[lane + 64 * j]) * (md[4 * (DM / 4) + lane + 64 * j] + 1.0f) + md[3 * (DM / 4) + lane + 64 * j];
            u32x2 w; w.x = pk2(hv.x, hv.y); w.y = pk2(hv.z, hv.w); o[lane + 64 * j] = w; }
    }
}
__device__ __forceinline__ void ph_final(const Frame& F) {
    const int gw = F.vcu * 8 + F.wave, NGW = F.G * 8, lane = F.lane;
    const f32x4* gpf = (const f32x4*)F.in[I_GPOSTFFN];
    for (int row = gw; row < ML; row += NGW) {
        const f32x4* md = (const f32x4*)(F_mod + (size_t)(row / TL) * NADA);
        const f32x4* yr = (const f32x4*)(F_Y2 + (size_t)row * DM); f32x4* outr = (f32x4*)(F.out + (size_t)row * DM);
        f32x4 y[16]; float ss = 0.f;
#pragma unroll
        for (int j = 0; j < 16; ++j) { y[j] = yr[lane + 64 * j]; ss += (y[j].x * y[j].x + y[j].y * y[j].y) + (y[j].z * y[j].z + y[j].w * y[j].w); }
        const float rs = rsqrtf(wave_sum(ss) * (1.0f / DM) + EPS);
#pragma unroll
        for (int j = 0; j < 16; ++j) outr[lane + 64 * j] = outr[lane + 64 * j] + md[5 * (DM / 4) + lane + 64 * j] * (y[j] * rs * gpf[lane + 64 * j]);
    }
}
__device__ __forceinline__ size_t gdn_item(int b, int h, int c, int d) { return ((size_t)((b * NH + h) * NCH + c)) * 2 + d; }
__device__ __forceinline__ void gdn_chunk_pre(const Frame& F) {
    LAS bf16* Kt_ = (LAS bf16*)(F.lds);
    LAS bf16* Qt_ = (LAS bf16*)(F.lds + 17408);
    LAS bf16* Vt_ = (LAS bf16*)(F.lds + 34816);
    LAS float* L_ = (LAS float*)(F.lds + 52224);
    LAS float* GC_ = (LAS float*)(F.lds + 84992);
    LAS float* BE_ = GC_ + 128;
    LAS float* BEG_ = GC_ + 256;
    LAS bf16* XW_ = (LAS bf16*)(F.lds + 86528);
    const int tid = F.tid, lane = F.lane, w = F.wave, fr = lane & 15, fq = lane >> 4;
    for (int it = F.vcu; it < NBATCH * NH * NCH; it += F.G) {
        const int c = it % NCH, bh = it / NCH, h = bh % NH, b = bh / NH;
        const size_t item0 = gdn_item(b, h, c, 0);
        __syncthreads();
        { const size_t gbase = ((size_t)b * SEQ_S + (size_t)c * 64) * GDW + h * HD;
#pragma unroll
          for (int r = 0; r < 2; ++r) { const int pc = tid + 512 * r, row = pc >> 4, cc = (pc & 15) * 8; const size_t g = gbase + (size_t)row * GDW + cc;
              *(LAS u32x4*)(Kt_ + row * 136 + cc) = *(const u32x4*)(F_KN + g); *(LAS u32x4*)(Qt_ + row * 136 + cc) = *(const u32x4*)(F_QN + g); *(LAS u32x4*)(Vt_ + row * 136 + cc) = *(const u32x4*)(F_VN + g); }
          if (tid < 128) { const int d = tid >> 6, p = tid & 63, i = d ? 63 - p : p;
              const f32x2 gb = F_GB[(size_t)((d * 2 + b) * NH + h) * SEQ_S + c * 64 + i];
              float gc = gb.x;
#pragma unroll
              for (int o = 1; o < 64; o <<= 1) { const float t = __shfl_up(gc, o); if (lane >= o) gc += t; }
              GC_[d * 64 + p] = gc; BE_[d * 64 + p] = gb.y; BEG_[d * 64 + p] = gb.y * __expf(gc);
              F_GSC[(item0 + d) * 128 + p] = 0.08838834764831845f * __expf(gc);
              if (p == 63) F_GSC[(item0 + d) * 128 + 64] = __expf(gc); } }
        __syncthreads();
        { const int mt = w >> 1; LAS bf16* IN_ = XW_;
          bf16x8 kA[4], qA[4];
#pragma unroll
          for (int ks = 0; ks < 4; ++ks) { kA[ks] = *(const LAS bf16x8*)(Kt_ + (16 * mt + fr) * 136 + 32 * ks + 8 * fq); qA[ks] = *(const LAS bf16x8*)(Qt_ + (16 * mt + fr) * 136 + 32 * ks + 8 * fq); }
#pragma unroll
          for (int t2 = 0; t2 < 2; ++t2) { const int nt = 2 * (w & 1) + t2;
              f32x4 aK = {0.f, 0.f, 0.f, 0.f}, aQ = aK;
#pragma unroll
              for (int ks = 0; ks < 4; ++ks) { const bf16x8 kB = *(const LAS bf16x8*)(Kt_ + (16 * nt + fr) * 136 + 32 * ks + 8 * fq);
                  aK = __builtin_amdgcn_mfma_f32_16x16x32_bf16(kA[ks], kB, aK, 0, 0, 0); aQ = __builtin_amdgcn_mfma_f32_16x16x32_bf16(qA[ks], kB, aQ, 0, 0, 0); }
              const int j = 16 * nt + fr, q1 = 63 - j; const float g0j = GC_[j], g1q = GC_[64 + q1];
#pragma unroll
              for (int rg = 0; rg < 4; ++rg) { const int i = 16 * mt + 4 * fq + rg, p1 = 63 - i;
                  const float e0 = i >= j ? __expf(GC_[i] - g0j) : 0.f, e1 = i <= j ? __expf(GC_[64 + p1] - g1q) : 0.f;
                  if (i > j) L_[i * 64 + j] = BE_[i] * aK[rg] * e0;
                  if (i < j) L_[4096 + p1 * 64 + q1] = BE_[64 + p1] * aK[rg] * e1;
                  const float y = aQ[rg] * 0.08838834764831845f;
                  IN_[i * 72 + j] = (bf16)f2bf(y * e0); IN_[64 * 72 + p1 * 72 + q1] = (bf16)f2bf(y * e1); } }
        }
        __syncthreads();
        { LAS bf16* IN_ = XW_;
#pragma unroll
          for (int r = 0; r < 2; ++r) { const int pc = tid + 512 * r, d = pc >> 9, row = (pc >> 3) & 63, cc = (pc & 7) * 8;
              *(u32x4*)(F_INTRA + (item0 + d) * 4096 + row * 64 + cc) = *(const LAS u32x4*)(IN_ + d * 64 * 72 + row * 72 + cc); } }
        { const int d = w >> 2, isw = (w >> 1) & 1, col = 64 * (w & 1) + lane;
          const LAS float* Ld = L_ + d * 4096; const LAS float* cf = (isw ? BEG_ : BE_) + d * 64; const LAS bf16* Tt = isw ? Kt_ : Vt_;
          float x[64];
#pragma unroll
          for (int p = 0; p < 64; ++p) { const int i = d ? 63 - p : p;
              float a0 = cf[p] * bf2f(Tt[i * 136 + col]), a1 = 0.f, a2 = 0.f, a3 = 0.f;
#pragma unroll
              for (int q4 = 0; q4 < p / 4; ++q4) { const f32x4 l = *(const LAS f32x4*)(Ld + p * 64 + 4 * q4); a0 -= l.x * x[4 * q4]; a1 -= l.y * x[4 * q4 + 1]; a2 -= l.z * x[4 * q4 + 2]; a3 -= l.w * x[4 * q4 + 3]; }
#pragma unroll
              for (int q = (p / 4) * 4; q < p; ++q) a0 -= Ld[p * 64 + q] * x[q];
              x[p] = (a0 + a1) + (a2 + a3); }
          __syncthreads();
          if (!isw) {
              u32x4* up = (u32x4*)(F_UT + (item0 + d) * 8192 + (size_t)col * 64); u32x4* kp = (u32x4*)(F_KT + (item0 + d) * 8192 + (size_t)col * 64);
              const float glast = GC_[d * 64 + 63];
#pragma unroll
              for (int p8 = 0; p8 < 8; ++p8) { u32x4 o; o.x = pk2(x[8 * p8], x[8 * p8 + 1]); o.y = pk2(x[8 * p8 + 2], x[8 * p8 + 3]); o.z = pk2(x[8 * p8 + 4], x[8 * p8 + 5]); o.w = pk2(x[8 * p8 + 6], x[8 * p8 + 7]); up[p8] = o;
                  float kt[8];
#pragma unroll
                  for (int e = 0; e < 8; ++e) { const int p = 8 * p8 + e, i = d ? 63 - p : p; kt[e] = bf2f(Kt_[i * 136 + col]) * __expf(glast - GC_[d * 64 + p]); }
                  u32x4 k4; k4.x = pk2(kt[0], kt[1]); k4.y = pk2(kt[2], kt[3]); k4.z = pk2(kt[4], kt[5]); k4.w = pk2(kt[6], kt[7]); kp[p8] = k4; }
          } else {
#pragma unroll
              for (int p = 0; p < 64; ++p) XW_[d * 64 * 136 + p * 136 + col] = (bf16)f2bf(x[p]);
          }
        }
        __syncthreads();
#pragma unroll
        for (int r = 0; r < 4; ++r) { const int pc = tid + 512 * r, d = pc >> 10, row = (pc >> 4) & 63, cc = (pc & 15) * 8;
            *(u32x4*)(F_W + (item0 + d) * 8192 + row * 128 + cc) = *(const LAS u32x4*)(XW_ + d * 64 * 136 + row * 136 + cc); }
#pragma unroll
        for (int r = 0; r < 2; ++r) { const int pc = tid + 512 * r, row = pc >> 4, cc = (pc & 15) * 8; *(u32x4*)(F_QC + (size_t)it * 8192 + row * 128 + cc) = *(const LAS u32x4*)(Qt_ + row * 136 + cc); }
    }
}
__device__ __forceinline__ void gdn_seq_chunked(const Frame& F, int item) {
    const int sl = item & 3, d = (item >> 2) & 1, h = (item >> 3) & 15, b = item >> 7;
    LAS bf16* St = (LAS bf16*)(F.lds);
    LAS bf16* Vt = (LAS bf16*)(F.lds + 8704);
    const int tid = F.tid, lane = F.lane, w = F.wave, fr = lane & 15, fq = lane >> 4;
    const int mt = w & 3, nt = w >> 2;
    for (int e = tid; e < 32 * 136 / 2; e += 512) ((LAS unsigned*)St)[e] = 0u;
    f32x4 S0 = {0.f, 0.f, 0.f, 0.f}, S1 = S0;
    const bf16* Qb = F_QC + (size_t)(b * NH + h) * NCH * 8192 + 8 * fq;
    float* Ob = F_O + (size_t)(b * NH + h) * 128 * 2 * 8192 + (size_t)d * 8192 + sl * 32 + 16 * nt + fr;
    struct Stg { bf16x8 wf[4], qf[4], inf[2], ktf[2]; u32x2 utv; f32x4 sqv; float gl; };
#define GDN_LOADC(G, step) do { const int c_ = d == 0 ? (step) : ((step) < 4 ? 3 - (step) : NCH - 1 - ((step) - 4)); const size_t it_ = gdn_item(b, h, c_, d); \
        const int prow_ = 16 * mt + fr, irow_ = d ? 63 - prow_ : prow_; \
        _Pragma("unroll") for (int ks = 0; ks < 4; ++ks) { G.wf[ks] = *(const bf16x8*)(F_W + it_ * 8192 + prow_ * 128 + 32 * ks + 8 * fq); G.qf[ks] = *(const bf16x8*)(Qb + (size_t)c_ * 8192 + irow_ * 128 + 32 * ks); } \
        _Pragma("unroll") for (int ks = 0; ks < 2; ++ks) { G.inf[ks] = *(const bf16x8*)(F_INTRA + it_ * 4096 + prow_ * 64 + 32 * ks + 8 * fq); G.ktf[ks] = *(const bf16x8*)(F_KT + it_ * 8192 + (16 * w + fr) * 64 + 32 * ks + 8 * fq); } \
        G.utv = *(const u32x2*)(F_UT + it_ * 8192 + (size_t)(32 * sl + 16 * nt + fr) * 64 + 16 * mt + 4 * fq); G.sqv = *(const f32x4*)(F_GSC + it_ * 128 + 16 * mt + 4 * fq); G.gl = F_GSC[it_ * 128 + 64]; } while (0)
#define GDN_STEP(G, step) do { const int c = d == 0 ? (step) : ((step) < 4 ? 3 - (step) : NCH - 1 - ((step) - 4)); \
        f32x4 aW = {0.f, 0.f, 0.f, 0.f}, aQ = aW; \
        _Pragma("unroll") for (int ks = 0; ks < 4; ++ks) { const bf16x8 bS = *(const LAS bf16x8*)(St + (16 * nt + fr) * 136 + 32 * ks + 8 * fq); \
            aW = __builtin_amdgcn_mfma_f32_16x16x32_bf16(G.wf[ks], bS, aW, 0, 0, 0); aQ = __builtin_amdgcn_mfma_f32_16x16x32_bf16(G.qf[ks], bS, aQ, 0, 0, 0); } \
        { const float v0 = bflo(G.utv.x) - aW[0], v1 = bfhi(G.utv.x) - aW[1], v2 = bflo(G.utv.y) - aW[2], v3 = bfhi(G.utv.y) - aW[3]; \
          u32x2 vn; vn.x = pk2(v0, v1); vn.y = pk2(v2, v3); *(LAS u32x2*)(Vt + (16 * nt + fr) * 72 + 16 * mt + 4 * fq) = vn; } \
        f32x4 o = aQ * G.sqv; \
        __syncthreads(); \
        { const bf16x8 b0 = *(const LAS bf16x8*)(Vt + (16 * nt + fr) * 72 + 8 * fq), b1 = *(const LAS bf16x8*)(Vt + (16 * nt + fr) * 72 + 32 + 8 * fq); \
          o = __builtin_amdgcn_mfma_f32_16x16x32_bf16(G.inf[0], b0, o, 0, 0, 0); o = __builtin_amdgcn_mfma_f32_16x16x32_bf16(G.inf[1], b1, o, 0, 0, 0); } \
        { const bf16x8 b00 = *(const LAS bf16x8*)(Vt + fr * 72 + 8 * fq), b01 = *(const LAS bf16x8*)(Vt + fr * 72 + 32 + 8 * fq); \
          const bf16x8 b10 = *(const LAS bf16x8*)(Vt + (16 + fr) * 72 + 8 * fq), b11 = *(const LAS bf16x8*)(Vt + (16 + fr) * 72 + 32 + 8 * fq); \
          S0 = S0 * G.gl; S1 = S1 * G.gl; \
          S0 = __builtin_amdgcn_mfma_f32_16x16x32_bf16(G.ktf[0], b00, S0, 0, 0, 0); S0 = __builtin_amdgcn_mfma_f32_16x16x32_bf16(G.ktf[1], b01, S0, 0, 0, 0); \
          S1 = __builtin_amdgcn_mfma_f32_16x16x32_bf16(G.ktf[0], b10, S1, 0, 0, 0); S1 = __builtin_amdgcn_mfma_f32_16x16x32_bf16(G.ktf[1], b11, S1, 0, 0, 0); \
          u32x2 s0; s0.x = pk2(S0[0], S0[1]); s0.y = pk2(S0[2], S0[3]); *(LAS u32x2*)(St + fr * 136 + 16 * w + 4 * fq) = s0; \
          u32x2 s1; s1.x = pk2(S1[0], S1[1]); s1.y = pk2(S1[2], S1[3]); *(LAS u32x2*)(St + (16 + fr) * 136 + 16 * w + 4 * fq) = s1; } \
        if (c >= 4) { _Pragma("unroll") for (int rg = 0; rg < 4; ++rg) Ob[(size_t)(c - 4) * 16384 + (16 * mt + 4 * fq + rg) * 128] = o[rg]; } \
        __syncthreads(); } while (0)
    Stg A, B, C;
    GDN_LOADC(A, 0); GDN_LOADC(B, 1);
    __syncthreads();
    static_assert(NCH % 3 == 0, "three-stage register pipeline");
    for (int step = 0; step < NCH; step += 3) {
        GDN_LOADC(C, step + 2); GDN_STEP(A, step);
        if (step + 3 < NCH) GDN_LOADC(A, step + 3); GDN_STEP(B, step + 1);
        if (step + 4 < NCH) GDN_LOADC(B, step + 4); GDN_STEP(C, step + 2);
    }
#undef GDN_STEP
#undef GDN_LOADC
}
#ifndef MK_N_LAUNCHES
#define MK_N_LAUNCHES 1
#endif
constexpr int N_PHASES = 14;
__global__ void __launch_bounds__(512, 2) fwd(Args args) {
    extern __shared__ __attribute__((aligned(16))) unsigned char lds[];
    Frame F;
    F.lds = (LAS unsigned char*)lds;
    F.tid = threadIdx.x; F.lane = F.tid & 63; F.wave = __builtin_amdgcn_readfirstlane(F.tid >> 6);
    F.G = gridDim.x; { const int bx = blockIdx.x; F.vcu = (F.G % 8 == 0) ? (bx % 8) * (F.G / 8) + bx / 8 : bx; }
    F.in = args.in; F.out = args.out; F.ws = args.ws;
    unsigned char* ws = args.ws;
    volatile LAS unsigned* MISC = (volatile LAS unsigned*)(F.lds + MISC_OFF);
    if (F.tid < 64) MISC[F.tid] = 0u;
    __syncthreads();
    const int lo = args.ph_lo, hi = args.ph_hi;
    XcdBarrier bar; bar.bar = (unsigned*)(ws + WS_CTL) + CW_BAR; bar.x = 0; bar.st = nullptr;
    if (hi - lo > 1) bar = xcd_barrier_post((unsigned*)(ws + WS_CTL) + CW_BAR, MISC + 8);
#ifndef PH_MASK
#define PH_MASK 0x3fff
#endif
#define IN(k) (((PH_MASK >> (k)) & 1) && lo <= (k) && (k) < hi)
#define SEAM(k) do { if (IN(k) && IN((k) + 1)) xcd_barrier(bar); } while (0)
    if (IN(0)) { ph0_prologue(F); } SEAM(0);
    if (IN(1)) { ph1_modreduce(F); } SEAM(1);
    if (IN(2)) { ph2_hrows(F); } SEAM(2);
    if (IN(3)) { pg8::Gemm g{F_H, F_Wt_in, MT, NINP, DM}; pg8::StaticOrder S; S.init(MT, NINP, F.G, (int)blockIdx.x);
        pg8::EpiProj E{F_LX, F_LG, F_QKV, F_Z, F_BA};
        pg8::gemm_phase<pg8::EpiProj, pg8::StaticOrder, true, true>(F.lds, g, S, E); } SEAM(3);
    if (IN(4)) { lru_pass<1>(F); gdn_pre(F); } SEAM(4);
    if (IN(5)) { lru_chains(F); gdn_chunk_pre(F); } SEAM(5);
    if (IN(6)) { for (int item = F.vcu; item < 256; item += F.G) gdn_seq_chunked(F, item); } SEAM(6);
    if (IN(7)) { lru_pass<2>(F); gdn_combine(F); } SEAM(7);
    if (IN(8)) { lru_normalize(F); } SEAM(8);
    if (IN(9)) { pg8::Gemm g{F_MIX, F_Wt_out, ML, DM, DM}; pg8::StaticOrder S; S.init(ML, DM, F.G, (int)blockIdx.x);
        pg8::EpiF32 E{F_Y1, DM};
        pg8::gemm_phase<pg8::EpiF32, pg8::StaticOrder, true, true>(F.lds, g, S, E); } SEAM(9);
    if (IN(10)) { ph_x1(F); } SEAM(10);
    if (IN(11)) { pg8::Gemm g{F_H2, F_Wt_gu, ML, 2 * DFF, DM}; pg8::StaticOrder S; S.init(ML, 2 * DFF, F.G, (int)blockIdx.x);
        pg8::EpiSwiGLU E{F_ACT, DFF};
        pg8::gemm_phase<pg8::EpiSwiGLU, pg8::StaticOrder, true, true>(F.lds, g, S, E); } SEAM(11);
    if (IN(12)) { pg8::Gemm g{F_ACT, F_Wt_dn, ML, DM, DFF}; pg8::StaticOrder S; S.init(ML, DM, F.G, (int)blockIdx.x);
        pg8::EpiF32 E{F_Y2, DM};
        pg8::gemm_phase<pg8::EpiF32, pg8::StaticOrder, true, true>(F.lds, g, S, E); } SEAM(12);
    if (IN(13)) { ph_final(F); }
#undef IN
#undef SEAM
}

extern "C" void kernel_launch(void* const* d_in, const int* in_sizes, int n_in, void* d_out, int out_size, void* d_ws, size_t ws_size, hipStream_t stream) {
    static int grid = 0;
    if (grid == 0) {
        if (n_in != N_INPUTS || in_sizes[0] != ML * DM || out_size != ML * DM || ws_size < WS_END) { fprintf(stderr, "kernel_launch: unexpected problem shape (n_in %d, in0 %d, out %d, ws %zu): nothing launched\n", n_in, n_in > 0 ? in_sizes[0] : -1, out_size, ws_size); grid = -1; return; }
        int dev = 0, cus = 0;
        if (hipGetDevice(&dev) != hipSuccess || hipDeviceGetAttribute(&cus, hipDeviceAttributeMultiprocessorCount, dev) != hipSuccess) { grid = -1; return; }
        if (hipFuncSetAttribute((const void*)fwd, hipFuncAttributeMaxDynamicSharedMemorySize, LDS_BYTES) != hipSuccess) { fprintf(stderr, "kernel_launch: hipFuncSetAttribute failed\n"); grid = -1; return; }
        (void)hipGetLastError();
        grid = cus >= 256 ? 256 : (cus / 16) * 16;
        if (grid < 16) { grid = -1; return; }
    }
    if (grid < 0) return;
    (void)hipMemsetAsync((char*)d_ws + WS_CTL, 0, CTL_ZERO_BYTES, stream);
    Args a{};
    for (int i = 0; i < N_INPUTS; ++i) a.in[i] = (const float*)d_in[i];
    a.out = (float*)d_out; a.ws = (unsigned char*)d_ws;
#if MK_N_LAUNCHES == 1
    a.ph_lo = 0; a.ph_hi = N_PHASES;
    hipLaunchKernelGGL(fwd, dim3(grid), dim3(512), LDS_BYTES, stream, a);
#else
#ifndef PROBE_REPEAT_MASK
#define PROBE_REPEAT_MASK 0
#endif
    for (int p = 0; p < N_PHASES; ++p) { a.ph_lo = p; a.ph_hi = p + 1; hipLaunchKernelGGL(fwd, dim3(grid), dim3(512), LDS_BYTES, stream, a);
        if ((PROBE_REPEAT_MASK >> p) & 1) hipLaunchKernelGGL(fwd, dim3(grid), dim3(512), LDS_BYTES, stream, a); }
#endif
}
```

```cpp
#include <hip/hip_runtime.h>
#include <cstdio>
#include <cstdint>
namespace pg8 {
#define PG8_LAS __attribute__((address_space(3)))
typedef unsigned short bf16_t;
typedef short bf16x8 __attribute__((ext_vector_type(8)));
typedef float f32x4 __attribute__((ext_vector_type(4)));
typedef unsigned u32x4 __attribute__((ext_vector_type(4)));
constexpr int BM = 256, BK = 64, HALF = 128, HTB = HALF * BK * 2  , STAGE_BYTES = 8 * HTB, NXCD = 8, WGM = 8;

__host__ __device__ __forceinline__ int lds_byte(int r, int c) { const int st = (r >> 4) * 2 + (c >> 5), rr = r & 15, cc = c & 31, ob = rr * 64 + cc * 2; return st * 1024 + (ob ^ (((ob >> 9) & 1) << 5)); }
__host__ __device__ __forceinline__ void stage_rc(int b, int& R, int& C) { const int st = b / 1024, sb = b % 1024, swz = sb ^ (((sb >> 9) & 1) << 5); R = (st >> 1) * 16 + swz / 64; C = (st & 1) * 32 + (swz % 64) / 2; }
__host__ __device__ __forceinline__ int perm32(int rho) { const int n = rho >> 4, i = rho & 15; return 8 * (i >> 2) + 4 * n + (i & 3); }

struct Unit { int pm, pn; };
struct Gemm { const bf16_t* A; const bf16_t* Bt; int M, N, K; };

struct StaticOrder {
    int nM, nN, nwg, G, c, wgm;
    __host__ __device__ void init(int M, int N, int G_, int c_, int wgm_ = WGM) { nM = M / BM; nN = N / BM; nwg = nM * nN; G = G_; c = c_; wgm = wgm_; }
    __host__ __device__ bool next(int i, Unit& u) const {
        const long L = (long)i * G + c; if (L >= nwg) return false;
        int wgid = (int)L; { const int q = nwg / NXCD, r = nwg % NXCD, xcd = wgid % NXCD, off = wgid / NXCD; wgid = (xcd < r ? xcd * (q + 1) : r * (q + 1) + (xcd - r) * q) + off; }
        const int nig = wgm * nN, gid = wgid / nig, fm = gid * wgm, gsz = (nM - fm) < wgm ? (nM - fm) : wgm;
        u.pm = fm + ((wgid % nig) % gsz); u.pn = (wgid % nig) / gsz; return true;
    }
    __device__ __forceinline__ void a_ready(const Unit&) const {}
    __device__ __forceinline__ void done(const Unit&) const {}
};
typedef __bf16 bf16x2_t __attribute__((ext_vector_type(2))); typedef float f32x2_t __attribute__((ext_vector_type(2)));
__device__ __forceinline__ unsigned cvt_pk_bf16(float lo, float hi) { const f32x2_t v = {lo, hi}; return __builtin_bit_cast(unsigned, __builtin_convertvector(v, bf16x2_t)); }
struct EpiF32 {
    static constexpr bool PERM = false, AFTER_DRAIN = false;
    float* C; int ldc;
    __device__ __forceinline__ void operator()(const f32x4 (&acc)[2][2][4][2], const Unit& u, int wr, int wc, int fr, int fq) const {
        const int row0 = u.pm * BM + wr * 64 + fr, col0 = u.pn * BM + wc * 32 + 4 * fq;
#pragma unroll
        for (int ai = 0; ai < 2; ++ai)
#pragma unroll
            for (int m = 0; m < 4; ++m) { float* rowp = C + (size_t)(row0 + ai * HALF + m * 16) * ldc + col0;
#pragma unroll
                for (int bj = 0; bj < 2; ++bj)
#pragma unroll
                    for (int n = 0; n < 2; ++n) *(f32x4*)(rowp + bj * HALF + n * 16) = acc[ai][bj][m][n]; }
    }
};
struct EpiProj {
    static constexpr bool PERM = true, AFTER_DRAIN = false;
    bf16_t *lx, *lg, *qkv, *z, *ba;
    __device__ __forceinline__ void operator()(const f32x4 (&acc)[2][2][4][2], const Unit& u, int wr, int wc, int fr, int fq) const {
        const int pn = u.pn; bf16_t* base; int ld, colt;
        if (pn < 8) { base = lx; ld = 2048; colt = pn * BM; }
        else if (pn < 16) { base = lg; ld = 2048; colt = (pn - 8) * BM; }
        else if (pn < 40) { base = qkv; ld = 6144; colt = (pn - 16) * BM; }
        else if (pn < 48) { base = z; ld = 2048; colt = (pn - 40) * BM; }
        else { base = ba; ld = 256; colt = 0; }
        const int row0 = u.pm * BM + wr * 64 + fr, col0 = colt + wc * 32 + 8 * fq;
#pragma unroll
        for (int ai = 0; ai < 2; ++ai)
#pragma unroll
            for (int m = 0; m < 4; ++m) { bf16_t* rowp = base + (size_t)(row0 + ai * HALF + m * 16) * ld + col0;
#pragma unroll
                for (int bj = 0; bj < 2; ++bj) { const f32x4 v0 = acc[ai][bj][m][0], v1 = acc[ai][bj][m][1];
                    u32x4 w; w.x = cvt_pk_bf16(v0[0], v0[1]); w.y = cvt_pk_bf16(v0[2], v0[3]); w.z = cvt_pk_bf16(v1[0], v1[1]); w.w = cvt_pk_bf16(v1[2], v1[3]);
                    *(u32x4*)(rowp + bj * HALF) = w; } }
    }
};
struct EpiBf16 {
    static constexpr bool PERM = true, AFTER_DRAIN = false;
    bf16_t* O; int ldc;
    __device__ __forceinline__ void operator()(const f32x4 (&acc)[2][2][4][2], const Unit& u, int wr, int wc, int fr, int fq) const {
        const int row0 = u.pm * BM + wr * 64 + fr, col0 = u.pn * BM + wc * 32 + 8 * fq;
#pragma unroll
        for (int ai = 0; ai < 2; ++ai)
#pragma unroll
            for (int m = 0; m < 4; ++m) { bf16_t* rowp = O + (size_t)(row0 + ai * HALF + m * 16) * ldc + col0;
#pragma unroll
                for (int bj = 0; bj < 2; ++bj) { const f32x4 v0 = acc[ai][bj][m][0], v1 = acc[ai][bj][m][1];
                    u32x4 w; w.x = cvt_pk_bf16(v0[0], v0[1]); w.y = cvt_pk_bf16(v0[2], v0[3]); w.z = cvt_pk_bf16(v1[0], v1[1]); w.w = cvt_pk_bf16(v1[2], v1[3]);
                    *(u32x4*)(rowp + bj * HALF) = w; } }
    }
};
struct EpiSwiGLU {
    static constexpr bool PERM = true, AFTER_DRAIN = false;
    bf16_t* O; int ldc;
    __device__ __forceinline__ void operator()(const f32x4 (&acc)[2][2][4][2], const Unit& u, int wr, int wc, int fr, int fq) const {
        const int row0 = u.pm * BM + wr * 64 + fr, col0 = u.pn * HALF + wc * 32 + 8 * fq;
#pragma unroll
        for (int ai = 0; ai < 2; ++ai)
#pragma unroll
            for (int m = 0; m < 4; ++m) { const int rr = wr * 64 + fr + ai * HALF + m * 16;
                bf16_t* rowp = O + ((size_t)u.pm * (ldc / 64) + (col0 >> 6)) * (size_t)(BM * 64) + rr * 64 + (col0 & 63);
                float r[8];
#pragma unroll
                for (int n = 0; n < 2; ++n)
#pragma unroll
                    for (int j = 0; j < 4; ++j) { const float g = acc[ai][0][m][n][j], up = acc[ai][1][m][n][j]; r[4 * n + j] = g * __builtin_amdgcn_rcpf(1.0f + __expf(-g)) * up; }
                u32x4 w; w.x = cvt_pk_bf16(r[0], r[1]); w.y = cvt_pk_bf16(r[2], r[3]); w.z = cvt_pk_bf16(r[4], r[5]); w.w = cvt_pk_bf16(r[6], r[7]);
                *(u32x4*)rowp = w; }
    }
};

template <class Epi, class Sched, bool ALIGN_EPI = false, bool SP2 = false, bool TILED = false, bool MIDSCALE = false>
__device__ __forceinline__ void gemm_phase(PG8_LAS unsigned char* lds, const Gemm g, const Sched& S, const Epi& E, const float* midscale = nullptr) {
    const int tid = threadIdx.x, wid = __builtin_amdgcn_readfirstlane(tid >> 6), lane = tid & 63, wr = wid >> 2, wc = wid & 3, fr = lane & 15, fq = lane >> 4;
    const int K = g.K, nt = K / BK;
    unsigned voffA[2], voffB[2];
#pragma unroll
    for (int i = 0; i < 2; ++i) { int R, C; stage_rc(tid * 16 + i * 8192, R, C); const int Rb = Epi::PERM ? ((R & ~31) + perm32(R & 31)) : R;
        voffA[i] = (unsigned)(R * (TILED ? BK : K) + C) * 2u; voffB[i] = (unsigned)(Rb * (TILED ? BK : K) + C) * 2u; }
    const size_t kstep = TILED ? (size_t)(BM * BK * 2) : (size_t)(BK * 2);
    const size_t hstep = TILED ? (size_t)(HALF * BK * 2) : (size_t)HALF * K * 2;
    const size_t tstep = (size_t)BM * K * 2;
    const unsigned ldsw = (unsigned)wid * 1024u;
    const int aoff = lds_byte(wr * 64 + fr, fq * 8), boff = lds_byte(wc * 32 + fr, fq * 8);
#define PG8_SA(b, h) (((b) * 2 + (h)) * HTB)
#define PG8_SB(b, h) ((4 + (b) * 2 + (h)) * HTB)
#define PG8_STAGE(bufoff, gbase, voff) do { _Pragma("unroll") for (int _i = 0; _i < 2; ++_i) \
        __builtin_amdgcn_global_load_lds((const unsigned*)((const char*)(gbase) + (voff)[_i]), (PG8_LAS unsigned*)(lds + (bufoff) + ldsw + _i * 8192), 16, 0, 0); } while (0)
#define PG8_LDA(dst, b, h) do { _Pragma("unroll") for (int m = 0; m < 4; ++m) _Pragma("unroll") for (int k = 0; k < 2; ++k) dst[m][k] = *(const PG8_LAS bf16x8*)(lds + PG8_SA(b, h) + aoff + m * 2048 + k * 1024); } while (0)
#define PG8_LDB(dst, b, h) do { _Pragma("unroll") for (int n = 0; n < 2; ++n) _Pragma("unroll") for (int k = 0; k < 2; ++k) dst[n][k] = *(const PG8_LAS bf16x8*)(lds + PG8_SB(b, h) + boff + n * 2048 + k * 1024); } while (0)
#define PG8_MMA(ai, bj, At, Bt) do { __builtin_amdgcn_s_setprio(1); _Pragma("unroll") for (int m = 0; m < 4; ++m) _Pragma("unroll") for (int n = 0; n < 2; ++n) _Pragma("unroll") for (int k = 0; k < 2; ++k) \
        acc[ai][bj][m][n] = __builtin_amdgcn_mfma_f32_16x16x32_bf16(Bt[n][k], At[m][k], acc[ai][bj][m][n], 0, 0, 0); __builtin_amdgcn_s_setprio(0); } while (0)
#define PG8_WAIT_V(n) asm volatile("s_waitcnt vmcnt(" #n ")" ::: "memory")
#define PG8_WAIT_L(n) asm volatile("s_waitcnt lgkmcnt(" #n ")" ::: "memory")
#define PG8_BAR __builtin_amdgcn_s_barrier()
#define PG8_SCHED __builtin_amdgcn_sched_barrier(0)
    Unit cur, nxt; int ui = 0;
    if (!S.next(0, cur)) return;
    f32x4 acc[2][2][4][2];
#pragma unroll
    for (int a = 0; a < 2; ++a)
#pragma unroll
        for (int b = 0; b < 2; ++b)
#pragma unroll
            for (int m = 0; m < 4; ++m)
#pragma unroll
                for (int n = 0; n < 2; ++n) acc[a][b][m][n] = (f32x4){0.f, 0.f, 0.f, 0.f};
    bf16x8 At[4][2], B0[2][2], B1[2][2];
    const char* cA = (const char*)g.A + (size_t)cur.pm * tstep; const char* cB = (const char*)g.Bt + (size_t)cur.pn * tstep;
    S.a_ready(cur);
    if constexpr (SP2) {
        PG8_STAGE(PG8_SB(0, 0), cB, voffB); PG8_STAGE(PG8_SB(0, 1), cB + hstep, voffB); PG8_STAGE(PG8_SA(0, 0), cA, voffA); PG8_STAGE(PG8_SA(0, 1), cA + hstep, voffA);
        if (wr == 1) PG8_BAR;
        PG8_WAIT_V(2); PG8_BAR;
        PG8_STAGE(PG8_SB(1, 0), cB + kstep, voffB); PG8_STAGE(PG8_SA(1, 0), cA + kstep, voffA); PG8_STAGE(PG8_SB(1, 1), cB + hstep + kstep, voffB);
        PG8_WAIT_V(6); PG8_BAR;
    } else {
        PG8_STAGE(PG8_SB(0, 0), cB, voffB); PG8_STAGE(PG8_SA(0, 0), cA, voffA); PG8_STAGE(PG8_SB(0, 1), cB + hstep, voffB); PG8_STAGE(PG8_SA(0, 1), cA + hstep, voffA);
        if (wr == 1) PG8_BAR;
        PG8_WAIT_V(4); PG8_BAR;
        PG8_STAGE(PG8_SB(1, 0), cB + kstep, voffB); PG8_STAGE(PG8_SA(1, 0), cA + kstep, voffA); PG8_STAGE(PG8_SB(1, 1), cB + hstep + kstep, voffB);
        PG8_WAIT_V(6); PG8_BAR;
    }
    for (;;) {
        const bool has_next = S.next(ui + 1, nxt);
        const char* nA = has_next ? (const char*)g.A + (size_t)nxt.pm * tstep : cA; const char* nB = has_next ? (const char*)g.Bt + (size_t)nxt.pn * tstep : cB;
        for (int t = 0; t < nt; t += 2) {
            if constexpr (MIDSCALE) { if (t == nt / 2) {
#pragma unroll
                for (int a = 0; a < 2; ++a)
#pragma unroll
                    for (int m = 0; m < 4; ++m) { const float sc = midscale[cur.pm * BM + a * HALF + wr * 64 + m * 16 + fr];
#pragma unroll
                        for (int bb = 0; bb < 2; ++bb)
#pragma unroll
                            for (int n = 0; n < 2; ++n) acc[a][bb][m][n] = acc[a][bb][m][n] * sc; } } }
            const bool last = (t == nt - 2);
            const char* a1 = cA + (size_t)(t + 1) * kstep;
            const char* a2 = last ? nA : cA + (size_t)(t + 2) * kstep; const char* b2 = last ? nB : cB + (size_t)(t + 2) * kstep;
            const char* a3 = a2 + kstep; const char* b3 = b2 + kstep;
            if (last && has_next) S.a_ready(nxt);
            if constexpr (SP2) {
            PG8_LDB(B0, 0, 0); PG8_LDB(B1, 0, 1); PG8_SCHED; PG8_LDA(At, 0, 0); PG8_STAGE(PG8_SA(1, 1), a1 + hstep, voffA);
            PG8_WAIT_V(8); PG8_WAIT_L(0); PG8_BAR; PG8_MMA(0, 0, At, B0); PG8_MMA(0, 1, At, B1); PG8_BAR; PG8_SCHED;
            PG8_LDA(At, 0, 1); PG8_STAGE(PG8_SB(0, 0), b2, voffB); PG8_STAGE(PG8_SB(0, 1), b2 + hstep, voffB); PG8_STAGE(PG8_SA(0, 0), a2, voffA);
            PG8_WAIT_V(8); PG8_WAIT_L(0); PG8_BAR; PG8_MMA(1, 0, At, B0); PG8_MMA(1, 1, At, B1); PG8_BAR; PG8_SCHED;
            PG8_LDB(B0, 1, 0); PG8_LDB(B1, 1, 1); PG8_SCHED; PG8_LDA(At, 1, 0); PG8_STAGE(PG8_SA(0, 1), a2 + hstep, voffA);
            PG8_WAIT_V(8); PG8_WAIT_L(0); PG8_BAR; PG8_MMA(0, 0, At, B0); PG8_MMA(0, 1, At, B1); PG8_BAR; PG8_SCHED;
            PG8_LDA(At, 1, 1); PG8_STAGE(PG8_SB(1, 0), b3, voffB); PG8_STAGE(PG8_SB(1, 1), b3 + hstep, voffB); PG8_STAGE(PG8_SA(1, 0), a3, voffA);
            PG8_WAIT_V(8); PG8_WAIT_L(0); PG8_BAR; PG8_MMA(1, 0, At, B0); PG8_MMA(1, 1, At, B1); PG8_BAR; PG8_SCHED;
            } else {
            PG8_LDB(B0, 0, 0); PG8_SCHED; PG8_LDA(At, 0, 0); PG8_STAGE(PG8_SA(1, 1), a1 + hstep, voffA);
            PG8_WAIT_L(8); PG8_BAR; PG8_WAIT_L(0); PG8_MMA(0, 0, At, B0); PG8_BAR; PG8_SCHED;
            PG8_LDB(B1, 0, 1); PG8_STAGE(PG8_SB(0, 0), b2, voffB);
            PG8_BAR; PG8_WAIT_L(0); PG8_MMA(0, 1, At, B1); PG8_BAR;
            PG8_LDA(At, 0, 1); PG8_STAGE(PG8_SA(0, 0), a2, voffA);
            PG8_BAR; PG8_WAIT_L(0); PG8_MMA(1, 0, At, B0); PG8_BAR; PG8_SCHED;
            PG8_STAGE(PG8_SB(0, 1), b2 + hstep, voffB);
            PG8_WAIT_V(6); PG8_BAR; PG8_MMA(1, 1, At, B1); PG8_BAR;
            PG8_LDB(B0, 1, 0); PG8_SCHED; PG8_LDA(At, 1, 0); PG8_STAGE(PG8_SA(0, 1), a2 + hstep, voffA);
            PG8_WAIT_L(8); PG8_BAR; PG8_WAIT_L(0); PG8_MMA(0, 0, At, B0); PG8_BAR; PG8_SCHED;
            PG8_LDB(B1, 1, 1); PG8_STAGE(PG8_SB(1, 0), b3, voffB);
            PG8_BAR; PG8_WAIT_L(0); PG8_MMA(0, 1, At, B1); PG8_BAR;
            PG8_LDA(At, 1, 1); PG8_STAGE(PG8_SA(1, 0), a3, voffA);
            PG8_BAR; PG8_WAIT_L(0); PG8_MMA(1, 0, At, B0); PG8_BAR; PG8_SCHED;
            PG8_STAGE(PG8_SB(1, 1), b3 + hstep, voffB);
            PG8_WAIT_V(6); PG8_BAR; PG8_MMA(1, 1, At, B1); PG8_BAR;
            }
        }
        if constexpr (ALIGN_EPI) { if (wr == 0) PG8_BAR; }
        if constexpr (!Epi::AFTER_DRAIN) { E(acc, cur, wr, wc, fr, fq); S.done(cur); }
        if (!has_next) break;
#pragma unroll
        for (int a = 0; a < 2; ++a)
#pragma unroll
            for (int b = 0; b < 2; ++b)
#pragma unroll
                for (int m = 0; m < 4; ++m)
#pragma unroll
                    for (int n = 0; n < 2; ++n) acc[a][b][m][n] = (f32x4){0.f, 0.f, 0.f, 0.f};
        cur = nxt; cA = nA; cB = nB; ++ui;
        if constexpr (ALIGN_EPI) { if (wr == 1) PG8_BAR; }
    }
    PG8_WAIT_V(0);
    if constexpr (!ALIGN_EPI) { if (wr == 0) PG8_BAR; }
    PG8_BAR;
    if constexpr (Epi::AFTER_DRAIN) { E.fused(acc, cur, wr, wc, fr, fq, lds, wid, lane); S.done(cur); }
#undef PG8_SA
#undef PG8_SB
#undef PG8_STAGE
#undef PG8_LDA
#undef PG8_LDB
#undef PG8_MMA
#undef PG8_WAIT_V
#undef PG8_WAIT_L
#undef PG8_BAR
#undef PG8_SCHED
}
}
constexpr int DM = 4096, NBATCH = 2, TL = 8192, TCX = 256, ML = NBATCH * TL, MC = NBATCH * TCX, MT = ML + MC;
constexpr int LW = 2048, GDW = 2048, NH = 16, HD = 128, DFF = 11008, NIN = 12352, NINP = 12544, NADA = 6 * DM;
constexpr int SEQ_S = TCX + TL;
constexpr int NCH = 132;
constexpr float EPS = 1e-6f;
enum { I_X = 0, I_C, I_CTX, I_CCTX, I_WADA, I_BADA, I_GPREMIX, I_GPOSTMIX, I_GPREFFN, I_GPOSTFFN, I_WIN, I_LCW, I_LCB, I_LWA, I_LBA, I_LWX, I_LBX, I_LLAM, I_LNG, I_GCW, I_GALOG, I_GDT, I_GNG, I_WOUT, I_WG, I_WU, I_WD, N_INPUTS };

constexpr size_t MiB = 1u << 20;
constexpr size_t WS_CTL = 0, CTL_ZERO_BYTES = 1 * MiB;
constexpr size_t WS_MODP = 1 * MiB, WS_MOD = 11 * MiB, WS_WL = 12 * MiB, WS_CAR = 14 * MiB, WS_HIN = 23 * MiB, WS_GB = 28 * MiB, WS_KQ = 33 * MiB, WS_SSQ = 35 * MiB;
constexpr size_t WS_WOUT = 44 * MiB, WS_WGU = 76 * MiB, WS_WDN = 248 * MiB;
constexpr size_t WS_R2 = 334 * MiB;
constexpr size_t WS_WIN = WS_R2, WS_H = WS_R2 + 98 * MiB;
constexpr size_t WS_QN = WS_R2, WS_KN = WS_R2 + 66 * MiB, WS_VN = WS_R2 + 132 * MiB;
constexpr size_t WS_H2 = WS_R2, WS_Y2 = WS_R2;
constexpr size_t WS_R3 = 590 * MiB;
constexpr size_t WS_LX = WS_R3, WS_LG = WS_R3 + 66 * MiB, WS_QKV = WS_R3 + 132 * MiB, WS_Z = WS_R3 + 330 * MiB, WS_BA = WS_R3 + 396 * MiB;
constexpr size_t WS_ACT = WS_R3;
constexpr size_t WS_MIX = 995 * MiB;
constexpr size_t WS_UT = 1123 * MiB, WS_W = 1255 * MiB, WS_INTRA = 1387 * MiB, WS_QC = 1453 * MiB, WS_END = 1519 * MiB;
constexpr size_t WS_KT = WS_R2, WS_GSC = 37 * MiB, WS_RSL = 42 * MiB;

constexpr size_t WS_Y1 = WS_UT, WS_Y2Y = WS_W;
static_assert(WS_SSQ + (size_t)ML * 16 * 4 <= WS_WOUT && WS_WOUT + (size_t)DM * DM * 2 <= WS_WGU && WS_WGU + (size_t)2 * DFF * DM * 2 <= WS_WDN && WS_WDN + (size_t)DM * DFF * 2 <= WS_R2, "ws map 1");
static_assert(WS_WIN + (size_t)NINP * DM * 2 <= WS_H && WS_H + (size_t)MT * DM * 2 <= WS_R3 && WS_VN + (size_t)NBATCH * SEQ_S * 2048 * 2 <= WS_R3 && WS_Y2 + (size_t)ML * DM * 4 <= WS_R3, "ws map 2");
static_assert((size_t)MT * 2048 * 2 <= 66 * MiB && (size_t)MT * 6144 * 2 <= 198 * MiB && WS_BA + (size_t)MT * 256 * 2 <= WS_MIX && WS_ACT + (size_t)ML * DFF * 2 <= WS_MIX && WS_MIX + (size_t)ML * DM * 2 <= WS_UT, "ws map 3");
static_assert((size_t)ML * DM * 2 <= 132 * MiB && (size_t)NBATCH * NH * NCH * 2 * 8192 * 2 == 132 * MiB && WS_KT + 132 * MiB <= WS_R3 && WS_GSC + (size_t)NBATCH * NH * NCH * 2 * 128 * 4 <= WS_WOUT && WS_SSQ + (size_t)ML * 16 * 4 <= WS_GSC, "ws map 4");
constexpr int CW_BAR = 4096;

constexpr int LDS_BYTES = 147456;
constexpr int MISC_OFF = LDS_BYTES - 256;

#define GAS __attribute__((address_space(1)))
#define LAS __attribute__((address_space(3)))
typedef unsigned short bf16;
typedef unsigned u32x4 __attribute__((ext_vector_type(4)));
typedef unsigned u32x2 __attribute__((ext_vector_type(2)));
typedef float f32x4 __attribute__((ext_vector_type(4)));
typedef float f32x2 __attribute__((ext_vector_type(2)));
typedef short bf16x8 __attribute__((ext_vector_type(8)));
#define LDS_WAIT() asm volatile("s_waitcnt lgkmcnt(0)" ::: "memory")
#define WAVE_LDS_FENCE() do { asm volatile("s_waitcnt lgkmcnt(0)" ::: "memory"); __builtin_amdgcn_wave_barrier(); } while (0)
typedef __bf16 bf16x2_t __attribute__((ext_vector_type(2)));
__device__ __forceinline__ unsigned pk2(float lo, float hi) { const f32x2 v = {lo, hi}; return __builtin_bit_cast(unsigned, __builtin_convertvector(v, bf16x2_t)); }
__device__ __forceinline__ unsigned f2bf(float f) { return pk2(f, 0.0f) & 0xffffu; }
__device__ __forceinline__ float bf2f(unsigned h) { return __builtin_bit_cast(float, h << 16); }
__device__ __forceinline__ float bflo(unsigned w) { return __builtin_bit_cast(float, w << 16); }
__device__ __forceinline__ float bfhi(unsigned w) { return __builtin_bit_cast(float, w & 0xffff0000u); }
__device__ __forceinline__ f32x4 ldg4(const float* base, unsigned off) { return *(const f32x4*)((const char*)base + off); }
__device__ __forceinline__ void stg4(float* base, unsigned off, f32x4 v) { *(f32x4*)((char*)base + off) = v; }
__device__ __forceinline__ void stg2u(void* base, unsigned off, u32x2 v) { *(u32x2*)((char*)base + off) = v; }
__device__ __forceinline__ float row16_sum(float v) {
    v += __builtin_bit_cast(float, __builtin_amdgcn_update_dpp(0, __builtin_bit_cast(int, v), 0x128, 0xf, 0xf, false));
    v += __builtin_bit_cast(float, __builtin_amdgcn_update_dpp(0, __builtin_bit_cast(int, v), 0x124, 0xf, 0xf, false));
    v += __builtin_bit_cast(float, __builtin_amdgcn_update_dpp(0, __builtin_bit_cast(int, v), 0x122, 0xf, 0xf, false));
    v += __builtin_bit_cast(float, __builtin_amdgcn_update_dpp(0, __builtin_bit_cast(int, v), 0x121, 0xf, 0xf, false));
    return v;
}
__device__ __forceinline__ float wave_sum(float v) {
    v = row16_sum(v);
    const int vi = __builtin_bit_cast(int, v);
    return (__builtin_bit_cast(float, __builtin_amdgcn_readlane(vi, 0)) + __builtin_bit_cast(float, __builtin_amdgcn_readlane(vi, 16))) + (__builtin_bit_cast(float, __builtin_amdgcn_readlane(vi, 32)) + __builtin_bit_cast(float, __builtin_amdgcn_readlane(vi, 48)));
}
__device__ __forceinline__ float sigmoidf_(float x) { return __builtin_amdgcn_rcpf(1.0f + __expf(-x)); }
__device__ __forceinline__ float siluf_(float x) { return x * sigmoidf_(x); }
__device__ __forceinline__ float softplusf_(float x) { return x > 20.f ? x : log1pf(__expf(x)); }
__device__ __forceinline__ float gelu_tanhf_(float x) { const float e = x * __builtin_fmaf(x * x, -0.10294324f, -2.3022082f); return x * __builtin_amdgcn_rcpf(__builtin_amdgcn_exp2f(e) + 1.0f); }
__device__ __forceinline__ float rdlane(float x, int l) { return __builtin_bit_cast(float, __builtin_amdgcn_readlane(__builtin_bit_cast(int, x), l)); }

#define XB_TMO      128
#define XB_XCNT(j)  (256  + 64 * (j))
#define XB_XSUB(j)  (1280 + 64 * (j))
#define XB_XGEN(j)  (2304 + 64 * (j))
#define XB_TOP      3328
#define XB_TOPGEN   3392
#define XCD_BAR_WORDS 3456
#define XB_SPIN_CAP (1u << 22)
__device__ __forceinline__ unsigned xb_ld(unsigned* p)              { return __hip_atomic_load(p, __ATOMIC_RELAXED, __HIP_MEMORY_SCOPE_AGENT); }
__device__ __forceinline__ unsigned xb_add(unsigned* p, unsigned v) { return __hip_atomic_fetch_add(p, v, __ATOMIC_RELAXED, __HIP_MEMORY_SCOPE_AGENT); }
__device__ __forceinline__ unsigned xb_xcc_id() { return (unsigned)__builtin_amdgcn_s_getreg((3 << 11) | 20) & 0xFu; }
#define XB_SPIN(cond, bar) do { unsigned _sp = 0; while (cond) { __builtin_amdgcn_s_sleep(1); \
    if ((++_sp & 255u) == 0u) { if (xb_ld(&(bar)[XB_TMO])) break; if (_sp > XB_SPIN_CAP) { atomicAdd(&(bar)[XB_TMO], 1u); break; } } } } while (0)
struct XcdBarrier { unsigned* bar; unsigned x; volatile LAS unsigned* st; };
__device__ __forceinline__ XcdBarrier xcd_barrier_post(unsigned* bar, volatile LAS unsigned* st) {
    XcdBarrier b; b.bar = bar; b.x = xb_xcc_id(); b.st = st;
    if (threadIdx.x == 0) (void)xb_add(&bar[XB_XCNT(b.x)], 1u);
    return b;
}
__device__ __forceinline__ void xcd_barrier_complete(unsigned* bar, unsigned x, unsigned& nloc, unsigned& nx) {
    const unsigned G = gridDim.x * gridDim.y * gridDim.z;
    unsigned sum, cnt, mine, sp = 0u;
    for (;;) {
        sum = 0u; cnt = 0u; mine = 0u;
#pragma unroll
        for (unsigned j = 0; j < 16; ++j) { const unsigned c = xb_ld(&bar[XB_XCNT(j)]); sum += c; cnt += (c > 0u) ? 1u : 0u; mine = (j == x) ? c : mine; }
        if (sum == G) break;
        __builtin_amdgcn_s_sleep(1);
        if ((++sp & 255u) == 0u) { if (xb_ld(&bar[XB_TMO])) break; if (sp > XB_SPIN_CAP) { atomicAdd(&bar[XB_TMO], 1u); break; } }
    }
    nloc = mine > 0u ? mine : 1u; nx = cnt > 0u ? cnt : 1u;
}
__device__ __forceinline__ void xcd_barrier(const XcdBarrier& b) {
    asm volatile("s_waitcnt vmcnt(0)" ::: "memory");
    __syncthreads();
    if (threadIdx.x == 0) {
        unsigned* bar = b.bar;
        __builtin_amdgcn_s_waitcnt(0);
        unsigned nloc = b.st[0], nx = b.st[1];
        if (nloc == 0u) { xcd_barrier_complete(bar, b.x, nloc, nx); b.st[0] = nloc; b.st[1] = nx; }
        const unsigned old = xb_add(&bar[XB_XSUB(b.x)], 1u);
        const unsigned gen = old / nloc;
        if (old + 1u == (gen + 1u) * nloc) {
            __builtin_amdgcn_fence(__ATOMIC_RELEASE, "agent");
            asm volatile("s_waitcnt vmcnt(0)" ::: "memory");
            const unsigned og = xb_add(&bar[XB_TOP], 1u);
            const unsigned tg = og / nx;
            if (og + 1u == (tg + 1u) * nx) xb_add(&bar[XB_TOPGEN], 1u);
            else XB_SPIN(xb_ld(&bar[XB_TOPGEN]) == tg, bar);
            __builtin_amdgcn_fence(__ATOMIC_ACQUIRE, "agent");
            xb_add(&bar[XB_XGEN(b.x)], 1u);
            asm volatile("s_waitcnt vmcnt(0)" ::: "memory");
        } else {
            XB_SPIN(xb_ld(&bar[XB_XGEN(b.x)]) == gen, bar);
            __builtin_amdgcn_fence(__ATOMIC_ACQUIRE, "agent");
            asm volatile("s_waitcnt vmcnt(0)" ::: "memory");
        }
    }
    __syncthreads();
}

struct Args { const float* in[N_INPUTS]; float* out; unsigned char* ws; int ph_lo, ph_hi; };
struct Frame {
    LAS unsigned char* lds;
    int tid, lane, wave, vcu, G;
    const float* const* in;
    float* out; unsigned char* ws;
    unsigned long long* pta;
};
#define F_modp ((float*)(F.ws + WS_MODP))
#define F_mod ((float*)(F.ws + WS_MOD))
#define F_WL ((bf16*)(F.ws + WS_WL))
#define F_CAR ((f32x2*)(F.ws + WS_CAR))
#define F_HIN ((float*)(F.ws + WS_HIN))
#define F_GB ((f32x2*)(F.ws + WS_GB))
#define F_KQ ((float*)(F.ws + WS_KQ))
#define F_SSQ ((float*)(F.ws + WS_SSQ))
#define F_Wt_out ((bf16*)(F.ws + WS_WOUT))
#define F_Wt_gu ((bf16*)(F.ws + WS_WGU))
#define F_Wt_dn ((bf16*)(F.ws + WS_WDN))
#define F_Wt_in ((bf16*)(F.ws + WS_WIN))
#define F_H ((bf16*)(F.ws + WS_H))
#define F_QN ((bf16*)(F.ws + WS_QN))
#define F_KN ((bf16*)(F.ws + WS_KN))
#define F_VN ((bf16*)(F.ws + WS_VN))
#define F_H2 ((bf16*)(F.ws + WS_H2))
#define F_LX ((bf16*)(F.ws + WS_LX))
#define F_LG ((bf16*)(F.ws + WS_LG))
#define F_QKV ((bf16*)(F.ws + WS_QKV))
#define F_Z ((bf16*)(F.ws + WS_Z))
#define F_BA ((bf16*)(F.ws + WS_BA))
#define F_ACT ((bf16*)(F.ws + WS_ACT))
#define F_MIX ((bf16*)(F.ws + WS_MIX))
#define F_RSL ((float*)(F.ws + WS_RSL))
#define F_X1B ((bf16*)(F.ws + WS_MIX))
#define F_Y1 ((bf16*)(F.ws + WS_Y1))
#define F_Y2 ((bf16*)(F.ws + WS_Y2Y))
#define F_O (F.out)
#define F_UT ((bf16*)(F.ws + WS_UT))
#define F_W ((bf16*)(F.ws + WS_W))
#define F_INTRA ((bf16*)(F.ws + WS_INTRA))
#define F_KT ((bf16*)(F.ws + WS_KT))
#define F_GSC ((float*)(F.ws + WS_GSC))
#define F_QC ((bf16*)(F.ws + WS_QC))

#if defined(PROBE_TIME_PHASE) && PROBE_TIME_PHASE >= 100
#define PTA_BEGIN(id) unsigned long long pta_t0_##id = ((id) == PROBE_TIME_PHASE - 100) ? __builtin_amdgcn_s_memrealtime() : 0ull
#define PTA_END(id) do { if ((id) == PROBE_TIME_PHASE - 100) *F.pta += __builtin_amdgcn_s_memrealtime() - pta_t0_##id; } while (0)
#else
#define PTA_BEGIN(id) do { } while (0)
#define PTA_END(id) do { } while (0)
#endif
template <bool FRAG = false, bool KTILED = false>
__device__ __forceinline__ void transpose_item(const float* W, int N, bf16* WT, int Kp, int k0, int n0, int drow0, LAS float* scr, int lane, const float* kscale = nullptr) {
    f32x4 tv[8];
    const int lr = lane >> 3, lq = 4 * (lane & 7);
#pragma unroll
    for (int i = 0; i < 8; ++i) tv[i] = *(const f32x4*)(W + (size_t)(k0 + 8 * i + lr) * N + n0 + lq);
    if (kscale) {
#pragma unroll
        for (int i = 0; i < 8; ++i) tv[i] = tv[i] * kscale[k0 + 8 * i + lr]; }
#pragma unroll
    for (int i = 0; i < 8; ++i) { LAS float* s = scr + (8 * i + lr) * 33 + lq; s[0] = tv[i].x; s[1] = tv[i].y; s[2] = tv[i].z; s[3] = tv[i].w; }
    LDS_WAIT(); asm volatile("" ::: "memory");
    const int c = lane & 7;
#pragma unroll
    for (int j = 0; j < 4; ++j) { const int n = (lane >> 3) + 8 * j; const LAS float* s = scr + (8 * c) * 33 + n;
        u32x4 o; o.x = pk2(s[0 * 33], s[1 * 33]); o.y = pk2(s[2 * 33], s[3 * 33]); o.z = pk2(s[4 * 33], s[5 * 33]); o.w = pk2(s[6 * 33], s[7 * 33]);
        if (FRAG) { const int jr = drow0 + n, ic = k0 + 8 * c; *(u32x4*)(WT + ((((jr >> 4) * 4 + (ic >> 5)) * 64 + ((ic >> 3) & 3) * 16 + (jr & 15)) * 8)) = o; }
        else if (KTILED) { const int jr = drow0 + n, ic = k0 + 8 * c; *(u32x4*)(WT + ((size_t)(jr >> 8) * (Kp / 64) + (ic >> 6)) * 16384 + (jr & 255) * 64 + (ic & 63)) = o; }
        else *(u32x4*)(WT + (size_t)(drow0 + n) * Kp + k0 + 8 * c) = o; }
    LDS_WAIT(); asm volatile("" ::: "memory");
}

constexpr int IT_G = 64 * (DFF / 32), IT_D = (DFF / 64) * (DM / 32);
template <int KIND>
__device__ __forceinline__ void wprep_late(const Frame& F, const int lo, const int hi, const int bidx, const int nb) {
    __syncthreads();
    LAS float* scr = (LAS float*)(F.lds + F.wave * 16384);
    const int lane = F.lane, st = nb * 8, c = lane & 7;
    f32x4 ta[8];
    const int lr = lane >> 3, lq = 4 * (lane & 7);
    auto src = [&](int r) -> const float* {
        if (KIND == 0) { const int up = r >= IT_G; if (up) r -= IT_G; const int kb = r / (DFF / 32), nbk = r % (DFF / 32);
            return F.in[up ? I_WU : I_WG] + (size_t)(64 * kb + lr) * DFF + 32 * nbk + lq; }
        const int kb = r / (DM / 32), nbk = r % (DM / 32); return F.in[I_WD] + (size_t)(64 * kb + lr) * DM + 32 * nbk + lq; };
    constexpr int NS = KIND == 0 ? DFF : DM;
#define WPL_LOAD(tv, item) do { if ((item) < hi) { const float* s_ = src(item); _Pragma("unroll") for (int i = 0; i < 8; ++i) tv[i] = __builtin_nontemporal_load((const f32x4*)(s_ + (size_t)(8 * i) * NS)); } } while (0)
#define WPL_ITEM(tv, item) do { \
        _Pragma("unroll") for (int i = 0; i < 8; ++i) { LAS float* s_ = scr + (8 * i + lr) * 33 + lq; s_[0] = tv[i].x; s_[1] = tv[i].y; s_[2] = tv[i].z; s_[3] = tv[i].w; } \
        WPL_LOAD(tv, (item) + st); \
        LDS_WAIT(); asm volatile("" ::: "memory"); \
        const int r = (item); \
        _Pragma("unroll") for (int j = 0; j < 4; ++j) { const int n = (lane >> 3) + 8 * j; const LAS float* s = scr + (8 * c) * 33 + n; \
            u32x4 o; o.x = pk2(s[0 * 33], s[1 * 33]); o.y = pk2(s[2 * 33], s[3 * 33]); o.z = pk2(s[4 * 33], s[5 * 33]); o.w = pk2(s[6 * 33], s[7 * 33]); \
            if (KIND == 0) { const int up = r >= IT_G, r2 = up ? r - IT_G : r, kb = r2 / (DFF / 32), n0 = 32 * (r2 % (DFF / 32)); \
                __builtin_nontemporal_store(o, (u32x4*)(F_Wt_gu + (size_t)(256 * (n0 >> 7) + (n0 & 127) + (up ? 128 : 0) + n) * DM + 64 * kb + 8 * c)); } \
            else { const int kb = r / (DM / 32), jr = 32 * (r % (DM / 32)) + n; \
                __builtin_nontemporal_store(o, (u32x4*)(F_Wt_dn + ((size_t)(jr >> 8) * (DFF / 64) + kb) * 16384 + (jr & 255) * 64 + 8 * c)); } } \
        LDS_WAIT(); asm volatile("" ::: "memory"); } while (0)
    int it = lo + bidx * 8 + F.wave;
    WPL_LOAD(ta, it);
    for (; it < hi; it += st) WPL_ITEM(ta, it);
#undef WPL_LOAD
#undef WPL_ITEM
}
__device__ __forceinline__ void ph0_prologue(const Frame& F, const int gu_lo) {
    const int gw = F.vcu * 8 + F.wave, NGW = F.G * 8, lane = F.lane;
    {
        const float* W = F.in[I_WADA]; const float* c = F.in[I_C]; const float* cc = F.in[I_CCTX];
        for (int it = gw; it < 96 * 32; it += NGW) {
            const int cg = it % 96, kc = it / 96;
            float sv[3][2];
#pragma unroll
            for (int h = 0; h < 2; ++h) { const int k = kc * 128 + h * 64 + lane; sv[0][h] = siluf_(c[k]); sv[1][h] = siluf_(c[DM + k]); sv[2][h] = siluf_(cc[k]); }
            f32x4 a0 = {0.f, 0.f, 0.f, 0.f}, a1 = a0, a2 = a0;
            const f32x4* wp = (const f32x4*)(W + (size_t)kc * 128 * NADA + cg * 256) + lane;
#pragma unroll
            for (int h = 0; h < 2; ++h) {
#pragma unroll 16
                for (int kk = 0; kk < 64; ++kk) { const f32x4 w = wp[(size_t)(h * 64 + kk) * (NADA / 4)];
                    const float s0 = rdlane(sv[0][h], kk), s1 = rdlane(sv[1][h], kk), s2 = rdlane(sv[2][h], kk);
                    a0 += w * s0; a1 += w * s1; a2 += w * s2; } }
            float* mp = F_modp + (size_t)(kc * 3) * NADA + cg * 256;
            ((f32x4*)mp)[lane] = a0; ((f32x4*)(mp + NADA))[lane] = a1; ((f32x4*)(mp + 2 * NADA))[lane] = a2;
        }
    }
    {
        LAS float* scr = (LAS float*)(F.lds + F.wave * 16384);
        constexpr int IT_IN = 64 * (NIN / 32), IT_OUT = 64 * (DM / 32), IT_L = 64 * 8;
        const int NGU = 2 * IT_G - gu_lo, NITEMS = IT_IN + IT_OUT + IT_L + NGU;
        for (int it = gw; it < NITEMS; it += NGW) {
            int r = it;
            if (r < IT_IN) { const int kb = r / (NIN / 32), nb = r % (NIN / 32); transpose_item(F.in[I_WIN], NIN, F_Wt_in, DM, 64 * kb, 32 * nb, 32 * nb, scr, lane); continue; } r -= IT_IN;
            if (r < IT_OUT) { const int kb = r / (DM / 32), nb = r % (DM / 32); transpose_item(F.in[I_WOUT], DM, F_Wt_out, DM, 64 * kb, 32 * nb, 32 * nb, scr, lane, 64 * kb < LW ? F.in[I_LNG] : nullptr); continue; } r -= IT_OUT;
            if (r < NGU) { r += gu_lo; const int up = r >= IT_G; if (up) r -= IT_G; const int kb = r / (DFF / 32), nb = r % (DFF / 32), n0 = 32 * nb;
                transpose_item(F.in[up ? I_WU : I_WG], DFF, F_Wt_gu, DM, 64 * kb, n0, 256 * (n0 >> 7) + (n0 & 127) + (up ? 128 : 0), scr, lane); continue; } r -= NGU;
            { const int mi = r >> 3, sub = r & 7, kb = sub >> 2, nb = sub & 3, d = mi >> 5, kind = (mi >> 4) & 1, n = mi & 15;
              transpose_item<true>(F.in[kind ? I_LWX : I_LWA] + (size_t)(d * 16 + n) * 16384, 128, F_WL + (size_t)((d * 2 + kind) * 16 + n) * 16384, 128, 64 * kb, 32 * nb, 32 * nb, scr, lane); }
        }
    }
    {
        u32x4* p = (u32x4*)(F_Wt_in + (size_t)NIN * DM); const u32x4 z = {0u, 0u, 0u, 0u};
        for (int i = F.vcu * 512 + F.tid; i < (NINP - NIN) * DM / 8; i += F.G * 512) p[i] = z;
    }
}
__device__ __forceinline__ void ph1_modreduce(const Frame& F) {
    const float* ba = F.in[I_BADA];
    for (int i = F.vcu * 512 + F.tid; i < 3 * NADA; i += F.G * 512) { const int r = i / NADA, col = i - r * NADA, seg = col >> 12, c = col & (DM - 1); float s = ba[col];
#pragma unroll 8
        for (int kc = 0; kc < 32; ++kc) s += F_modp[(size_t)(kc * 3 + r) * NADA + col];
        float v; int dst;
        if (seg == 0) { v = s; dst = 1; } else if (seg == 1) { v = F.in[I_GPREMIX][c] * (1.0f + s); dst = 0; } else if (seg == 2) { v = s * F.in[I_GPOSTMIX][c]; dst = 2; }
        else if (seg == 3) { v = s; dst = 4; } else if (seg == 4) { v = F.in[I_GPREFFN][c] * (1.0f + s); dst = 3; } else { v = s * F.in[I_GPOSTFFN][c]; dst = 5; }
        F_mod[(size_t)r * NADA + dst * DM + c] = v; }
}
__device__ __forceinline__ void ph2_hrows(const Frame& F) {
    const int gw = F.vcu * 8 + F.wave, NGW = F.G * 8, lane = F.lane;
    for (int row = gw; row < MT; row += NGW) {
        const f32x4* xr = (const f32x4*)(row < ML ? F.in[I_X] + (size_t)row * DM : F.in[I_CTX] + (size_t)(row - ML) * DM);
        const f32x4* md = (const f32x4*)(F_mod + (size_t)(row < ML ? row / TL : 2) * NADA);
        f32x4 v[16]; float ss = 0.f;
#pragma unroll
        for (int j = 0; j < 16; ++j) { v[j] = xr[lane + 64 * j]; ss += (v[j].x * v[j].x + v[j].y * v[j].y) + (v[j].z * v[j].z + v[j].w * v[j].w); }
        const float rs = rsqrtf(wave_sum(ss) * (1.0f / DM) + EPS);
        u32x2* o = (u32x2*)(F_H + (size_t)row * DM);
#pragma unroll
        for (int j = 0; j < 16; ++j) { const f32x4 y = (v[j] * rs) * md[lane + 64 * j] + md[DM / 4 + lane + 64 * j];
            u32x2 w; w.x = pk2(y.x, y.y); w.y = pk2(y.z, y.w); o[lane + 64 * j] = w; }
    }
}

template <int PASS>
__device__ __forceinline__ void lru_pass(const Frame& F, const int widx, const int nw) {
    LAS bf16* U = (LAS bf16*)(F.lds);
    LAS float* XC = (LAS float*)(F.lds + 17408);
    LAS bf16* XCB = (LAS bf16*)(F.lds + 17408 + 32768);
    LAS f32x2* SC = (LAS f32x2*)(F.lds + 17408 + 32768 + 17408 + F.wave * 8192);
    const int tid = F.tid, lane = F.lane, w = F.wave, fr = lane & 15, fq = lane >> 4;
    const int n = widx & 15;
    const int cl = 16 * w + fr, cg = n * 128 + cl;
    float ba[2], bx[2], sp[2];
#pragma unroll
    for (int d = 0; d < 2; ++d) { ba[d] = F.in[I_LBA][d * LW + cg]; bx[d] = F.in[I_LBX][d * LW + cg]; sp[d] = softplusf_(-F.in[I_LLAM][d * LW + cg]); }
    const int cc = tid & 127, tg = tid >> 7;
    float cw[4];
#pragma unroll
    for (int j = 0; j < 4; ++j) cw[j] = F.in[I_LCW][j * LW + n * 128 + cc];
    const float cb = F.in[I_LCB][n * 128 + cc];
    const int qstep = nw >> 4;
    u32x4 ur[3];
#define LRU_LOADU(qq) do { const int b_ = (qq) / NCH, ci_ = (qq) - b_ * NCH; const bool ic_ = ci_ < 4; const int t0_ = ic_ ? ci_ * 64 : (ci_ - 4) * 64, Ts_ = ic_ ? TCX : TL; \
        const size_t rb_ = ic_ ? (size_t)ML + (size_t)b_ * TCX : (size_t)b_ * TL; \
        _Pragma("unroll") for (int k_ = 0; k_ < 3; ++k_) { const int rr_ = (tid >> 4) + 32 * k_, t_ = t0_ - 2 + rr_; ur[k_] = (u32x4){0u, 0u, 0u, 0u}; \
            if (rr_ < 67 && t_ >= 0 && t_ < Ts_) ur[k_] = *(const u32x4*)(F_LX + (rb_ + t_) * LW + n * 128 + (tid & 15) * 8); } } while (0)
    int q = widx >> 4;
    if (PASS == 2) while (q < NBATCH * NCH && (q % NCH) < 4) q += qstep;
    if (q < NBATCH * NCH) LRU_LOADU(q);
    while (q < NBATCH * NCH) {
        int qn = q + qstep;
        if (PASS == 2) while (qn < NBATCH * NCH && (qn % NCH) < 4) qn += qstep;
        int tz = F.tid; asm volatile("" : "+v"(tz));
        const int tid = tz, lane = tz & 63, fr = lane & 15, fq = lane >> 4, cl = 16 * w + fr, cc = tid & 127, tg = tid >> 7;
        const int b = q / NCH, cidx = q - b * NCH;
        const bool isctx = cidx < 4; const int t0 = isctx ? cidx * 64 : (cidx - 4) * 64;
        const size_t rowbase = isctx ? (size_t)ML + (size_t)b * TCX : (size_t)b * TL;
        PTA_BEGIN(10);
        __syncthreads();
#pragma unroll
        for (int k = 0; k < 3; ++k) { const int rr = (tid >> 4) + 32 * k; if (rr < 67) *(LAS u32x4*)(U + rr * 128 + (tid & 15) * 8) = ur[k]; }
        if (qn < NBATCH * NCH) LRU_LOADU(qn);
        bf16x8 bfr[2][4];
#define LRU_LOADB(dd) do { _Pragma("unroll") for (int mat = 0; mat < 2; ++mat) _Pragma("unroll") for (int ks = 0; ks < 4; ++ks) bfr[mat][ks] = *(const bf16x8*)(F_WL + (size_t)((2 * (dd) + mat) * 16 + n) * 16384 + ((w * 4 + ks) * 64 + lane) * 8); } while (0)
        LRU_LOADB(0);
        u32x4 gt0 = {0u, 0u, 0u, 0u}, gt1 = gt0;
        if (PASS == 2) { gt0 = *(const u32x4*)(F_LG + (rowbase + t0 + (tid >> 4)) * LW + n * 128 + (tid & 15) * 8); gt1 = *(const u32x4*)(F_LG + (rowbase + t0 + 32 + (tid >> 4)) * LW + n * 128 + (tid & 15) * 8); }
        __syncthreads();
        { float x0 = bf2f(U[(tg * 16 + 0) * 128 + cc]), x1 = bf2f(U[(tg * 16 + 1) * 128 + cc]), x2 = bf2f(U[(tg * 16 + 2) * 128 + cc]);
#pragma unroll
          for (int i = 0; i < 16; ++i) { const int tt = tg * 16 + i; const float x3 = bf2f(U[(tt + 3) * 128 + cc]);
              const float y = cb + cw[0] * x0 + cw[1] * x1 + cw[2] * x2 + cw[3] * x3; XC[tt * 128 + cc] = y; XCB[tt * 136 + cc] = (bf16)f2bf(y); x0 = x1; x1 = x2; x2 = x3; } }
        __syncthreads();
        if (PASS == 2) { *(LAS u32x4*)(U + (tid >> 4) * 128 + (tid & 15) * 8) = gt0; *(LAS u32x4*)(U + (32 + (tid >> 4)) * 128 + (tid & 15) * 8) = gt1; }
        if (PASS == 1) PTA_END(10);
        PTA_BEGIN(11);
        float hsum[4][4];
#pragma unroll
        for (int d = 0; d < 2; ++d) {
            f32x4 acc[2][4];
#pragma unroll
            for (int mat = 0; mat < 2; ++mat)
#pragma unroll
                for (int mt = 0; mt < 4; ++mt) acc[mat][mt] = (f32x4){0.f, 0.f, 0.f, 0.f};
#pragma unroll
            for (int mt = 0; mt < 4; ++mt)
#pragma unroll
                for (int ks = 0; ks < 4; ++ks) { const bf16x8 af = *(const LAS bf16x8*)(XCB + (16 * mt + fr) * 136 + 32 * ks + 8 * fq);
                    acc[0][mt] = __builtin_amdgcn_mfma_f32_16x16x32_bf16(af, bfr[0][ks], acc[0][mt], 0, 0, 0);
                    acc[1][mt] = __builtin_amdgcn_mfma_f32_16x16x32_bf16(af, bfr[1][ks], acc[1][mt], 0, 0, 0); }
            if (d == 0) LRU_LOADB(1);
#pragma unroll
            for (int mt = 0; mt < 4; ++mt)
#pragma unroll
                for (int rg = 0; rg < 4; ++rg) { const int tok = 16 * mt + 4 * fq + rg; const float xcv = XC[tok * 128 + cl];
                    const float r = sigmoidf_(acc[0][mt][rg] + ba[d]), ig = sigmoidf_(acc[1][mt][rg] + bx[d]);
                    const float la = -8.0f * r * sp[d]; const float a = __expf(la);
                    const float em = __builtin_fmaf(-a, a, 1.0f);
                    const float bb = sqrtf(em) * (ig * xcv);
                    SC[tok * 16 + fr] = (f32x2){a, bb}; }
            WAVE_LDS_FENCE();
            float P = 1.0f, h = 0.0f;
            float Pk[16], hk[16];
#pragma unroll
            for (int i = 0; i < 16; ++i) { const int tok = 16 * fq + (d == 0 ? i : 15 - i); const f32x2 ab = SC[tok * 16 + fr]; h = ab.x * h + ab.y; P *= ab.x; Pk[i] = P; hk[i] = h; }
            float As[4], Bs[4];
#pragma unroll
            for (int s = 0; s < 4; ++s) { As[s] = __shfl(P, s * 16 + fr); Bs[s] = __shfl(h, s * 16 + fr); }
            const size_t cidx_off = ((size_t)((d * 2 + b) * NCH + cidx)) * LW + cg;
            if (PASS == 1) {
                float At = 1.0f, Bt = 0.0f;
#pragma unroll
                for (int s = 0; s < 4; ++s) { const int sgi = d == 0 ? s : 3 - s; Bt = As[sgi] * Bt + Bs[sgi]; At *= As[sgi]; }
                if (fq == 0) F_CAR[cidx_off] = (f32x2){At, Bt};
            } else {
                float hin = F_HIN[cidx_off];
#pragma unroll
                for (int s = 0; s < 4; ++s) { const int sgi = d == 0 ? s : 3 - s; const bool before = d == 0 ? (sgi < fq) : (sgi > fq); if (before) hin = As[sgi] * hin + Bs[sgi]; }
#pragma unroll
                for (int i = 0; i < 16; ++i) { const int tok = 16 * fq + (d == 0 ? i : 15 - i); SC[tok * 16 + fr].y = hk[i] + Pk[i] * hin; }
                WAVE_LDS_FENCE();
#pragma unroll
                for (int mt = 0; mt < 4; ++mt)
#pragma unroll
                    for (int rg = 0; rg < 4; ++rg) { const float hv = SC[(16 * mt + 4 * fq + rg) * 16 + fr].y; hsum[mt][rg] = d == 0 ? hv : hsum[mt][rg] + hv; }
            }
            WAVE_LDS_FENCE();
        }
#undef LRU_LOADB
        if (PASS == 1) PTA_END(11);
        if (PASS == 2) {
            __syncthreads();
#pragma unroll
            for (int mt = 0; mt < 4; ++mt)
#pragma unroll
                for (int rg = 0; rg < 4; ++rg) { const int tok = 16 * mt + 4 * fq + rg;
                    const float y = hsum[mt][rg] * gelu_tanhf_(bf2f(U[tok * 128 + cl])); XCB[tok * 136 + cl] = (bf16)f2bf(y); }
            __syncthreads();
#pragma unroll
            for (int hh = 0; hh < 2; ++hh) { const int tok = hh * 32 + (tid >> 4); const u32x4 wv = *(const LAS u32x4*)(XCB + tok * 136 + (tid & 15) * 8);
                const size_t row = rowbase + t0 + tok; *(u32x4*)(F_MIX + row * DM + n * 128 + (tid & 15) * 8) = wv;
                float sq = (bflo(wv.x) * bflo(wv.x) + bfhi(wv.x) * bfhi(wv.x)) + (bflo(wv.y) * bflo(wv.y) + bfhi(wv.y) * bfhi(wv.y)) + (bflo(wv.z) * bflo(wv.z) + bfhi(wv.z) * bfhi(wv.z)) + (bflo(wv.w) * bflo(wv.w) + bfhi(wv.w) * bfhi(wv.w));
                sq = row16_sum(sq);
                if ((tid & 15) == 0) F_SSQ[row * 16 + n] = sq; }
        }
        q = qn;
    }
#undef LRU_LOADU
}
__device__ __forceinline__ int gdn_row(int b, int s) {
    if (s < TCX) return ML + b * TCX + s;
    const int m = s - TCX; return b * TL + (m & 127) * 64 + (m >> 7);
}
__device__ __forceinline__ void lru_chains_block(const Frame& F, const int n) {
    int tz = F.tid; asm volatile("" : "+v"(tz));
    { const int cg = n * 128 + (tz & 127), b = __builtin_amdgcn_readfirstlane((tz >> 7) & 1), d = __builtin_amdgcn_readfirstlane(tz >> 8);
        float h = 0.f;
        const size_t base = (size_t)((d * 2 + b) * NCH) * LW;
#pragma unroll 1
        for (int s0 = 0; s0 < NCH; s0 += 66) { f32x2 ab[66];
#pragma unroll
            for (int k = 0; k < 66; ++k) { const int step = s0 + k, cidx = d == 0 ? step : (step < 4 ? 3 - step : NCH - 1 - (step - 4)); ab[k] = (F_CAR + base + (size_t)cidx * LW)[cg]; }
#pragma unroll
            for (int k = 0; k < 66; ++k) { const int step = s0 + k, cidx = d == 0 ? step : (step < 4 ? 3 - step : NCH - 1 - (step - 4)); (F_HIN + base + (size_t)cidx * LW)[cg] = h; h = ab[k].x * h + ab[k].y; } }
    }
    __builtin_amdgcn_fence(__ATOMIC_RELEASE, "workgroup"); __syncthreads(); __builtin_amdgcn_fence(__ATOMIC_ACQUIRE, "workgroup");
}
__device__ __forceinline__ void unpk8(const u32x4 w, f32x4& lo, f32x4& hi);
__device__ __forceinline__ float sq4(const f32x4 v);
__device__ __forceinline__ void mix_finish(const Frame& F) {
    const int gw = F.vcu * 8 + F.wave, NGW = F.G * 8, lane = F.lane, lg = lane >> 4, l8 = 8 * (lane & 15);
    const f32x4 gn0 = *(const f32x4*)(F.in[I_GNG] + l8), gn1 = *(const f32x4*)(F.in[I_GNG] + l8 + 4);
    for (int row = gw; row < ML; row += NGW) {
        const int b = row / TL, t = row - b * TL, m = (t & 63) * 128 + (t >> 6), cl = m >> 6, i = m & 63;
#pragma unroll
        for (int j = 0; j < 4; ++j) { const int h = 4 * ((j + gw) & 3) + lg;
            const size_t it0 = ((size_t)((b * NH + h) * 128 + cl)) * 2;
            const u32x4 a = *(const u32x4*)((const bf16*)F_O + it0 * 8192 + i * 128 + l8), c = *(const u32x4*)((const bf16*)F_O + (it0 + 1) * 8192 + (63 - i) * 128 + l8);
            const u32x4 zw = *(const u32x4*)(F_Z + (size_t)row * GDW + h * HD + l8);
            f32x4 a0, a1, c0, c1, z0, z1; unpk8(a, a0, a1); unpk8(c, c0, c1); unpk8(zw, z0, z1);
            const f32x4 o0 = a0 + c0, o1 = a1 + c1;
            const float rs = rsqrtf(row16_sum(sq4(o0) + sq4(o1)) * (1.0f / HD) + EPS);
            u32x4 o; o.x = pk2(o0.x * rs * gn0.x * siluf_(z0.x), o0.y * rs * gn0.y * siluf_(z0.y)); o.y = pk2(o0.z * rs * gn0.z * siluf_(z0.z), o0.w * rs * gn0.w * siluf_(z0.w));
            o.z = pk2(o1.x * rs * gn1.x * siluf_(z1.x), o1.y * rs * gn1.y * siluf_(z1.y)); o.w = pk2(o1.z * rs * gn1.z * siluf_(z1.z), o1.w * rs * gn1.w * siluf_(z1.w));
            *(u32x4*)(F_MIX + (size_t)row * DM + LW + h * HD + l8) = o; }
        const float rsl = rsqrtf(row16_sum(F_SSQ[(size_t)row * 16 + (lane & 15)]) * (1.0f / LW) + EPS);
        if (lane == 0) F_RSL[row] = rsl;
    }
}
__device__ __forceinline__ void unpk8(const u32x4 w, f32x4& lo, f32x4& hi) { lo = (f32x4){bflo(w.x), bfhi(w.x), bflo(w.y), bfhi(w.y)}; hi = (f32x4){bflo(w.z), bfhi(w.z), bflo(w.w), bfhi(w.w)}; }
__device__ __forceinline__ float sq4(const f32x4 v) { return (v.x * v.x + v.y * v.y) + (v.z * v.z + v.w * v.w); }
__device__ __forceinline__ void ph_x1(const Frame& F) {
    const int gw = F.vcu * 8 + F.wave, NGW = F.G * 8, lane = F.lane;
    for (int row = gw; row < ML; row += NGW) {
        const f32x4* __restrict__ md = (const f32x4*)(F_mod + (size_t)(row / TL) * NADA) + 2 * lane;
        const u32x4* __restrict__ yr = (const u32x4*)(F_Y1 + (size_t)row * DM) + lane; const f32x4* __restrict__ xr = (const f32x4*)(F.in[I_X] + (size_t)row * DM) + 2 * lane;
        f32x4 y[16]; float ss = 0.f;
#pragma unroll
        for (int j = 0; j < 8; ++j) { unpk8(yr[64 * j], y[2 * j], y[2 * j + 1]); ss += sq4(y[2 * j]) + sq4(y[2 * j + 1]); }
        const float rs = rsqrtf(wave_sum(ss) * (1.0f / DM) + EPS); float s2 = 0.f;
#pragma unroll
        for (int j = 0; j < 8; ++j) {
#pragma unroll
            for (int e = 0; e < 2; ++e) { const f32x4 x1 = xr[128 * j + e] + md[2 * (DM / 4) + 128 * j + e] * (y[2 * j + e] * rs); y[2 * j + e] = x1; s2 += sq4(x1); }
            if (j & 1) asm volatile("" ::: "memory"); }
        const float r2 = rsqrtf(wave_sum(s2) * (1.0f / DM) + EPS);
        u32x4* __restrict__ o = (u32x4*)(F_H2 + (size_t)row * DM) + lane; u32x4* __restrict__ ox = (u32x4*)(F_X1B + (size_t)row * DM) + lane;
#pragma unroll
        for (int j = 0; j < 8; ++j) { { u32x4 w; w.x = pk2(y[2 * j].x, y[2 * j].y); w.y = pk2(y[2 * j].z, y[2 * j].w); w.z = pk2(y[2 * j + 1].x, y[2 * j + 1].y); w.w = pk2(y[2 * j + 1].z, y[2 * j + 1].w); ox[64 * j] = w; }
            const f32x4 h0 = (y[2 * j] * r2) * md[3 * (DM / 4) + 128 * j] + md[4 * (DM / 4) + 128 * j], h1 = (y[2 * j + 1] * r2) * md[3 * (DM / 4) + 128 * j + 1] + md[4 * (DM / 4) + 128 * j + 1];
            u32x4 w; w.x = pk2(h0.x, h0.y); w.y = pk2(h0.z, h0.w); w.z = pk2(h1.x, h1.y); w.w = pk2(h1.z, h1.w); o[64 * j] = w;
            if (j & 1) asm volatile("" ::: "memory"); }
    }
}
__device__ __forceinline__ void ph_final(const Frame& F) {
    int tz = F.tid; asm volatile("" : "+v"(tz));
    const int gw = F.vcu * 8 + F.wave, NGW = F.G * 8, lane = tz & 63;
    for (int row = gw; row < ML; row += NGW) {
        const f32x4* __restrict__ md = (const f32x4*)(F_mod + (size_t)(row / TL) * NADA) + 5 * (DM / 4) + 2 * lane;
        const u32x4* __restrict__ x1r = (const u32x4*)(F_X1B + (size_t)row * DM) + lane; const u32x4* __restrict__ y2r = (const u32x4*)(F_Y2 + (size_t)row * DM) + lane;
        f32x4* __restrict__ outr = (f32x4*)(F.out + (size_t)row * DM) + 2 * lane;
        u32x4 p[8], xq[8]; float s2 = 0.f;
#pragma unroll
        for (int j = 0; j < 8; ++j) { p[j] = y2r[64 * j]; xq[j] = x1r[64 * j]; }
#pragma unroll
        for (int j = 0; j < 8; ++j) { f32x4 lo, hi; unpk8(p[j], lo, hi); s2 += sq4(lo) + sq4(hi); }
        const float r2 = rsqrtf(wave_sum(s2) * (1.0f / DM) + EPS);
#pragma unroll
        for (int j = 0; j < 8; ++j) { f32x4 a0, a1, c0, c1; unpk8(xq[j], a0, a1); unpk8(p[j], c0, c1);
            outr[128 * j] = a0 + md[128 * j] * (c0 * r2); outr[128 * j + 1] = a1 + md[128 * j + 1] * (c1 * r2); }
    }
}
__device__ __forceinline__ size_t gdn_item(int b, int h, int c, int d) { return ((size_t)((b * NH + h) * NCH + c)) * 2 + d; }
__device__ __forceinline__ void gdn_solve32(const LAS float* Lb, float (&x)[32]) {
#define LROW(r, c0) (*(const LAS f32x4*)(Lb + (r) * 64 + (c0)))
    constexpr int GS = 8;
    f32x4 lbuf[2][GS]; int gb = 0;
#pragma unroll
    for (int j = 0; j < GS; ++j) lbuf[0][j] = LROW(4 + j, 0);
#pragma unroll
    for (int k = 0; k < 8; ++k) { const int r0 = 4 * k, nrows = 28 - 4 * k, ng = (nrows + GS - 1) / GS;
        { const f32x4 l1 = LROW(r0 + 1, r0), l2 = LROW(r0 + 2, r0), l3 = LROW(r0 + 3, r0);
          x[r0 + 1] -= l1.x * x[r0];
          x[r0 + 2] -= l2.x * x[r0] + l2.y * x[r0 + 1];
          x[r0 + 3] -= l3.x * x[r0] + l3.y * x[r0 + 1] + l3.z * x[r0 + 2]; }
#pragma unroll
        for (int g = 0; g < ng; ++g) { const int cur_ = (gb + g) & 1, nxt = cur_ ^ 1, rg0 = r0 + 4 + GS * g;
            if (g + 1 < ng) {
#pragma unroll
                for (int j = 0; j < GS; ++j) if (rg0 + GS + j < 32) lbuf[nxt][j] = LROW(rg0 + GS + j, r0);
            } else if (k + 1 < 8) {
#pragma unroll
                for (int j = 0; j < GS; ++j) if (r0 + 8 + j < 32) lbuf[nxt][j] = LROW(r0 + 8 + j, r0 + 4);
            }
#pragma unroll
            for (int j = 0; j < GS; ++j) if (rg0 + j < 32) { const int r = rg0 + j; const f32x4 l = lbuf[cur_][j];
                x[r] = __builtin_fmaf(-l.w, x[r0 + 3], __builtin_fmaf(-l.z, x[r0 + 2], __builtin_fmaf(-l.y, x[r0 + 1], __builtin_fmaf(-l.x, x[r0], x[r])))); }
            asm volatile("" ::: "memory"); }
        gb += ng; }
#undef LROW
}
__device__ __forceinline__ void gdn_chunk_pre(const Frame& F, const int v0) {
    LAS bf16* RAW = (LAS bf16*)(F.lds);
    LAS float* L_ = (LAS float*)(F.lds);
    LAS bf16* IN_ = (LAS bf16*)(F.lds + 32768);
    LAS bf16* Kt_ = (LAS bf16*)(F.lds + 51456);
    LAS bf16* Qt_ = (LAS bf16*)(F.lds + 68864);
    LAS bf16* VT_ = (LAS bf16*)(F.lds + 86272);
    LAS bf16* KTr_ = (LAS bf16*)(F.lds + 104704);
    LAS float* GC_ = (LAS float*)(F.lds + 123136);
    LAS float* BE_ = GC_ + 128;
    LAS float* BEG_ = GC_ + 256;
    LAS float* RK_ = GC_ + 384;
    LAS float* RQ_ = GC_ + 448;
    LAS float* RKD_ = GC_ + 512;
    const float* cwp = F.in[I_GCW];
    u32x4 rw[3][3]; f32x2 cwv[3][4]; float gpb = 0.f, gpa = 0.f, galog = 0.f, gdtb = 0.f;
#define GDN_LOADRAW(itx) do { const int c_ = (itx) / (NBATCH * NH), bh_ = (itx) % (NBATCH * NH), h_ = bh_ % NH, b_ = bh_ / NH, s0_ = c_ * 64, slo_ = c_ < 4 ? 0 : TCX, shi_ = c_ < 4 ? TCX : SEQ_S; \
        _Pragma("unroll") for (int p_ = 0; p_ < 3; ++p_) _Pragma("unroll") for (int j_ = 0; j_ < 4; ++j_) cwv[p_][j_] = *(const f32x2*)(cwp + (size_t)j_ * 6144 + p_ * GDW + h_ * HD + 2 * ((int)threadIdx.x & 63)); \
        if ((int)threadIdx.x < 128) { const int d_ = (int)threadIdx.x >> 6, pp_ = (int)threadIdx.x & 63, i_ = d_ ? 63 - pp_ : pp_; const bf16* bar_ = F_BA + (size_t)gdn_row(b_, s0_ + i_) * 256; \
            gpb = bf2f(bar_[d_ * 16 + h_]); gpa = bf2f(bar_[32 + d_ * 16 + h_]); galog = F.in[I_GALOG][d_ * 16 + h_]; gdtb = F.in[I_GDT][d_ * 16 + h_]; } \
        _Pragma("unroll") for (int k_ = 0; k_ < 3; ++k_) { const int pc_ = (int)threadIdx.x + 512 * k_, rr_ = pc_ >> 4, piece_ = pc_ & 15, s_ = s0_ - 2 + rr_; \
            rw[k_][0] = (u32x4){0u, 0u, 0u, 0u}; rw[k_][1] = rw[k_][0]; rw[k_][2] = rw[k_][0]; \
            if (pc_ < 67 * 16 && s_ >= slo_ && s_ < shi_) { const bf16* src_ = F_QKV + (size_t)gdn_row(b_, s_) * 6144 + h_ * HD + piece_ * 8; rw[k_][0] = *(const u32x4*)src_; rw[k_][1] = *(const u32x4*)(src_ + GDW); rw[k_][2] = *(const u32x4*)(src_ + 2 * GDW); } } } while (0)
    if (v0 < NBATCH * NH * NCH) GDN_LOADRAW(v0);
    for (int jt = v0; jt < NBATCH * NH * NCH; jt += F.G) {
        int tz = F.tid; asm volatile("" : "+v"(tz));
        const int tid = tz, lane = tz & 63, w = __builtin_amdgcn_readfirstlane(tz >> 6), fr = lane & 15, fq = lane >> 4;
        const int c = jt / (NBATCH * NH), bh = jt % (NBATCH * NH), h = bh % NH, b = bh / NH, it = bh * NCH + c;
        const size_t item0 = gdn_item(b, h, c, 0);
        const int s0 = c * 64, slo = c < 4 ? 0 : TCX, shi = c < 4 ? TCX : SEQ_S;
        __syncthreads();
        PTA_BEGIN(0);
#pragma unroll
        for (int k = 0; k < 3; ++k) { const int pc = tid + 512 * k; if (pc < 67 * 16) { LAS bf16* dst = RAW + (pc >> 4) * 384 + (pc & 15) * 8; *(LAS u32x4*)dst = rw[k][0]; *(LAS u32x4*)(dst + 128) = rw[k][1]; *(LAS u32x4*)(dst + 256) = rw[k][2]; } }
        PTA_BEGIN(8);
        const float beta = sigmoidf_(gpb), g = -__expf(galog) * softplusf_(gpa + gdtb);
        f32x2 cw[3][4];
#pragma unroll
        for (int p_ = 0; p_ < 3; ++p_)
#pragma unroll
            for (int j_ = 0; j_ < 4; ++j_) cw[p_][j_] = cwv[p_][j_];
        if (jt + F.G < NBATCH * NH * NCH) GDN_LOADRAW(jt + F.G);
        if (tid < 128) { const int d = tid >> 6, p = tid & 63;
            float gc = g;
#pragma unroll
            for (int o = 1; o < 64; o <<= 1) { const float t = __shfl_up(gc, o); if (lane >= o) gc += t; }
            GC_[d * 64 + p] = gc; BE_[d * 64 + p] = beta; BEG_[d * 64 + p] = beta * __expf(gc); }
        PTA_END(8); PTA_BEGIN(9);
        __syncthreads();
        PTA_END(9);
        PTA_BEGIN(6);
        { const int cp = tid & 63, tg = tid >> 6;
#pragma unroll
          for (int part = 0; part < 3; ++part) { LAS bf16* T = (part == 0 ? Qt_ : Kt_) + tg * 8 * 136 + 2 * cp; const LAS bf16* R = RAW + tg * 8 * 384 + part * 128 + 2 * cp;
              const f32x2 c0 = cw[part][0], c1 = cw[part][1], c2 = cw[part][2], c3 = cw[part][3];
              unsigned w0 = *(const LAS unsigned*)R, w1 = *(const LAS unsigned*)(R + 384), w2 = *(const LAS unsigned*)(R + 768);
              f32x2 x0 = {bflo(w0), bfhi(w0)}, x1 = {bflo(w1), bfhi(w1)}, x2 = {bflo(w2), bfhi(w2)}; f32x2 ys[8];
#pragma unroll
              for (int i = 0; i < 8; ++i) { const unsigned w3 = *(const LAS unsigned*)(R + (i + 3) * 384); const f32x2 x3 = {bflo(w3), bfhi(w3)};
                  const f32x2 a = c0 * x0 + c1 * x1 + c2 * x2 + c3 * x3;
                  const f32x2 e = a * (-1.4426950408889634f); f32x2 dn; dn.x = __builtin_amdgcn_exp2f(e.x); dn.y = __builtin_amdgcn_exp2f(e.y); dn = dn + 1.0f;
                  f32x2 rc; rc.x = __builtin_amdgcn_rcpf(dn.x); rc.y = __builtin_amdgcn_rcpf(dn.y); ys[i] = a * rc;
                  if (part < 2) *(LAS unsigned*)(T + i * 136) = pk2(ys[i].x, ys[i].y);
                  x0 = x1; x1 = x2; x2 = x3; }
              if (part > 0) { LAS bf16* TT = (part == 1 ? KTr_ : VT_) + (2 * cp) * 72 + tg * 8;
                  u32x4 ta, tb; ta.x = pk2(ys[0].x, ys[1].x); ta.y = pk2(ys[2].x, ys[3].x); ta.z = pk2(ys[4].x, ys[5].x); ta.w = pk2(ys[6].x, ys[7].x);
                  tb.x = pk2(ys[0].y, ys[1].y); tb.y = pk2(ys[2].y, ys[3].y); tb.z = pk2(ys[4].y, ys[5].y); tb.w = pk2(ys[6].y, ys[7].y);
                  *(LAS u32x4*)TT = ta; *(LAS u32x4*)(TT + 72) = tb; }
              asm volatile("" ::: "memory"); } }
        PTA_END(6); PTA_BEGIN(7);
        __syncthreads();
        PTA_END(7);
        PTA_END(0); PTA_BEGIN(1);
        { const int mt = w >> 1;
          bf16x8 kA[4], qA[4];
#pragma unroll
          for (int ks = 0; ks < 4; ++ks) { kA[ks] = *(const LAS bf16x8*)(Kt_ + (16 * mt + fr) * 136 + 32 * ks + 8 * fq); qA[ks] = *(const LAS bf16x8*)(Qt_ + (16 * mt + fr) * 136 + 32 * ks + 8 * fq); }
          f32x4 aK[2], aQ[2];
#pragma unroll
          for (int t2 = 0; t2 < 2; ++t2) { const int nt = 2 * (w & 1) + t2; aK[t2] = (f32x4){0.f, 0.f, 0.f, 0.f}; aQ[t2] = aK[t2];
#pragma unroll
              for (int ks = 0; ks < 4; ++ks) { const bf16x8 kB = *(const LAS bf16x8*)(Kt_ + (16 * nt + fr) * 136 + 32 * ks + 8 * fq);
                  aK[t2] = __builtin_amdgcn_mfma_f32_16x16x32_bf16(kA[ks], kB, aK[t2], 0, 0, 0); aQ[t2] = __builtin_amdgcn_mfma_f32_16x16x32_bf16(qA[ks], kB, aQ[t2], 0, 0, 0); } }
          if ((w & 1) == (w >> 2)) {
              f32x4 aQQ = {0.f, 0.f, 0.f, 0.f};
#pragma unroll
              for (int ks = 0; ks < 4; ++ks) aQQ = __builtin_amdgcn_mfma_f32_16x16x32_bf16(qA[ks], qA[ks], aQQ, 0, 0, 0);
              const f32x4 dK = (mt & 1) ? aK[1] : aK[0]; const int rg = fr & 3;
              const float k2 = rg == 0 ? dK[0] : rg == 1 ? dK[1] : rg == 2 ? dK[2] : dK[3], q2 = rg == 0 ? aQQ[0] : rg == 1 ? aQQ[1] : rg == 2 ? aQQ[2] : aQQ[3];
              if ((fr >> 2) == fq) { RK_[16 * mt + fr] = rsqrtf(k2 + EPS); RQ_[16 * mt + fr] = rsqrtf(q2 + EPS); } }
          __syncthreads();
          if (tid < 128) { const int d = tid >> 6, p = tid & 63, i = d ? 63 - p : p; const float rk = RK_[i]; BEG_[d * 64 + p] *= rk; RKD_[d * 64 + p] = rk * __expf(GC_[d * 64 + 63] - GC_[d * 64 + p]); }
#pragma unroll
          for (int t2 = 0; t2 < 2; ++t2) { const int nt = 2 * (w & 1) + t2;
              const int j = 16 * nt + fr, q1 = 63 - j; const float g0j = GC_[j], g1q = GC_[64 + q1], rkj = RK_[j];
#pragma unroll
              for (int rg = 0; rg < 4; ++rg) { const int i = 16 * mt + 4 * fq + rg, p1 = 63 - i;
                  const float e0 = i >= j ? __expf(GC_[i] - g0j) : 0.f, e1 = i <= j ? __expf(GC_[64 + p1] - g1q) : 0.f;
                  const float kk = aK[t2][rg] * RK_[i] * rkj;
                  if (i > j) L_[i * 64 + j] = BE_[i] * kk * e0;
                  if (i < j) L_[4096 + p1 * 64 + q1] = BE_[64 + p1] * kk * e1;
                  const float y = aQ[t2][rg] * RQ_[i] * rkj * 0.08838834764831845f;
                  IN_[i * 72 + j] = (bf16)f2bf(y * e0); IN_[64 * 72 + p1 * 72 + q1] = (bf16)f2bf(y * e1); } }
        }
        __syncthreads();
        {
#pragma unroll
          for (int r = 0; r < 2; ++r) { const int pc = tid + 512 * r, d = pc >> 9, blk = (pc >> 6) & 7, l = pc & 63, row = 16 * (blk >> 1) + (l & 15), cc = 4 * (blk & 1) + (l >> 4);
              *(u32x4*)(F_INTRA + (item0 + d) * 4096 + (size_t)(pc & 511) * 8) = *(const LAS u32x4*)(IN_ + d * 64 * 72 + row * 72 + cc * 8); } }
        if (tid < 128) { const int d = tid >> 6, p = tid & 63, i = d ? 63 - p : p; const float eg = __expf(GC_[d * 64 + p]);
            F_GSC[(item0 + d) * 128 + p] = 0.08838834764831845f * eg * RQ_[i];
            if (p == 63) F_GSC[(item0 + d) * 128 + 64] = eg; }
        PTA_END(1); PTA_BEGIN(2);
        if (w < 2) {
            const int d = w, c = lane, hi = c >> 5, cl = c & 31; const LAS float* Ld = L_ + d * 4096;
            LAS bf16* SA = (LAS bf16*)(F.lds + 125696 + d * 7168);
            LAS float* SM = (LAS float*)(F.lds + 125696 + d * 7168 + 2560);
            float xa[32];
#pragma unroll
            for (int p = 0; p < 32; ++p) xa[p] = (p == cl) ? 1.0f : 0.0f;
            gdn_solve32(Ld + hi * (32 * 64 + 32), xa);
            if (!hi) {
#pragma unroll
                for (int p8 = 0; p8 < 4; ++p8) { u32x4 o; o.x = pk2(xa[8 * p8], xa[8 * p8 + 1]); o.y = pk2(xa[8 * p8 + 2], xa[8 * p8 + 3]); o.z = pk2(xa[8 * p8 + 4], xa[8 * p8 + 5]); o.w = pk2(xa[8 * p8 + 6], xa[8 * p8 + 7]);
                    *(LAS u32x4*)(SA + cl * 40 + 8 * p8) = o; } }
            WAVE_LDS_FENCE();
#pragma unroll
            for (int mt = 0; mt < 2; ++mt) {
                const f32x4 la = *(const LAS f32x4*)(Ld + (32 + 16 * mt + fr) * 64 + 8 * fq), lb = *(const LAS f32x4*)(Ld + (32 + 16 * mt + fr) * 64 + 8 * fq + 4);
                u32x4 aw; aw.x = pk2(la.x, la.y); aw.y = pk2(la.z, la.w); aw.z = pk2(lb.x, lb.y); aw.w = pk2(lb.z, lb.w); const bf16x8 af = __builtin_bit_cast(bf16x8, aw);
#pragma unroll
                for (int nt = 0; nt < 2; ++nt) { const bf16x8 bfm = *(const LAS bf16x8*)(SA + (16 * nt + fr) * 40 + 8 * fq);
                    const f32x4 m = __builtin_amdgcn_mfma_f32_16x16x32_bf16(af, bfm, (f32x4){0.f, 0.f, 0.f, 0.f}, 0, 0, 0);
                    *(LAS f32x4*)(SM + (16 * nt + fr) * 36 + 16 * mt + 4 * fq) = m; } }
            WAVE_LDS_FENCE();
            float xb[32];
#pragma unroll
            for (int p4 = 0; p4 < 8; ++p4) { const f32x4 m = *(const LAS f32x4*)(SM + cl * 36 + 4 * p4); xb[4 * p4] = hi ? 0.f : -m.x; xb[4 * p4 + 1] = hi ? 0.f : -m.y; xb[4 * p4 + 2] = hi ? 0.f : -m.z; xb[4 * p4 + 3] = hi ? 0.f : -m.w; }
            gdn_solve32(Ld + 32 * 64 + 32, xb);
            asm volatile("s_waitcnt lgkmcnt(0)" ::: "memory");
            { LAS bf16* TAu = (LAS bf16*)(F.lds + d * 16384); LAS bf16* TAw = TAu + 4096; const int ic = d ? 63 - c : c; const float bu = BE_[d * 64 + c], bw = BEG_[d * 64 + c];
#pragma unroll
              for (int p = 0; p < 32; ++p) { const float top = hi ? 0.f : xa[p], bot = hi ? xa[p] : xb[p];
                  TAu[p * 64 + ic] = (bf16)f2bf(top * bu); TAw[p * 64 + ic] = (bf16)f2bf(top * bw); TAu[(32 + p) * 64 + ic] = (bf16)f2bf(bot * bu); TAw[(32 + p) * 64 + ic] = (bf16)f2bf(bot * bw); } }
        } else {
            const int t2 = tid - 128;
#pragma unroll
            for (int k = 0; k < 6; ++k) { const int id = t2 + 384 * k;
                if (id < 2048) { const int d = id >> 10, blk = (id >> 6) & 15, l = id & 63, dk = 16 * (blk >> 1) + (l & 15), p0 = 32 * (blk & 1) + 8 * (l >> 4);
                    const u32x4 kv = *(const LAS u32x4*)(KTr_ + dk * 72 + (d ? 56 - p0 : p0));
                    const float k0 = bflo(kv.x), k1 = bfhi(kv.x), k2 = bflo(kv.y), k3 = bfhi(kv.y), k4 = bflo(kv.z), k5 = bfhi(kv.z), k6 = bflo(kv.w), k7 = bfhi(kv.w);
                    const LAS float* sc = RKD_ + d * 64 + p0; u32x4 o;
                    if (d == 0) { o.x = pk2(k0 * sc[0], k1 * sc[1]); o.y = pk2(k2 * sc[2], k3 * sc[3]); o.z = pk2(k4 * sc[4], k5 * sc[5]); o.w = pk2(k6 * sc[6], k7 * sc[7]); }
                    else        { o.x = pk2(k7 * sc[0], k6 * sc[1]); o.y = pk2(k5 * sc[2], k4 * sc[3]); o.z = pk2(k3 * sc[4], k2 * sc[5]); o.w = pk2(k1 * sc[6], k0 * sc[7]); }
                    *(u32x4*)(F_KT + (item0 + d) * 8192 + (size_t)(id & 1023) * 8) = o; } }
#pragma unroll
            for (int k = 0; k < 3; ++k) { const int id = t2 + 384 * k;
                if (id < 1024) { const int blk = id >> 6, l = id & 63, row = 16 * (blk >> 2) + (l & 15), c0 = 32 * (blk & 3) + 4 * (l >> 4);
                    const u32x2 lo = *(const LAS u32x2*)(Qt_ + row * 136 + c0), hi = *(const LAS u32x2*)(Qt_ + row * 136 + c0 + 16);
                    *(u32x4*)(F_QC + (size_t)it * 8192 + (size_t)id * 8) = (u32x4){lo.x, lo.y, hi.x, hi.y}; } }
        }
        PTA_END(2); PTA_BEGIN(3);
        __syncthreads();
        { const int d = w >> 2, pt = w & 3; const LAS bf16* TAu = (const LAS bf16*)(F.lds + d * 16384); const LAS bf16* TAw = TAu + 4096;
          bf16x8 au[2], bw[2];
#pragma unroll
          for (int kk = 0; kk < 2; ++kk) { au[kk] = *(const LAS bf16x8*)(TAu + (16 * pt + fr) * 64 + 32 * kk + 8 * fq); bw[kk] = *(const LAS bf16x8*)(TAw + (16 * pt + fr) * 64 + 32 * kk + 8 * fq); }
#pragma unroll
          for (int nt = 0; nt < 8; ++nt) { f32x4 acc = {0.f, 0.f, 0.f, 0.f};
#pragma unroll
              for (int kk = 0; kk < 2; ++kk) acc = __builtin_amdgcn_mfma_f32_16x16x32_bf16(au[kk], *(const LAS bf16x8*)(VT_ + (16 * nt + fr) * 72 + 32 * kk + 8 * fq), acc, 0, 0, 0);
              u32x2 o; o.x = pk2(acc[0], acc[1]); o.y = pk2(acc[2], acc[3]); *(u32x2*)(F_UT + (item0 + d) * 8192 + (size_t)((nt * 4 + pt) * 64 + lane) * 4) = o; }
#pragma unroll
          for (int ks = 0; ks < 4; ++ks) { f32x4 a0 = {0.f, 0.f, 0.f, 0.f}, a1 = a0;
#pragma unroll
              for (int kk = 0; kk < 2; ++kk) { a0 = __builtin_amdgcn_mfma_f32_16x16x32_bf16(*(const LAS bf16x8*)(KTr_ + (32 * ks + fr) * 72 + 32 * kk + 8 * fq), bw[kk], a0, 0, 0, 0);
                  a1 = __builtin_amdgcn_mfma_f32_16x16x32_bf16(*(const LAS bf16x8*)(KTr_ + (32 * ks + 16 + fr) * 72 + 32 * kk + 8 * fq), bw[kk], a1, 0, 0, 0); }
              u32x4 o; o.x = pk2(a0[0], a0[1]); o.y = pk2(a0[2], a0[3]); o.z = pk2(a1[0], a1[1]); o.w = pk2(a1[2], a1[3]);
              *(u32x4*)(F_W + (item0 + d) * 8192 + (size_t)((pt * 4 + ks) * 64 + lane) * 8) = o; } }
        PTA_END(3);
    }
#undef GDN_LOADRAW
}
template <int DVS>
__device__ __forceinline__ void gdn_seq_chunked(const Frame& F, int item, const int VARIANT) {
    constexpr int NT = DVS / 16, NTW = NT / 2, NSL = 128 / DVS;
    const int sl = item % NSL, d = (item / NSL) & 1, h = (item / (2 * NSL)) & 15, b = item / (32 * NSL);
    LAS bf16* St = (LAS bf16*)(F.lds);
    LAS bf16* Vt = (LAS bf16*)(F.lds + DVS * 272);
    int tz = F.tid; asm volatile("" : "+v"(tz));
    const int tid = tz, lane = tz & 63, w = F.wave, fr = lane & 15, fq = lane >> 4;
    const int mt = w & 3, nt0 = (w >> 2) * NTW;
    for (int e = tid; e < DVS * 136 / 2; e += 512) ((LAS unsigned*)St)[e] = 0u;
    f32x4 S[NT];
#pragma unroll
    for (int n = 0; n < NT; ++n) S[n] = (f32x4){0.f, 0.f, 0.f, 0.f};
    const bf16* Qb = F_QC + (size_t)(b * NH + h) * NCH * 8192;
    bf16* Ob = (bf16*)F_O + (size_t)(b * NH + h) * 128 * 2 * 8192 + (size_t)d * 8192 + sl * DVS + 16 * nt0 + 4 * fq;
    struct Stg { bf16x8 wf[4], qf[4], inf[2], ktf[2]; u32x2 utv[NTW]; float sq1; float gl; };
#define GDN_LOADC(G, step) do { const int c_ = d == 0 ? (step) : ((step) < 4 ? 3 - (step) : NCH - 1 - ((step) - 4)); const size_t it_ = gdn_item(b, h, c_, d); \
        const int qoff_ = d ? ((3 - mt) * 4 * 64 + fq * 16 + 15 - fr) * 8 : (mt * 4 * 64 + lane) * 8;     \
        _Pragma("unroll") for (int ks = 0; ks < 4; ++ks) { G.wf[ks] = *(const bf16x8*)(F_W + it_ * 8192 + ((mt * 4 + ks) * 64 + lane) * 8); G.qf[ks] = *(const bf16x8*)(Qb + (size_t)c_ * 8192 + qoff_ + ks * 512); } \
        _Pragma("unroll") for (int ks = 0; ks < 2; ++ks) { G.inf[ks] = *(const bf16x8*)(F_INTRA + it_ * 4096 + ((mt * 2 + ks) * 64 + lane) * 8); G.ktf[ks] = *(const bf16x8*)(F_KT + it_ * 8192 + ((w * 2 + ks) * 64 + lane) * 8); } \
        _Pragma("unroll") for (int n = 0; n < NTW; ++n) G.utv[n] = *(const u32x2*)(F_UT + it_ * 8192 + (((DVS / 16) * sl + nt0 + n) * 4 + mt) * 256 + lane * 4); \
        G.sq1 = F_GSC[it_ * 128 + 16 * mt + fr]; G.gl = F_GSC[it_ * 128 + 64]; } while (0)
#define GDN_STEP(G, step) do { const int c = d == 0 ? (step) : ((step) < 4 ? 3 - (step) : NCH - 1 - ((step) - 4)); \
        f32x4 o[NTW]; \
        _Pragma("unroll") for (int n = 0; n < NTW; ++n) { f32x4 aW = {0.f, 0.f, 0.f, 0.f}, aQ = aW; \
            _Pragma("unroll") for (int ks = 0; ks < 4; ++ks) { const bf16x8 bS = *(const LAS bf16x8*)(St + (16 * (nt0 + n) + fr) * 136 + 32 * ks + 8 * fq); \
                aW = __builtin_amdgcn_mfma_f32_16x16x32_bf16(G.wf[ks], bS, aW, 0, 0, 0); aQ = __builtin_amdgcn_mfma_f32_16x16x32_bf16(bS, G.qf[ks], aQ, 0, 0, 0); }     \
            const float v0 = bflo(G.utv[n].x) - aW[0], v1 = bfhi(G.utv[n].x) - aW[1], v2 = bflo(G.utv[n].y) - aW[2], v3 = bfhi(G.utv[n].y) - aW[3]; \
            u32x2 vn; vn.x = pk2(v0, v1); vn.y = pk2(v2, v3); *(LAS u32x2*)(Vt + (16 * (nt0 + n) + fr) * 72 + 16 * mt + 4 * fq) = vn; \
            o[n] = aQ * G.sq1; } \
        __syncthreads(); \
        _Pragma("unroll") for (int n = 0; n < NTW; ++n) { const bf16x8 b0 = *(const LAS bf16x8*)(Vt + (16 * (nt0 + n) + fr) * 72 + 8 * fq), b1 = *(const LAS bf16x8*)(Vt + (16 * (nt0 + n) + fr) * 72 + 32 + 8 * fq); \
            o[n] = __builtin_amdgcn_mfma_f32_16x16x32_bf16(b0, G.inf[0], o[n], 0, 0, 0); o[n] = __builtin_amdgcn_mfma_f32_16x16x32_bf16(b1, G.inf[1], o[n], 0, 0, 0); }     \
        _Pragma("unroll") for (int n = 0; n < NT; ++n) { const bf16x8 b0 = *(const LAS bf16x8*)(Vt + (16 * n + fr) * 72 + 8 * fq), b1 = *(const LAS bf16x8*)(Vt + (16 * n + fr) * 72 + 32 + 8 * fq); \
            S[n] = S[n] * G.gl; \
            S[n] = __builtin_amdgcn_mfma_f32_16x16x32_bf16(G.ktf[0], b0, S[n], 0, 0, 0); S[n] = __builtin_amdgcn_mfma_f32_16x16x32_bf16(G.ktf[1], b1, S[n], 0, 0, 0); \
            u32x2 s0; s0.x = pk2(S[n][0], S[n][1]); s0.y = pk2(S[n][2], S[n][3]); *(LAS u32x2*)(St + (16 * n + fr) * 136 + 32 * (w >> 1) + 8 * fq + 4 * (w & 1)) = s0; }     \
        if (c >= 4 && VARIANT == 0) { _Pragma("unroll") for (int n = 0; n < NTW; ++n) { u32x2 ow; ow.x = pk2(o[n][0], o[n][1]); ow.y = pk2(o[n][2], o[n][3]); *(u32x2*)(Ob + (size_t)(c - 4) * 16384 + (16 * mt + fr) * 128 + 16 * n) = ow; } } \
        _Pragma("unroll") for (int n = 0; n < NTW; ++n) asm volatile("" :: "v"(o[n])); \
        __syncthreads(); } while (0)
    if constexpr (DVS <= 64) {
        Stg A, B, C;
        GDN_LOADC(A, 0); GDN_LOADC(B, 1);
        __syncthreads();
        static_assert(NCH % 6 == 0, "register pipelines of 2 and 3 stages");
        for (int step = 0; step < NCH; step += 3) {
            if (VARIANT != 1 || step == 0) GDN_LOADC(C, step + 2); GDN_STEP(A, step);
            if (VARIANT != 1 && step + 3 < NCH) GDN_LOADC(A, step + 3); GDN_STEP(B, step + 1);
            if (VARIANT != 1 && step + 4 < NCH) GDN_LOADC(B, step + 4); GDN_STEP(C, step + 2);
        }
    } else {
        Stg A, B;
        GDN_LOADC(A, 0);
        __syncthreads();
        for (int step = 0; step < NCH; step += 2) {
            if (VARIANT != 1 || step == 0) GDN_LOADC(B, step + 1); GDN_STEP(A, step);
            if (VARIANT != 1 && step + 2 < NCH) GDN_LOADC(A, step + 2); GDN_STEP(B, step + 1);
        }
    }
#undef GDN_STEP
#undef GDN_LOADC
}
#ifndef MK_N_LAUNCHES
#define MK_N_LAUNCHES 1
#endif
constexpr int N_PHASES = 13;
#ifndef GEMM4_WGM
#define GEMM4_WGM 8
#endif
#ifndef GDN_DVS
#define GDN_DVS 64
#endif
#ifndef LATE_A1
#define LATE_A1 27000
#endif
__global__ void __launch_bounds__(512, 2) fwd(Args args) {
    extern __shared__ __attribute__((aligned(16))) unsigned char lds[];
    Frame F;
    F.lds = (LAS unsigned char*)lds;
    F.tid = threadIdx.x; F.lane = F.tid & 63; F.wave = __builtin_amdgcn_readfirstlane(F.tid >> 6);
    F.G = gridDim.x; { const int bx = blockIdx.x; F.vcu = (F.G % 8 == 0) ? (bx % 8) * (F.G / 8) + bx / 8 : bx; }
    F.in = args.in; F.out = args.out; F.ws = args.ws; F.pta = nullptr;
    unsigned char* ws = args.ws;
    volatile LAS unsigned* MISC = (volatile LAS unsigned*)(F.lds + MISC_OFF);
    if (F.tid < 64) MISC[F.tid] = 0u;
    __syncthreads();
    const int lo = args.ph_lo, hi = args.ph_hi;
    XcdBarrier bar; bar.bar = (unsigned*)(ws + WS_CTL) + CW_BAR; bar.x = 0; bar.st = nullptr;
    if (hi - lo > 1) bar = xcd_barrier_post((unsigned*)(ws + WS_CTL) + CW_BAR, MISC + 8);
#ifndef PH_MASK
#define PH_MASK 0x1fff
#endif
#define IN(k) (((PH_MASK >> (k)) & 1) && lo <= (k) && (k) < hi)
#define SEAM(k) do { if (IN(k) && IN((k) + 1)) xcd_barrier(bar); } while (0)
#ifdef PROBE_TIME_PHASE
    unsigned long long pt_t0 = 0, pt_dt = 0; F.pta = &pt_dt;
#define PT_BEGIN(k) do { if ((k) == PROBE_TIME_PHASE) pt_t0 = __builtin_amdgcn_s_memrealtime(); } while (0)
#define PT_END(k) do { if ((k) == PROBE_TIME_PHASE) pt_dt = __builtin_amdgcn_s_memrealtime() - pt_t0; } while (0)
#else
#define PT_BEGIN(k) do { } while (0)
#define PT_END(k) do { } while (0)
#endif
    constexpr int G1_REM = ((MT / 256) * (NINP / 256)) % 256, G3_REM = ((ML / 256) * (2 * DFF / 256)) % 256;
    const bool late = F.G == 256;
    if (IN(0)) { PT_BEGIN(0); ph0_prologue(F, late ? LATE_A1 : 0); if (!late) wprep_late<1>(F, 0, IT_D, F.vcu, F.G); PT_END(0); } SEAM(0);
    if (IN(1)) { PT_BEGIN(1); ph1_modreduce(F); PT_END(1); } SEAM(1);
    if (IN(2)) { PT_BEGIN(2); ph2_hrows(F); PT_END(2); } SEAM(2);
    if (IN(3)) { PT_BEGIN(3); pg8::Gemm g{F_H, F_Wt_in, MT, NINP, DM}; pg8::StaticOrder S; S.init(MT, NINP, F.G, (int)blockIdx.x);
        pg8::EpiProj E{F_LX, F_LG, F_QKV, F_Z, F_BA};
        pg8::gemm_phase<pg8::EpiProj, pg8::StaticOrder, true, true>(F.lds, g, S, E);
        if (late && (int)blockIdx.x >= G1_REM) wprep_late<0>(F, 0, LATE_A1, (int)blockIdx.x - G1_REM, 256 - G1_REM); PT_END(3); } SEAM(3);
    if (IN(4)) { PT_BEGIN(4); lru_pass<1>(F, F.vcu, F.G); gdn_chunk_pre(F, F.G - 1 - F.vcu); PT_END(4); } if (IN(4) && IN(6)) xcd_barrier(bar);
    constexpr int SEQ_STRIDE = GDN_DVS / 32;
    if (IN(6)) { PT_BEGIN(6);
        if (SEQ_STRIDE == 1 || F.G != 256) { for (int item = F.vcu; item < 8192 / GDN_DVS; item += F.G) gdn_seq_chunked<GDN_DVS>(F, item, 0); lru_chains_block(F, F.vcu & 15); lru_pass<2>(F, F.vcu, F.G); }
        else if ((F.vcu % SEQ_STRIDE) == 0) gdn_seq_chunked<GDN_DVS>(F, F.vcu / SEQ_STRIDE, 0);
        else { const int oi = (F.vcu / SEQ_STRIDE) * (SEQ_STRIDE - 1) + (F.vcu % SEQ_STRIDE) - 1; lru_chains_block(F, oi & 15); lru_pass<2>(F, oi, 256 - 256 / SEQ_STRIDE); }
        PT_END(6); } SEAM(6);
    if (IN(7)) { PT_BEGIN(7); mix_finish(F); PT_END(7); } SEAM(7);
    if (IN(8)) { PT_BEGIN(8); pg8::Gemm g{F_MIX, F_Wt_out, ML, DM, DM}; pg8::StaticOrder S; S.init(ML, DM, F.G, (int)blockIdx.x);
        pg8::EpiBf16 E{F_Y1, DM};
        pg8::gemm_phase<pg8::EpiBf16, pg8::StaticOrder, true, true, false, true>(F.lds, g, S, E, F_RSL); PT_END(8); } SEAM(8);
    if (IN(9)) { PT_BEGIN(9); ph_x1(F); PT_END(9); } SEAM(9);
    if (IN(10)) { PT_BEGIN(10); pg8::Gemm g{F_H2, F_Wt_gu, ML, 2 * DFF, DM}; pg8::StaticOrder S; S.init(ML, 2 * DFF, F.G, (int)blockIdx.x);
        pg8::EpiSwiGLU E{F_ACT, DFF};
        pg8::gemm_phase<pg8::EpiSwiGLU, pg8::StaticOrder, true, true>(F.lds, g, S, E);
        if (late && (int)blockIdx.x >= G3_REM) wprep_late<1>(F, 0, IT_D, (int)blockIdx.x - G3_REM, 256 - G3_REM); PT_END(10); } SEAM(10);
    if (IN(11)) { PT_BEGIN(11); pg8::Gemm g{F_ACT, F_Wt_dn, ML, DM, DFF}; pg8::StaticOrder S; S.init(ML, DM, F.G, (int)blockIdx.x, GEMM4_WGM);
        pg8::EpiBf16 E{F_Y2, DM};
        pg8::gemm_phase<pg8::EpiBf16, pg8::StaticOrder, true, true, true>(F.lds, g, S, E); PT_END(11); } SEAM(11);
    if (IN(12)) { PT_BEGIN(12); ph_final(F); PT_END(12); }
#ifdef PROBE_TIME_PHASE
#ifndef PROBE_BLOCK
#define PROBE_BLOCK 0
#endif
    if (blockIdx.x == PROBE_BLOCK) { const unsigned long long t1 = __builtin_amdgcn_s_memrealtime(); while (__builtin_amdgcn_s_memrealtime() - t1 < pt_dt * PROBE_TIME_MULT) __builtin_amdgcn_s_sleep(8); }
#endif
#undef IN
#undef SEAM
}

extern "C" void kernel_launch(void* const* d_in, const int* in_sizes, int n_in, void* d_out, int out_size, void* d_ws, size_t ws_size, hipStream_t stream) {
    static int grid = 0;
    if (grid == 0) {
        if (n_in != N_INPUTS || in_sizes[0] != ML * DM || out_size != ML * DM || ws_size < WS_END) { fprintf(stderr, "kernel_launch: unexpected problem shape (n_in %d, in0 %d, out %d, ws %zu): nothing launched\n", n_in, n_in > 0 ? in_sizes[0] : -1, out_size, ws_size); grid = -1; return; }
        int dev = 0, cus = 0;
        if (hipGetDevice(&dev) != hipSuccess || hipDeviceGetAttribute(&cus, hipDeviceAttributeMultiprocessorCount, dev) != hipSuccess) { grid = -1; return; }
        if (hipFuncSetAttribute((const void*)fwd, hipFuncAttributeMaxDynamicSharedMemorySize, LDS_BYTES) != hipSuccess) { fprintf(stderr, "kernel_launch: hipFuncSetAttribute failed\n"); grid = -1; return; }
        (void)hipGetLastError();
        grid = cus >= 256 ? 256 : (cus / 16) * 16;
        if (grid < 16) { grid = -1; return; }
    }
    if (grid < 0) return;
    (void)hipMemsetAsync((char*)d_ws + WS_CTL, 0, CTL_ZERO_BYTES, stream);
    Args a{};
    for (int i = 0; i < N_INPUTS; ++i) a.in[i] = (const float*)d_in[i];
    a.out = (float*)d_out; a.ws = (unsigned char*)d_ws;
#if MK_N_LAUNCHES == 1
    a.ph_lo = 0; a.ph_hi = N_PHASES;
    hipLaunchKernelGGL(fwd, dim3(grid), dim3(512), LDS_BYTES, stream, a);
#else
#ifndef PROBE_REPEAT_MASK
#define PROBE_REPEAT_MASK 0
#endif
    for (int p = 0; p < N_PHASES; ++p) { a.ph_lo = p; a.ph_hi = p + 1; hipLaunchKernelGGL(fwd, dim3(grid), dim3(512), LDS_BYTES, stream, a);
        if ((PROBE_REPEAT_MASK >> p) & 1) hipLaunchKernelGGL(fwd, dim3(grid), dim3(512), LDS_BYTES, stream, a); }
#endif
}
```

```cpp
#include <hip/hip_runtime.h>
#include <cstdio>
#include <cstdint>
namespace pg8 {
#define PG8_LAS __attribute__((address_space(3)))
typedef unsigned short bf16_t;
typedef short bf16x8 __attribute__((ext_vector_type(8)));
typedef float f32x4 __attribute__((ext_vector_type(4)));
typedef unsigned u32x4 __attribute__((ext_vector_type(4)));
constexpr int BM = 256, BK = 64, HALF = 128, HTB = HALF * BK * 2  , STAGE_BYTES = 8 * HTB, NXCD = 8, WGM = 8;

__host__ __device__ __forceinline__ int lds_byte(int r, int c) { const int st = (r >> 4) * 2 + (c >> 5), rr = r & 15, cc = c & 31, ob = rr * 64 + cc * 2; return st * 1024 + (ob ^ (((ob >> 9) & 1) << 5)); }
__host__ __device__ __forceinline__ void stage_rc(int b, int& R, int& C) { const int st = b / 1024, sb = b % 1024, swz = sb ^ (((sb >> 9) & 1) << 5); R = (st >> 1) * 16 + swz / 64; C = (st & 1) * 32 + (swz % 64) / 2; }
__host__ __device__ __forceinline__ int perm32(int rho) { const int n = rho >> 4, i = rho & 15; return 8 * (i >> 2) + 4 * n + (i & 3); }

struct Unit { int pm, pn; };
struct Gemm { const bf16_t* A; const bf16_t* Bt; int M, N, K; };

struct StaticOrder {
    int nM, nN, nwg, G, c, wgm;
    __host__ __device__ void init(int M, int N, int G_, int c_, int wgm_ = WGM) { nM = M / BM; nN = N / BM; nwg = nM * nN; G = G_; c = c_; wgm = wgm_; }
    __host__ __device__ bool next(int i, Unit& u) const {
        const long L = (long)i * G + c; if (L >= nwg) return false;
        int wgid = (int)L; { const int q = nwg / NXCD, r = nwg % NXCD, xcd = wgid % NXCD, off = wgid / NXCD; wgid = (xcd < r ? xcd * (q + 1) : r * (q + 1) + (xcd - r) * q) + off; }
        const int nig = wgm * nN, gid = wgid / nig, fm = gid * wgm, gsz = (nM - fm) < wgm ? (nM - fm) : wgm;
        u.pm = fm + ((wgid % nig) % gsz); u.pn = (wgid % nig) / gsz; return true;
    }
    __device__ __forceinline__ void a_ready(const Unit&) const {}
    __device__ __forceinline__ void done(const Unit&) const {}
};
typedef __bf16 bf16x2_t __attribute__((ext_vector_type(2))); typedef float f32x2_t __attribute__((ext_vector_type(2)));
__device__ __forceinline__ unsigned cvt_pk_bf16(float lo, float hi) { const f32x2_t v = {lo, hi}; return __builtin_bit_cast(unsigned, __builtin_convertvector(v, bf16x2_t)); }
struct EpiF32 {
    static constexpr bool PERM = false, AFTER_DRAIN = false;
    float* C; int ldc;
    __device__ __forceinline__ void operator()(const f32x4 (&acc)[2][2][4][2], const Unit& u, int wr, int wc, int fr, int fq) const {
        const int row0 = u.pm * BM + wr * 64 + fr, col0 = u.pn * BM + wc * 32 + 4 * fq;
#pragma unroll
        for (int ai = 0; ai < 2; ++ai)
#pragma unroll
            for (int m = 0; m < 4; ++m) { float* rowp = C + (size_t)(row0 + ai * HALF + m * 16) * ldc + col0;
#pragma unroll
                for (int bj = 0; bj < 2; ++bj)
#pragma unroll
                    for (int n = 0; n < 2; ++n) *(f32x4*)(rowp + bj * HALF + n * 16) = acc[ai][bj][m][n]; }
    }
};
struct EpiProj {
    static constexpr bool PERM = true, AFTER_DRAIN = false;
    bf16_t *lx, *lg, *qkv, *z, *ba;
    __device__ __forceinline__ void operator()(const f32x4 (&acc)[2][2][4][2], const Unit& u, int wr, int wc, int fr, int fq) const {
        const int pn = u.pn; bf16_t* base; int ld, colt;
        if (pn < 8) { base = lx; ld = 2048; colt = pn * BM; }
        else if (pn < 16) { base = lg; ld = 2048; colt = (pn - 8) * BM; }
        else if (pn < 40) { base = qkv; ld = 6144; colt = (pn - 16) * BM; }
        else if (pn < 48) { base = z; ld = 2048; colt = (pn - 40) * BM; }
        else { base = ba; ld = 256; colt = 0; }
        const int row0 = u.pm * BM + wr * 64 + fr, col0 = colt + wc * 32 + 8 * fq;
#pragma unroll
        for (int ai = 0; ai < 2; ++ai)
#pragma unroll
            for (int m = 0; m < 4; ++m) { bf16_t* rowp = base + (size_t)(row0 + ai * HALF + m * 16) * ld + col0;
#pragma unroll
                for (int bj = 0; bj < 2; ++bj) { const f32x4 v0 = acc[ai][bj][m][0], v1 = acc[ai][bj][m][1];
                    u32x4 w; w.x = cvt_pk_bf16(v0[0], v0[1]); w.y = cvt_pk_bf16(v0[2], v0[3]); w.z = cvt_pk_bf16(v1[0], v1[1]); w.w = cvt_pk_bf16(v1[2], v1[3]);
                    *(u32x4*)(rowp + bj * HALF) = w; } }
    }
};
struct EpiBf16 {
    static constexpr bool PERM = true, AFTER_DRAIN = false;
    bf16_t* O; int ldc;
    __device__ __forceinline__ void operator()(const f32x4 (&acc)[2][2][4][2], const Unit& u, int wr, int wc, int fr, int fq) const {
        const int row0 = u.pm * BM + wr * 64 + fr, col0 = u.pn * BM + wc * 32 + 8 * fq;
#pragma unroll
        for (int ai = 0; ai < 2; ++ai)
#pragma unroll
            for (int m = 0; m < 4; ++m) { bf16_t* rowp = O + (size_t)(row0 + ai * HALF + m * 16) * ldc + col0;
#pragma unroll
                for (int bj = 0; bj < 2; ++bj) { const f32x4 v0 = acc[ai][bj][m][0], v1 = acc[ai][bj][m][1];
                    u32x4 w; w.x = cvt_pk_bf16(v0[0], v0[1]); w.y = cvt_pk_bf16(v0[2], v0[3]); w.z = cvt_pk_bf16(v1[0], v1[1]); w.w = cvt_pk_bf16(v1[2], v1[3]);
                    *(u32x4*)(rowp + bj * HALF) = w; } }
    }
};
struct EpiSwiGLU {
    static constexpr bool PERM = true, AFTER_DRAIN = false;
    bf16_t* O; int ldc;
    __device__ __forceinline__ void operator()(const f32x4 (&acc)[2][2][4][2], const Unit& u, int wr, int wc, int fr, int fq) const {
        const int row0 = u.pm * BM + wr * 64 + fr, col0 = u.pn * HALF + wc * 32 + 8 * fq;
#pragma unroll
        for (int ai = 0; ai < 2; ++ai)
#pragma unroll
            for (int m = 0; m < 4; ++m) { const int rr = wr * 64 + fr + ai * HALF + m * 16;
                bf16_t* rowp = O + ((size_t)u.pm * (ldc / 64) + (col0 >> 6)) * (size_t)(BM * 64) + rr * 64 + (col0 & 63);
                float r[8];
#pragma unroll
                for (int n = 0; n < 2; ++n)
#pragma unroll
                    for (int j = 0; j < 4; ++j) { const float g = acc[ai][0][m][n][j], up = acc[ai][1][m][n][j]; r[4 * n + j] = g * __builtin_amdgcn_rcpf(1.0f + __expf(-g)) * up; }
                u32x4 w; w.x = cvt_pk_bf16(r[0], r[1]); w.y = cvt_pk_bf16(r[2], r[3]); w.z = cvt_pk_bf16(r[4], r[5]); w.w = cvt_pk_bf16(r[6], r[7]);
                *(u32x4*)rowp = w; }
    }
};

template <class Epi, class Sched, bool ALIGN_EPI = false, bool SP2 = false, bool TILED = false, bool MIDSCALE = false>
__device__ __forceinline__ void gemm_phase(PG8_LAS unsigned char* lds, const Gemm g, const Sched& S, const Epi& E, const float* midscale = nullptr) {
    const int tid = threadIdx.x, wid = __builtin_amdgcn_readfirstlane(tid >> 6), lane = tid & 63, wr = wid >> 2, wc = wid & 3, fr = lane & 15, fq = lane >> 4;
    const int K = g.K, nt = K / BK;
    unsigned voffA[2], voffB[2];
#pragma unroll
    for (int i = 0; i < 2; ++i) { int R, C; stage_rc(tid * 16 + i * 8192, R, C); const int Rb = Epi::PERM ? ((R & ~31) + perm32(R & 31)) : R;
        voffA[i] = (unsigned)(R * (TILED ? BK : K) + C) * 2u; voffB[i] = (unsigned)(Rb * (TILED ? BK : K) + C) * 2u; }
    const size_t kstep = TILED ? (size_t)(BM * BK * 2) : (size_t)(BK * 2);
    const size_t hstep = TILED ? (size_t)(HALF * BK * 2) : (size_t)HALF * K * 2;
    const size_t tstep = (size_t)BM * K * 2;
    const unsigned ldsw = (unsigned)wid * 1024u;
    const int aoff = lds_byte(wr * 64 + fr, fq * 8), boff = lds_byte(wc * 32 + fr, fq * 8);
#define PG8_SA(b, h) (((b) * 2 + (h)) * HTB)
#define PG8_SB(b, h) ((4 + (b) * 2 + (h)) * HTB)
#define PG8_STAGE(bufoff, gbase, voff) do { _Pragma("unroll") for (int _i = 0; _i < 2; ++_i) \
        __builtin_amdgcn_global_load_lds((const unsigned*)((const char*)(gbase) + (voff)[_i]), (PG8_LAS unsigned*)(lds + (bufoff) + ldsw + _i * 8192), 16, 0, 0); } while (0)
#define PG8_LDA(dst, b, h) do { _Pragma("unroll") for (int m = 0; m < 4; ++m) _Pragma("unroll") for (int k = 0; k < 2; ++k) dst[m][k] = *(const PG8_LAS bf16x8*)(lds + PG8_SA(b, h) + aoff + m * 2048 + k * 1024); } while (0)
#define PG8_LDB(dst, b, h) do { _Pragma("unroll") for (int n = 0; n < 2; ++n) _Pragma("unroll") for (int k = 0; k < 2; ++k) dst[n][k] = *(const PG8_LAS bf16x8*)(lds + PG8_SB(b, h) + boff + n * 2048 + k * 1024); } while (0)
#define PG8_MMA(ai, bj, At, Bt) do { __builtin_amdgcn_s_setprio(1); _Pragma("unroll") for (int m = 0; m < 4; ++m) _Pragma("unroll") for (int n = 0; n < 2; ++n) _Pragma("unroll") for (int k = 0; k < 2; ++k) \
        acc[ai][bj][m][n] = __builtin_amdgcn_mfma_f32_16x16x32_bf16(Bt[n][k], At[m][k], acc[ai][bj][m][n], 0, 0, 0); __builtin_amdgcn_s_setprio(0); } while (0)
#define PG8_WAIT_V(n) asm volatile("s_waitcnt vmcnt(" #n ")" ::: "memory")
#define PG8_WAIT_L(n) asm volatile("s_waitcnt lgkmcnt(" #n ")" ::: "memory")
#define PG8_BAR __builtin_amdgcn_s_barrier()
#define PG8_SCHED __builtin_amdgcn_sched_barrier(0)
    Unit cur, nxt; int ui = 0;
    if (!S.next(0, cur)) return;
    f32x4 acc[2][2][4][2];
#pragma unroll
    for (int a = 0; a < 2; ++a)
#pragma unroll
        for (int b = 0; b < 2; ++b)
#pragma unroll
            for (int m = 0; m < 4; ++m)
#pragma unroll
                for (int n = 0; n < 2; ++n) acc[a][b][m][n] = (f32x4){0.f, 0.f, 0.f, 0.f};
    bf16x8 At[4][2], B0[2][2], B1[2][2];
    const char* cA = (const char*)g.A + (size_t)cur.pm * tstep; const char* cB = (const char*)g.Bt + (size_t)cur.pn * tstep;
    S.a_ready(cur);
    if constexpr (SP2) {
        PG8_STAGE(PG8_SB(0, 0), cB, voffB); PG8_STAGE(PG8_SB(0, 1), cB + hstep, voffB); PG8_STAGE(PG8_SA(0, 0), cA, voffA); PG8_STAGE(PG8_SA(0, 1), cA + hstep, voffA);
        if (wr == 1) PG8_BAR;
        PG8_WAIT_V(2); PG8_BAR;
        PG8_STAGE(PG8_SB(1, 0), cB + kstep, voffB); PG8_STAGE(PG8_SA(1, 0), cA + kstep, voffA); PG8_STAGE(PG8_SB(1, 1), cB + hstep + kstep, voffB);
        PG8_WAIT_V(6); PG8_BAR;
    } else {
        PG8_STAGE(PG8_SB(0, 0), cB, voffB); PG8_STAGE(PG8_SA(0, 0), cA, voffA); PG8_STAGE(PG8_SB(0, 1), cB + hstep, voffB); PG8_STAGE(PG8_SA(0, 1), cA + hstep, voffA);
        if (wr == 1) PG8_BAR;
        PG8_WAIT_V(4); PG8_BAR;
        PG8_STAGE(PG8_SB(1, 0), cB + kstep, voffB); PG8_STAGE(PG8_SA(1, 0), cA + kstep, voffA); PG8_STAGE(PG8_SB(1, 1), cB + hstep + kstep, voffB);
        PG8_WAIT_V(6); PG8_BAR;
    }
    for (;;) {
        const bool has_next = S.next(ui + 1, nxt);
        const char* nA = has_next ? (const char*)g.A + (size_t)nxt.pm * tstep : cA; const char* nB = has_next ? (const char*)g.Bt + (size_t)nxt.pn * tstep : cB;
        for (int t = 0; t < nt; t += 2) {
            if constexpr (MIDSCALE) { if (t == nt / 2) {
#pragma unroll
                for (int a = 0; a < 2; ++a)
#pragma unroll
                    for (int m = 0; m < 4; ++m) { const float sc = midscale[cur.pm * BM + a * HALF + wr * 64 + m * 16 + fr];
#pragma unroll
                        for (int bb = 0; bb < 2; ++bb)
#pragma unroll
                            for (int n = 0; n < 2; ++n) acc[a][bb][m][n] = acc[a][bb][m][n] * sc; } } }
            const bool last = (t == nt - 2);
            const char* a1 = cA + (size_t)(t + 1) * kstep;
            const char* a2 = last ? nA : cA + (size_t)(t + 2) * kstep; const char* b2 = last ? nB : cB + (size_t)(t + 2) * kstep;
            const char* a3 = a2 + kstep; const char* b3 = b2 + kstep;
            if (last && has_next) S.a_ready(nxt);
            if constexpr (SP2) {
            PG8_LDB(B0, 0, 0); PG8_LDB(B1, 0, 1); PG8_SCHED; PG8_LDA(At, 0, 0); PG8_STAGE(PG8_SA(1, 1), a1 + hstep, voffA);
            PG8_WAIT_V(8); PG8_WAIT_L(0); PG8_BAR; PG8_MMA(0, 0, At, B0); PG8_MMA(0, 1, At, B1); PG8_BAR; PG8_SCHED;
            PG8_LDA(At, 0, 1); PG8_STAGE(PG8_SB(0, 0), b2, voffB); PG8_STAGE(PG8_SB(0, 1), b2 + hstep, voffB); PG8_STAGE(PG8_SA(0, 0), a2, voffA);
            PG8_WAIT_V(8); PG8_WAIT_L(0); PG8_BAR; PG8_MMA(1, 0, At, B0); PG8_MMA(1, 1, At, B1); PG8_BAR; PG8_SCHED;
            PG8_LDB(B0, 1, 0); PG8_LDB(B1, 1, 1); PG8_SCHED; PG8_LDA(At, 1, 0); PG8_STAGE(PG8_SA(0, 1), a2 + hstep, voffA);
            PG8_WAIT_V(8); PG8_WAIT_L(0); PG8_BAR; PG8_MMA(0, 0, At, B0); PG8_MMA(0, 1, At, B1); PG8_BAR; PG8_SCHED;
            PG8_LDA(At, 1, 1); PG8_STAGE(PG8_SB(1, 0), b3, voffB); PG8_STAGE(PG8_SB(1, 1), b3 + hstep, voffB); PG8_STAGE(PG8_SA(1, 0), a3, voffA);
            PG8_WAIT_V(8); PG8_WAIT_L(0); PG8_BAR; PG8_MMA(1, 0, At, B0); PG8_MMA(1, 1, At, B1); PG8_BAR; PG8_SCHED;
            } else {
            PG8_LDB(B0, 0, 0); PG8_SCHED; PG8_LDA(At, 0, 0); PG8_STAGE(PG8_SA(1, 1), a1 + hstep, voffA);
            PG8_WAIT_L(8); PG8_BAR; PG8_WAIT_L(0); PG8_MMA(0, 0, At, B0); PG8_BAR; PG8_SCHED;
            PG8_LDB(B1, 0, 1); PG8_STAGE(PG8_SB(0, 0), b2, voffB);
            PG8_BAR; PG8_WAIT_L(0); PG8_MMA(0, 1, At, B1); PG8_BAR;
            PG8_LDA(At, 0, 1); PG8_STAGE(PG8_SA(0, 0), a2, voffA);
            PG8_BAR; PG8_WAIT_L(0); PG8_MMA(1, 0, At, B0); PG8_BAR; PG8_SCHED;
            PG8_STAGE(PG8_SB(0, 1), b2 + hstep, voffB);
            PG8_WAIT_V(6); PG8_BAR; PG8_MMA(1, 1, At, B1); PG8_BAR;
            PG8_LDB(B0, 1, 0); PG8_SCHED; PG8_LDA(At, 1, 0); PG8_STAGE(PG8_SA(0, 1), a2 + hstep, voffA);
            PG8_WAIT_L(8); PG8_BAR; PG8_WAIT_L(0); PG8_MMA(0, 0, At, B0); PG8_BAR; PG8_SCHED;
            PG8_LDB(B1, 1, 1); PG8_STAGE(PG8_SB(1, 0), b3, voffB);
            PG8_BAR; PG8_WAIT_L(0); PG8_MMA(0, 1, At, B1); PG8_BAR;
            PG8_LDA(At, 1, 1); PG8_STAGE(PG8_SA(1, 0), a3, voffA);
            PG8_BAR; PG8_WAIT_L(0); PG8_MMA(1, 0, At, B0); PG8_BAR; PG8_SCHED;
            PG8_STAGE(PG8_SB(1, 1), b3 + hstep, voffB);
            PG8_WAIT_V(6); PG8_BAR; PG8_MMA(1, 1, At, B1); PG8_BAR;
            }
        }
        if constexpr (ALIGN_EPI) { if (wr == 0) PG8_BAR; }
        if constexpr (!Epi::AFTER_DRAIN) { E(acc, cur, wr, wc, fr, fq); S.done(cur); }
        if (!has_next) break;
#pragma unroll
        for (int a = 0; a < 2; ++a)
#pragma unroll
            for (int b = 0; b < 2; ++b)
#pragma unroll
                for (int m = 0; m < 4; ++m)
#pragma unroll
                    for (int n = 0; n < 2; ++n) acc[a][b][m][n] = (f32x4){0.f, 0.f, 0.f, 0.f};
        cur = nxt; cA = nA; cB = nB; ++ui;
        if constexpr (ALIGN_EPI) { if (wr == 1) PG8_BAR; }
    }
    PG8_WAIT_V(0);
    if constexpr (!ALIGN_EPI) { if (wr == 0) PG8_BAR; }
    PG8_BAR;
    if constexpr (Epi::AFTER_DRAIN) { E.fused(acc, cur, wr, wc, fr, fq, lds, wid, lane); S.done(cur); }
#undef PG8_SA
#undef PG8_SB
#undef PG8_STAGE
#undef PG8_LDA
#undef PG8_LDB
#undef PG8_MMA
#undef PG8_WAIT_V
#undef PG8_WAIT_L
#undef PG8_BAR
#undef PG8_SCHED
}
}
constexpr int DM = 4096, NBATCH = 2, TL = 8192, TCX = 256, ML = NBATCH * TL, MC = NBATCH * TCX, MT = ML + MC;
constexpr int LW = 2048, GDW = 2048, NH = 16, HD = 128, DFF = 11008, NIN = 12352, NINP = 12544, NADA = 6 * DM;
constexpr int SEQ_S = TCX + TL;
constexpr int NCH = 132;
constexpr float EPS = 1e-6f;
enum { I_X = 0, I_C, I_CTX, I_CCTX, I_WADA, I_BADA, I_GPREMIX, I_GPOSTMIX, I_GPREFFN, I_GPOSTFFN, I_WIN, I_LCW, I_LCB, I_LWA, I_LBA, I_LWX, I_LBX, I_LLAM, I_LNG, I_GCW, I_GALOG, I_GDT, I_GNG, I_WOUT, I_WG, I_WU, I_WD, N_INPUTS };

constexpr size_t MiB = 1u << 20;
constexpr size_t WS_CTL = 0, CTL_ZERO_BYTES = 1 * MiB;
constexpr size_t WS_MODP = 1 * MiB, WS_MOD = 11 * MiB, WS_WL = 12 * MiB, WS_CAR = 14 * MiB, WS_HIN = 23 * MiB, WS_GB = 28 * MiB, WS_KQ = 33 * MiB, WS_SSQ = 35 * MiB;
constexpr size_t WS_WOUT = 44 * MiB, WS_WGU = 76 * MiB, WS_WDN = 248 * MiB;
constexpr size_t WS_R2 = 334 * MiB;
constexpr size_t WS_WIN = WS_R2, WS_H = WS_R2 + 98 * MiB;
constexpr size_t WS_QN = WS_R2, WS_KN = WS_R2 + 66 * MiB, WS_VN = WS_R2 + 132 * MiB;
constexpr size_t WS_H2 = WS_R2, WS_Y2 = WS_R2;
constexpr size_t WS_R3 = 590 * MiB;
constexpr size_t WS_LX = WS_R3, WS_LG = WS_R3 + 66 * MiB, WS_QKV = WS_R3 + 132 * MiB, WS_Z = WS_R3 + 330 * MiB, WS_BA = WS_R3 + 396 * MiB;
constexpr size_t WS_ACT = WS_R3;
constexpr size_t WS_MIX = 995 * MiB;
constexpr size_t WS_UT = 1123 * MiB, WS_W = 1255 * MiB, WS_INTRA = 1387 * MiB, WS_QC = 1453 * MiB, WS_END = 1519 * MiB;
constexpr size_t WS_KT = WS_R2, WS_GSC = 37 * MiB, WS_RSL = 42 * MiB;

constexpr size_t WS_Y1 = WS_UT, WS_Y2Y = WS_W;
static_assert(WS_SSQ + (size_t)ML * 16 * 4 <= WS_WOUT && WS_WOUT + (size_t)DM * DM * 2 <= WS_WGU && WS_WGU + (size_t)2 * DFF * DM * 2 <= WS_WDN && WS_WDN + (size_t)DM * DFF * 2 <= WS_R2, "ws map 1");
static_assert(WS_WIN + (size_t)NINP * DM * 2 <= WS_H && WS_H + (size_t)MT * DM * 2 <= WS_R3 && WS_VN + (size_t)NBATCH * SEQ_S * 2048 * 2 <= WS_R3 && WS_Y2 + (size_t)ML * DM * 4 <= WS_R3, "ws map 2");
static_assert((size_t)MT * 2048 * 2 <= 66 * MiB && (size_t)MT * 6144 * 2 <= 198 * MiB && WS_BA + (size_t)MT * 256 * 2 <= WS_MIX && WS_ACT + (size_t)ML * DFF * 2 <= WS_MIX && WS_MIX + (size_t)ML * DM * 2 <= WS_UT, "ws map 3");
static_assert((size_t)ML * DM * 2 <= 132 * MiB && (size_t)NBATCH * NH * NCH * 2 * 8192 * 2 == 132 * MiB && WS_KT + 132 * MiB <= WS_R3 && WS_GSC + (size_t)NBATCH * NH * NCH * 2 * 128 * 4 <= WS_WOUT && WS_SSQ + (size_t)ML * 16 * 4 <= WS_GSC, "ws map 4");
constexpr int CW_BAR = 4096;

constexpr int LDS_BYTES = 147456;
constexpr int MISC_OFF = LDS_BYTES - 256;

#define GAS __attribute__((address_space(1)))
#define LAS __attribute__((address_space(3)))
typedef unsigned short bf16;
typedef unsigned u32x4 __attribute__((ext_vector_type(4)));
typedef unsigned u32x2 __attribute__((ext_vector_type(2)));
typedef float f32x4 __attribute__((ext_vector_type(4)));
typedef float f32x2 __attribute__((ext_vector_type(2)));
typedef short bf16x8 __attribute__((ext_vector_type(8)));
#define LDS_WAIT() asm volatile("s_waitcnt lgkmcnt(0)" ::: "memory")
#define WAVE_LDS_FENCE() do { asm volatile("s_waitcnt lgkmcnt(0)" ::: "memory"); __builtin_amdgcn_wave_barrier(); } while (0)
typedef __bf16 bf16x2_t __attribute__((ext_vector_type(2)));
__device__ __forceinline__ unsigned pk2(float lo, float hi) { const f32x2 v = {lo, hi}; return __builtin_bit_cast(unsigned, __builtin_convertvector(v, bf16x2_t)); }
__device__ __forceinline__ unsigned f2bf(float f) { return pk2(f, 0.0f) & 0xffffu; }
__device__ __forceinline__ float bf2f(unsigned h) { return __builtin_bit_cast(float, h << 16); }
__device__ __forceinline__ float bflo(unsigned w) { return __builtin_bit_cast(float, w << 16); }
__device__ __forceinline__ float bfhi(unsigned w) { return __builtin_bit_cast(float, w & 0xffff0000u); }
__device__ __forceinline__ f32x4 ldg4(const float* base, unsigned off) { return *(const f32x4*)((const char*)base + off); }
__device__ __forceinline__ void stg4(float* base, unsigned off, f32x4 v) { *(f32x4*)((char*)base + off) = v; }
__device__ __forceinline__ void stg2u(void* base, unsigned off, u32x2 v) { *(u32x2*)((char*)base + off) = v; }
__device__ __forceinline__ float row16_sum(float v) {
    v += __builtin_bit_cast(float, __builtin_amdgcn_update_dpp(0, __builtin_bit_cast(int, v), 0x128, 0xf, 0xf, false));
    v += __builtin_bit_cast(float, __builtin_amdgcn_update_dpp(0, __builtin_bit_cast(int, v), 0x124, 0xf, 0xf, false));
    v += __builtin_bit_cast(float, __builtin_amdgcn_update_dpp(0, __builtin_bit_cast(int, v), 0x122, 0xf, 0xf, false));
    v += __builtin_bit_cast(float, __builtin_amdgcn_update_dpp(0, __builtin_bit_cast(int, v), 0x121, 0xf, 0xf, false));
    return v;
}
__device__ __forceinline__ float wave_sum(float v) {
    v = row16_sum(v);
    const int vi = __builtin_bit_cast(int, v);
    return (__builtin_bit_cast(float, __builtin_amdgcn_readlane(vi, 0)) + __builtin_bit_cast(float, __builtin_amdgcn_readlane(vi, 16))) + (__builtin_bit_cast(float, __builtin_amdgcn_readlane(vi, 32)) + __builtin_bit_cast(float, __builtin_amdgcn_readlane(vi, 48)));
}
__device__ __forceinline__ float sigmoidf_(float x) { return __builtin_amdgcn_rcpf(1.0f + __expf(-x)); }
__device__ __forceinline__ float siluf_(float x) { return x * sigmoidf_(x); }
__device__ __forceinline__ float softplusf_(float x) { return x > 20.f ? x : log1pf(__expf(x)); }
__device__ __forceinline__ float gelu_tanhf_(float x) { const float e = x * __builtin_fmaf(x * x, -0.10294324f, -2.3022082f); return x * __builtin_amdgcn_rcpf(__builtin_amdgcn_exp2f(e) + 1.0f); }
__device__ __forceinline__ float rdlane(float x, int l) { return __builtin_bit_cast(float, __builtin_amdgcn_readlane(__builtin_bit_cast(int, x), l)); }

#define XB_TMO      128
#define XB_XCNT(j)  (256  + 64 * (j))
#define XB_XSUB(j)  (1280 + 64 * (j))
#define XB_XGEN(j)  (2304 + 64 * (j))
#define XB_TOP      3328
#define XB_TOPGEN   3392
#define XCD_BAR_WORDS 3456
#define XB_SPIN_CAP (1u << 22)
__device__ __forceinline__ unsigned xb_ld(unsigned* p)              { return __hip_atomic_load(p, __ATOMIC_RELAXED, __HIP_MEMORY_SCOPE_AGENT); }
__device__ __forceinline__ unsigned xb_add(unsigned* p, unsigned v) { return __hip_atomic_fetch_add(p, v, __ATOMIC_RELAXED, __HIP_MEMORY_SCOPE_AGENT); }
__device__ __forceinline__ unsigned xb_xcc_id() { return (unsigned)__builtin_amdgcn_s_getreg((3 << 11) | 20) & 0xFu; }
#define XB_SPIN(cond, bar) do { unsigned _sp = 0; while (cond) { __builtin_amdgcn_s_sleep(1); \
    if ((++_sp & 255u) == 0u) { if (xb_ld(&(bar)[XB_TMO])) break; if (_sp > XB_SPIN_CAP) { atomicAdd(&(bar)[XB_TMO], 1u); break; } } } } while (0)
struct XcdBarrier { unsigned* bar; unsigned x; volatile LAS unsigned* st; };
__device__ __forceinline__ XcdBarrier xcd_barrier_post(unsigned* bar, volatile LAS unsigned* st) {
    XcdBarrier b; b.bar = bar; b.x = xb_xcc_id(); b.st = st;
    if (threadIdx.x == 0) (void)xb_add(&bar[XB_XCNT(b.x)], 1u);
    return b;
}
__device__ __forceinline__ void xcd_barrier_complete(unsigned* bar, unsigned x, unsigned& nloc, unsigned& nx) {
    const unsigned G = gridDim.x * gridDim.y * gridDim.z;
    unsigned sum, cnt, mine, sp = 0u;
    for (;;) {
        sum = 0u; cnt = 0u; mine = 0u;
#pragma unroll
        for (unsigned j = 0; j < 16; ++j) { const unsigned c = xb_ld(&bar[XB_XCNT(j)]); sum += c; cnt += (c > 0u) ? 1u : 0u; mine = (j == x) ? c : mine; }
        if (sum == G) break;
        __builtin_amdgcn_s_sleep(1);
        if ((++sp & 255u) == 0u) { if (xb_ld(&bar[XB_TMO])) break; if (sp > XB_SPIN_CAP) { atomicAdd(&bar[XB_TMO], 1u); break; } }
    }
    nloc = mine > 0u ? mine : 1u; nx = cnt > 0u ? cnt : 1u;
}
__device__ __forceinline__ void xcd_barrier(const XcdBarrier& b) {
    asm volatile("s_waitcnt vmcnt(0)" ::: "memory");
    __syncthreads();
    if (threadIdx.x == 0) {
        unsigned* bar = b.bar;
        __builtin_amdgcn_s_waitcnt(0);
        unsigned nloc = b.st[0], nx = b.st[1];
        if (nloc == 0u) { xcd_barrier_complete(bar, b.x, nloc, nx); b.st[0] = nloc; b.st[1] = nx; }
        const unsigned old = xb_add(&bar[XB_XSUB(b.x)], 1u);
        const unsigned gen = old / nloc;
        if (old + 1u == (gen + 1u) * nloc) {
            __builtin_amdgcn_fence(__ATOMIC_RELEASE, "agent");
            asm volatile("s_waitcnt vmcnt(0)" ::: "memory");
            const unsigned og = xb_add(&bar[XB_TOP], 1u);
            const unsigned tg = og / nx;
            if (og + 1u == (tg + 1u) * nx) xb_add(&bar[XB_TOPGEN], 1u);
            else XB_SPIN(xb_ld(&bar[XB_TOPGEN]) == tg, bar);
            __builtin_amdgcn_fence(__ATOMIC_ACQUIRE, "agent");
            xb_add(&bar[XB_XGEN(b.x)], 1u);
            asm volatile("s_waitcnt vmcnt(0)" ::: "memory");
        } else {
            XB_SPIN(xb_ld(&bar[XB_XGEN(b.x)]) == gen, bar);
            __builtin_amdgcn_fence(__ATOMIC_ACQUIRE, "agent");
            asm volatile("s_waitcnt vmcnt(0)" ::: "memory");
        }
    }
    __syncthreads();
}

struct Args { const float* in[N_INPUTS]; float* out; unsigned char* ws; int ph_lo, ph_hi; };
struct Frame {
    LAS unsigned char* lds;
    int tid, lane, wave, vcu, G;
    const float* const* in;
    float* out; unsigned char* ws;
    unsigned long long* pta;
};
#define F_modp ((float*)(F.ws + WS_MODP))
#define F_mod ((float*)(F.ws + WS_MOD))
#define F_WL ((bf16*)(F.ws + WS_WL))
#define F_CAR ((f32x2*)(F.ws + WS_CAR))
#define F_HIN ((float*)(F.ws + WS_HIN))
#define F_GB ((f32x2*)(F.ws + WS_GB))
#define F_KQ ((float*)(F.ws + WS_KQ))
#define F_SSQ ((float*)(F.ws + WS_SSQ))
#define F_Wt_out ((bf16*)(F.ws + WS_WOUT))
#define F_Wt_gu ((bf16*)(F.ws + WS_WGU))
#define F_Wt_dn ((bf16*)(F.ws + WS_WDN))
#define F_Wt_in ((bf16*)(F.ws + WS_WIN))
#define F_H ((bf16*)(F.ws + WS_H))
#define F_QN ((bf16*)(F.ws + WS_QN))
#define F_KN ((bf16*)(F.ws + WS_KN))
#define F_VN ((bf16*)(F.ws + WS_VN))
#define F_H2 ((bf16*)(F.ws + WS_H2))
#define F_LX ((bf16*)(F.ws + WS_LX))
#define F_LG ((bf16*)(F.ws + WS_LG))
#define F_QKV ((bf16*)(F.ws + WS_QKV))
#define F_Z ((bf16*)(F.ws + WS_Z))
#define F_BA ((bf16*)(F.ws + WS_BA))
#define F_ACT ((bf16*)(F.ws + WS_ACT))
#define F_MIX ((bf16*)(F.ws + WS_MIX))
#define F_RSL ((float*)(F.ws + WS_RSL))
#define F_X1B ((bf16*)(F.ws + WS_MIX))
#define F_Y1 ((bf16*)(F.ws + WS_Y1))
#define F_Y2 ((bf16*)(F.ws + WS_Y2Y))
#define F_O (F.out)
#define F_UT ((bf16*)(F.ws + WS_UT))
#define F_W ((bf16*)(F.ws + WS_W))
#define F_INTRA ((bf16*)(F.ws + WS_INTRA))
#define F_KT ((bf16*)(F.ws + WS_KT))
#define F_GSC ((float*)(F.ws + WS_GSC))
#define F_QC ((bf16*)(F.ws + WS_QC))

#if defined(PROBE_TIME_PHASE) && PROBE_TIME_PHASE >= 100
#define PTA_BEGIN(id) unsigned long long pta_t0_##id = ((id) == PROBE_TIME_PHASE - 100) ? __builtin_amdgcn_s_memrealtime() : 0ull
#define PTA_END(id) do { if ((id) == PROBE_TIME_PHASE - 100) *F.pta += __builtin_amdgcn_s_memrealtime() - pta_t0_##id; } while (0)
#else
#define PTA_BEGIN(id) do { } while (0)
#define PTA_END(id) do { } while (0)
#endif
template <bool FRAG = false, bool KTILED = false>
__device__ __forceinline__ void transpose_item(const float* W, int N, bf16* WT, int Kp, int k0, int n0, int drow0, LAS float* scr, int lane, const float* kscale = nullptr) {
    f32x4 tv[8];
    const int lr = lane >> 3, lq = 4 * (lane & 7);
#pragma unroll
    for (int i = 0; i < 8; ++i) tv[i] = *(const f32x4*)(W + (size_t)(k0 + 8 * i + lr) * N + n0 + lq);
    if (kscale) {
#pragma unroll
        for (int i = 0; i < 8; ++i) tv[i] = tv[i] * kscale[k0 + 8 * i + lr]; }
#pragma unroll
    for (int i = 0; i < 8; ++i) { LAS float* s = scr + (8 * i + lr) * 33 + lq; s[0] = tv[i].x; s[1] = tv[i].y; s[2] = tv[i].z; s[3] = tv[i].w; }
    LDS_WAIT(); asm volatile("" ::: "memory");
    const int c = lane & 7;
#pragma unroll
    for (int j = 0; j < 4; ++j) { const int n = (lane >> 3) + 8 * j; const LAS float* s = scr + (8 * c) * 33 + n;
        u32x4 o; o.x = pk2(s[0 * 33], s[1 * 33]); o.y = pk2(s[2 * 33], s[3 * 33]); o.z = pk2(s[4 * 33], s[5 * 33]); o.w = pk2(s[6 * 33], s[7 * 33]);
        if (FRAG) { const int jr = drow0 + n, ic = k0 + 8 * c; *(u32x4*)(WT + ((((jr >> 4) * 4 + (ic >> 5)) * 64 + ((ic >> 3) & 3) * 16 + (jr & 15)) * 8)) = o; }
        else if (KTILED) { const int jr = drow0 + n, ic = k0 + 8 * c; *(u32x4*)(WT + ((size_t)(jr >> 8) * (Kp / 64) + (ic >> 6)) * 16384 + (jr & 255) * 64 + (ic & 63)) = o; }
        else *(u32x4*)(WT + (size_t)(drow0 + n) * Kp + k0 + 8 * c) = o; }
    LDS_WAIT(); asm volatile("" ::: "memory");
}

constexpr int IT_G = 64 * (DFF / 32), IT_D = (DFF / 64) * (DM / 32);
template <int KIND>
__device__ __forceinline__ void wprep_late(const Frame& F, const int lo, const int hi, const int bidx, const int nb) {
    __syncthreads();
    LAS float* scr = (LAS float*)(F.lds + F.wave * 16384);
    const int lane = F.lane, st = nb * 8, c = lane & 7;
    f32x4 ta[8];
    const int lr = lane >> 3, lq = 4 * (lane & 7);
    auto src = [&](int r) -> const float* {
        if (KIND == 0) { const int up = r >= IT_G; if (up) r -= IT_G; const int kb = r / (DFF / 32), nbk = r % (DFF / 32);
            return F.in[up ? I_WU : I_WG] + (size_t)(64 * kb + lr) * DFF + 32 * nbk + lq; }
        const int kb = r / (DM / 32), nbk = r % (DM / 32); return F.in[I_WD] + (size_t)(64 * kb + lr) * DM + 32 * nbk + lq; };
    constexpr int NS = KIND == 0 ? DFF : DM;
#define WPL_LOAD(tv, item) do { if ((item) < hi) { const float* s_ = src(item); _Pragma("unroll") for (int i = 0; i < 8; ++i) tv[i] = __builtin_nontemporal_load((const f32x4*)(s_ + (size_t)(8 * i) * NS)); } } while (0)
#define WPL_ITEM(tv, item) do { \
        _Pragma("unroll") for (int i = 0; i < 8; ++i) { LAS float* s_ = scr + (8 * i + lr) * 33 + lq; s_[0] = tv[i].x; s_[1] = tv[i].y; s_[2] = tv[i].z; s_[3] = tv[i].w; } \
        WPL_LOAD(tv, (item) + st); \
        LDS_WAIT(); asm volatile("" ::: "memory"); \
        const int r = (item); \
        _Pragma("unroll") for (int j = 0; j < 4; ++j) { const int n = (lane >> 3) + 8 * j; const LAS float* s = scr + (8 * c) * 33 + n; \
            u32x4 o; o.x = pk2(s[0 * 33], s[1 * 33]); o.y = pk2(s[2 * 33], s[3 * 33]); o.z = pk2(s[4 * 33], s[5 * 33]); o.w = pk2(s[6 * 33], s[7 * 33]); \
            if (KIND == 0) { const int up = r >= IT_G, r2 = up ? r - IT_G : r, kb = r2 / (DFF / 32), n0 = 32 * (r2 % (DFF / 32)); \
                __builtin_nontemporal_store(o, (u32x4*)(F_Wt_gu + (size_t)(256 * (n0 >> 7) + (n0 & 127) + (up ? 128 : 0) + n) * DM + 64 * kb + 8 * c)); } \
            else { const int kb = r / (DM / 32), jr = 32 * (r % (DM / 32)) + n; \
                __builtin_nontemporal_store(o, (u32x4*)(F_Wt_dn + ((size_t)(jr >> 8) * (DFF / 64) + kb) * 16384 + (jr & 255) * 64 + 8 * c)); } } \
        LDS_WAIT(); asm volatile("" ::: "memory"); } while (0)
    int it = lo + bidx * 8 + F.wave;
    WPL_LOAD(ta, it);
    for (; it < hi; it += st) WPL_ITEM(ta, it);
#undef WPL_LOAD
#undef WPL_ITEM
}
__device__ __forceinline__ void ph0_prologue(const Frame& F, const int gu_lo) {
    const int gw = F.vcu * 8 + F.wave, NGW = F.G * 8, lane = F.lane;
    {
        const float* W = F.in[I_WADA]; const float* c = F.in[I_C]; const float* cc = F.in[I_CCTX];
        for (int it = gw; it < 96 * 32; it += NGW) {
            const int cg = it % 96, kc = it / 96;
            float sv[3][2];
#pragma unroll
            for (int h = 0; h < 2; ++h) { const int k = kc * 128 + h * 64 + lane; sv[0][h] = siluf_(c[k]); sv[1][h] = siluf_(c[DM + k]); sv[2][h] = siluf_(cc[k]); }
            f32x4 a0 = {0.f, 0.f, 0.f, 0.f}, a1 = a0, a2 = a0;
            const f32x4* wp = (const f32x4*)(W + (size_t)kc * 128 * NADA + cg * 256) + lane;
#pragma unroll
            for (int h = 0; h < 2; ++h) {
#pragma unroll 16
                for (int kk = 0; kk < 64; ++kk) { const f32x4 w = wp[(size_t)(h * 64 + kk) * (NADA / 4)];
                    const float s0 = rdlane(sv[0][h], kk), s1 = rdlane(sv[1][h], kk), s2 = rdlane(sv[2][h], kk);
                    a0 += w * s0; a1 += w * s1; a2 += w * s2; } }
            float* mp = F_modp + (size_t)(kc * 3) * NADA + cg * 256;
            ((f32x4*)mp)[lane] = a0; ((f32x4*)(mp + NADA))[lane] = a1; ((f32x4*)(mp + 2 * NADA))[lane] = a2;
        }
    }
    {
        LAS float* scr = (LAS float*)(F.lds + F.wave * 16384);
        constexpr int IT_IN = 64 * (NIN / 32), IT_OUT = 64 * (DM / 32), IT_L = 64 * 8;
        const int NGU = 2 * IT_G - gu_lo, NITEMS = IT_IN + IT_OUT + IT_L + NGU;
        for (int it = gw; it < NITEMS; it += NGW) {
            int r = it;
            if (r < IT_IN) { const int kb = r / (NIN / 32), nb = r % (NIN / 32); transpose_item(F.in[I_WIN], NIN, F_Wt_in, DM, 64 * kb, 32 * nb, 32 * nb, scr, lane); continue; } r -= IT_IN;
            if (r < IT_OUT) { const int kb = r / (DM / 32), nb = r % (DM / 32); transpose_item(F.in[I_WOUT], DM, F_Wt_out, DM, 64 * kb, 32 * nb, 32 * nb, scr, lane, 64 * kb < LW ? F.in[I_LNG] : nullptr); continue; } r -= IT_OUT;
            if (r < NGU) { r += gu_lo; const int up = r >= IT_G; if (up) r -= IT_G; const int kb = r / (DFF / 32), nb = r % (DFF / 32), n0 = 32 * nb;
                transpose_item(F.in[up ? I_WU : I_WG], DFF, F_Wt_gu, DM, 64 * kb, n0, 256 * (n0 >> 7) + (n0 & 127) + (up ? 128 : 0), scr, lane); continue; } r -= NGU;
            { const int mi = r >> 3, sub = r & 7, kb = sub >> 2, nb = sub & 3, d = mi >> 5, kind = (mi >> 4) & 1, n = mi & 15;
              transpose_item<true>(F.in[kind ? I_LWX : I_LWA] + (size_t)(d * 16 + n) * 16384, 128, F_WL + (size_t)((d * 2 + kind) * 16 + n) * 16384, 128, 64 * kb, 32 * nb, 32 * nb, scr, lane); }
        }
    }
    {
        u32x4* p = (u32x4*)(F_Wt_in + (size_t)NIN * DM); const u32x4 z = {0u, 0u, 0u, 0u};
        for (int i = F.vcu * 512 + F.tid; i < (NINP - NIN) * DM / 8; i += F.G * 512) p[i] = z;
    }
}
__device__ __forceinline__ void ph1_modreduce(const Frame& F) {
    const float* ba = F.in[I_BADA];
    for (int i = F.vcu * 512 + F.tid; i < 3 * NADA; i += F.G * 512) { const int r = i / NADA, col = i - r * NADA, seg = col >> 12, c = col & (DM - 1); float s = ba[col];
#pragma unroll 8
        for (int kc = 0; kc < 32; ++kc) s += F_modp[(size_t)(kc * 3 + r) * NADA + col];
        float v; int dst;
        if (seg == 0) { v = s; dst = 1; } else if (seg == 1) { v = F.in[I_GPREMIX][c] * (1.0f + s); dst = 0; } else if (seg == 2) { v = s * F.in[I_GPOSTMIX][c]; dst = 2; }
        else if (seg == 3) { v = s; dst = 4; } else if (seg == 4) { v = F.in[I_GPREFFN][c] * (1.0f + s); dst = 3; } else { v = s * F.in[I_GPOSTFFN][c]; dst = 5; }
        F_mod[(size_t)r * NADA + dst * DM + c] = v; }
}
__device__ __forceinline__ void ph2_hrows(const Frame& F) {
    const int gw = F.vcu * 8 + F.wave, NGW = F.G * 8, lane = F.lane;
    for (int row = gw; row < MT; row += NGW) {
        const f32x4* xr = (const f32x4*)(row < ML ? F.in[I_X] + (size_t)row * DM : F.in[I_CTX] + (size_t)(row - ML) * DM);
        const f32x4* md = (const f32x4*)(F_mod + (size_t)(row < ML ? row / TL : 2) * NADA);
        f32x4 v[16]; float ss = 0.f;
#pragma unroll
        for (int j = 0; j < 16; ++j) { v[j] = xr[lane + 64 * j]; ss += (v[j].x * v[j].x + v[j].y * v[j].y) + (v[j].z * v[j].z + v[j].w * v[j].w); }
        const float rs = rsqrtf(wave_sum(ss) * (1.0f / DM) + EPS);
        u32x2* o = (u32x2*)(F_H + (size_t)row * DM);
#pragma unroll
        for (int j = 0; j < 16; ++j) { const f32x4 y = (v[j] * rs) * md[lane + 64 * j] + md[DM / 4 + lane + 64 * j];
            u32x2 w; w.x = pk2(y.x, y.y); w.y = pk2(y.z, y.w); o[lane + 64 * j] = w; }
    }
}

template <int PASS>
__device__ __forceinline__ void lru_pass(const Frame& F, const int widx, const int nw) {
    LAS bf16* U = (LAS bf16*)(F.lds);
    LAS float* XC = (LAS float*)(F.lds + 17408);
    LAS bf16* XCB = (LAS bf16*)(F.lds + 17408 + 32768);
    LAS f32x2* SC = (LAS f32x2*)(F.lds + 17408 + 32768 + 17408 + F.wave * 8192);
    const int tid = F.tid, lane = F.lane, w = F.wave, fr = lane & 15, fq = lane >> 4;
    const int n = widx & 15;
    const int cl = 16 * w + fr, cg = n * 128 + cl;
    float ba[2], bx[2], sp[2];
#pragma unroll
    for (int d = 0; d < 2; ++d) { ba[d] = F.in[I_LBA][d * LW + cg]; bx[d] = F.in[I_LBX][d * LW + cg]; sp[d] = softplusf_(-F.in[I_LLAM][d * LW + cg]); }
    const int cc = tid & 127, tg = tid >> 7;
    float cw[4];
#pragma unroll
    for (int j = 0; j < 4; ++j) cw[j] = F.in[I_LCW][j * LW + n * 128 + cc];
    const float cb = F.in[I_LCB][n * 128 + cc];
    const int qstep = nw >> 4;
    u32x4 ur[3];
#define LRU_LOADU(qq) do { const int b_ = (qq) / NCH, ci_ = (qq) - b_ * NCH; const bool ic_ = ci_ < 4; const int t0_ = ic_ ? ci_ * 64 : (ci_ - 4) * 64, Ts_ = ic_ ? TCX : TL; \
        const size_t rb_ = ic_ ? (size_t)ML + (size_t)b_ * TCX : (size_t)b_ * TL; \
        _Pragma("unroll") for (int k_ = 0; k_ < 3; ++k_) { const int rr_ = (tid >> 4) + 32 * k_, t_ = t0_ - 2 + rr_; ur[k_] = (u32x4){0u, 0u, 0u, 0u}; \
            if (rr_ < 67 && t_ >= 0 && t_ < Ts_) ur[k_] = *(const u32x4*)(F_LX + (rb_ + t_) * LW + n * 128 + (tid & 15) * 8); } } while (0)
    int q = widx >> 4;
    if (PASS == 2) while (q < NBATCH * NCH && (q % NCH) < 4) q += qstep;
    if (q < NBATCH * NCH) LRU_LOADU(q);
    while (q < NBATCH * NCH) {
        int qn = q + qstep;
        if (PASS == 2) while (qn < NBATCH * NCH && (qn % NCH) < 4) qn += qstep;
        int tz = F.tid; asm volatile("" : "+v"(tz));
        const int tid = tz, lane = tz & 63, fr = lane & 15, fq = lane >> 4, cl = 16 * w + fr, cc = tid & 127, tg = tid >> 7;
        const int b = q / NCH, cidx = q - b * NCH;
        const bool isctx = cidx < 4; const int t0 = isctx ? cidx * 64 : (cidx - 4) * 64;
        const size_t rowbase = isctx ? (size_t)ML + (size_t)b * TCX : (size_t)b * TL;
        PTA_BEGIN(10);
        __syncthreads();
#pragma unroll
        for (int k = 0; k < 3; ++k) { const int rr = (tid >> 4) + 32 * k; if (rr < 67) *(LAS u32x4*)(U + rr * 128 + (tid & 15) * 8) = ur[k]; }
        if (qn < NBATCH * NCH) LRU_LOADU(qn);
        bf16x8 bfr[2][4];
#define LRU_LOADB(dd) do { _Pragma("unroll") for (int mat = 0; mat < 2; ++mat) _Pragma("unroll") for (int ks = 0; ks < 4; ++ks) bfr[mat][ks] = *(const bf16x8*)(F_WL + (size_t)((2 * (dd) + mat) * 16 + n) * 16384 + ((w * 4 + ks) * 64 + lane) * 8); } while (0)
        LRU_LOADB(0);
        u32x4 gt0 = {0u, 0u, 0u, 0u}, gt1 = gt0;
        if (PASS == 2) { gt0 = *(const u32x4*)(F_LG + (rowbase + t0 + (tid >> 4)) * LW + n * 128 + (tid & 15) * 8); gt1 = *(const u32x4*)(F_LG + (rowbase + t0 + 32 + (tid >> 4)) * LW + n * 128 + (tid & 15) * 8); }
        __syncthreads();
        { float x0 = bf2f(U[(tg * 16 + 0) * 128 + cc]), x1 = bf2f(U[(tg * 16 + 1) * 128 + cc]), x2 = bf2f(U[(tg * 16 + 2) * 128 + cc]);
#pragma unroll
          for (int i = 0; i < 16; ++i) { const int tt = tg * 16 + i; const float x3 = bf2f(U[(tt + 3) * 128 + cc]);
              const float y = cb + cw[0] * x0 + cw[1] * x1 + cw[2] * x2 + cw[3] * x3; XC[tt * 128 + cc] = y; XCB[tt * 136 + cc] = (bf16)f2bf(y); x0 = x1; x1 = x2; x2 = x3; } }
        __syncthreads();
        if (PASS == 2) { *(LAS u32x4*)(U + (tid >> 4) * 128 + (tid & 15) * 8) = gt0; *(LAS u32x4*)(U + (32 + (tid >> 4)) * 128 + (tid & 15) * 8) = gt1; }
        if (PASS == 1) PTA_END(10);
        PTA_BEGIN(11);
        float hsum[4][4];
#pragma unroll
        for (int d = 0; d < 2; ++d) {
            f32x4 acc[2][4];
#pragma unroll
            for (int mat = 0; mat < 2; ++mat)
#pragma unroll
                for (int mt = 0; mt < 4; ++mt) acc[mat][mt] = (f32x4){0.f, 0.f, 0.f, 0.f};
#pragma unroll
            for (int mt = 0; mt < 4; ++mt)
#pragma unroll
                for (int ks = 0; ks < 4; ++ks) { const bf16x8 af = *(const LAS bf16x8*)(XCB + (16 * mt + fr) * 136 + 32 * ks + 8 * fq);
                    acc[0][mt] = __builtin_amdgcn_mfma_f32_16x16x32_bf16(af, bfr[0][ks], acc[0][mt], 0, 0, 0);
                    acc[1][mt] = __builtin_amdgcn_mfma_f32_16x16x32_bf16(af, bfr[1][ks], acc[1][mt], 0, 0, 0); }
            if (d == 0) LRU_LOADB(1);
#pragma unroll
            for (int mt = 0; mt < 4; ++mt)
#pragma unroll
                for (int rg = 0; rg < 4; ++rg) { const int tok = 16 * mt + 4 * fq + rg; const float xcv = XC[tok * 128 + cl];
                    const float r = sigmoidf_(acc[0][mt][rg] + ba[d]), ig = sigmoidf_(acc[1][mt][rg] + bx[d]);
                    const float la = -8.0f * r * sp[d]; const float a = __expf(la);
                    const float em = __builtin_fmaf(-a, a, 1.0f);
                    const float bb = __builtin_amdgcn_sqrtf(em) * (ig * xcv);
                    SC[tok * 16 + fr] = (f32x2){a, bb}; }
            WAVE_LDS_FENCE();
            float P = 1.0f, h = 0.0f;
            float Pk[16], hk[16];
#pragma unroll
            for (int i = 0; i < 16; ++i) { const int tok = 16 * fq + (d == 0 ? i : 15 - i); const f32x2 ab = SC[tok * 16 + fr]; h = ab.x * h + ab.y; P *= ab.x; Pk[i] = P; hk[i] = h; }
            float As[4], Bs[4];
#pragma unroll
            for (int s = 0; s < 4; ++s) { As[s] = __shfl(P, s * 16 + fr); Bs[s] = __shfl(h, s * 16 + fr); }
            const size_t cidx_off = ((size_t)((d * 2 + b) * NCH + cidx)) * LW + cg;
            if (PASS == 1) {
                float At = 1.0f, Bt = 0.0f;
#pragma unroll
                for (int s = 0; s < 4; ++s) { const int sgi = d == 0 ? s : 3 - s; Bt = As[sgi] * Bt + Bs[sgi]; At *= As[sgi]; }
                if (fq == 0) F_CAR[cidx_off] = (f32x2){At, Bt};
            } else {
                float hin = F_HIN[cidx_off];
#pragma unroll
                for (int s = 0; s < 4; ++s) { const int sgi = d == 0 ? s : 3 - s; const bool before = d == 0 ? (sgi < fq) : (sgi > fq); if (before) hin = As[sgi] * hin + Bs[sgi]; }
#pragma unroll
                for (int i = 0; i < 16; ++i) { const int tok = 16 * fq + (d == 0 ? i : 15 - i); SC[tok * 16 + fr].y = hk[i] + Pk[i] * hin; }
                WAVE_LDS_FENCE();
#pragma unroll
                for (int mt = 0; mt < 4; ++mt)
#pragma unroll
                    for (int rg = 0; rg < 4; ++rg) { const float hv = SC[(16 * mt + 4 * fq + rg) * 16 + fr].y; hsum[mt][rg] = d == 0 ? hv : hsum[mt][rg] + hv; }
            }
            WAVE_LDS_FENCE();
        }
#undef LRU_LOADB
        if (PASS == 1) PTA_END(11);
        if (PASS == 2) {
            __syncthreads();
#pragma unroll
            for (int mt = 0; mt < 4; ++mt)
#pragma unroll
                for (int rg = 0; rg < 4; ++rg) { const int tok = 16 * mt + 4 * fq + rg;
                    const float y = hsum[mt][rg] * gelu_tanhf_(bf2f(U[tok * 128 + cl])); XCB[tok * 136 + cl] = (bf16)f2bf(y); }
            __syncthreads();
#pragma unroll
            for (int hh = 0; hh < 2; ++hh) { const int tok = hh * 32 + (tid >> 4); const u32x4 wv = *(const LAS u32x4*)(XCB + tok * 136 + (tid & 15) * 8);
                const size_t row = rowbase + t0 + tok; *(u32x4*)(F_MIX + row * DM + n * 128 + (tid & 15) * 8) = wv;
                float sq = (bflo(wv.x) * bflo(wv.x) + bfhi(wv.x) * bfhi(wv.x)) + (bflo(wv.y) * bflo(wv.y) + bfhi(wv.y) * bfhi(wv.y)) + (bflo(wv.z) * bflo(wv.z) + bfhi(wv.z) * bfhi(wv.z)) + (bflo(wv.w) * bflo(wv.w) + bfhi(wv.w) * bfhi(wv.w));
                sq = row16_sum(sq);
                if ((tid & 15) == 0) F_SSQ[row * 16 + n] = sq; }
        }
        q = qn;
    }
#undef LRU_LOADU
}
__device__ __forceinline__ int gdn_row(int b, int s) {
    if (s < TCX) return ML + b * TCX + s;
    const int m = s - TCX; return b * TL + (m & 127) * 64 + (m >> 7);
}
__device__ __forceinline__ void lru_chains_block(const Frame& F, const int n) {
    int tz = F.tid; asm volatile("" : "+v"(tz));
    { const int cg = n * 128 + (tz & 127), b = __builtin_amdgcn_readfirstlane((tz >> 7) & 1), d = __builtin_amdgcn_readfirstlane(tz >> 8);
        float h = 0.f;
        const size_t base = (size_t)((d * 2 + b) * NCH) * LW;
#pragma unroll 1
        for (int s0 = 0; s0 < NCH; s0 += 66) { f32x2 ab[66];
#pragma unroll
            for (int k = 0; k < 66; ++k) { const int step = s0 + k, cidx = d == 0 ? step : (step < 4 ? 3 - step : NCH - 1 - (step - 4)); ab[k] = (F_CAR + base + (size_t)cidx * LW)[cg]; }
#pragma unroll
            for (int k = 0; k < 66; ++k) { const int step = s0 + k, cidx = d == 0 ? step : (step < 4 ? 3 - step : NCH - 1 - (step - 4)); (F_HIN + base + (size_t)cidx * LW)[cg] = h; h = ab[k].x * h + ab[k].y; } }
    }
    __builtin_amdgcn_fence(__ATOMIC_RELEASE, "workgroup"); __syncthreads(); __builtin_amdgcn_fence(__ATOMIC_ACQUIRE, "workgroup");
}
__device__ __forceinline__ void unpk8(const u32x4 w, f32x4& lo, f32x4& hi);
__device__ __forceinline__ float sq4(const f32x4 v);
__device__ __forceinline__ void mix_finish(const Frame& F) {
    const int gw = F.vcu * 8 + F.wave, NGW = F.G * 8, lane = F.lane, lg = lane >> 4, l8 = 8 * (lane & 15);
    const f32x4 gn0 = *(const f32x4*)(F.in[I_GNG] + l8), gn1 = *(const f32x4*)(F.in[I_GNG] + l8 + 4);
    for (int row = gw; row < ML; row += NGW) {
        const int b = row / TL, t = row - b * TL, m = (t & 63) * 128 + (t >> 6), cl = m >> 6, i = m & 63;
#pragma unroll
        for (int j = 0; j < 4; ++j) { const int h = 4 * ((j + gw) & 3) + lg;
            const size_t it0 = ((size_t)((b * NH + h) * 128 + cl)) * 2;
            const u32x4 a = *(const u32x4*)((const bf16*)F_O + it0 * 8192 + i * 128 + l8), c = *(const u32x4*)((const bf16*)F_O + (it0 + 1) * 8192 + (63 - i) * 128 + l8);
            const u32x4 zw = *(const u32x4*)(F_Z + (size_t)row * GDW + h * HD + l8);
            f32x4 a0, a1, c0, c1, z0, z1; unpk8(a, a0, a1); unpk8(c, c0, c1); unpk8(zw, z0, z1);
            const f32x4 o0 = a0 + c0, o1 = a1 + c1;
            const float rs = rsqrtf(row16_sum(sq4(o0) + sq4(o1)) * (1.0f / HD) + EPS);
            u32x4 o; o.x = pk2(o0.x * rs * gn0.x * siluf_(z0.x), o0.y * rs * gn0.y * siluf_(z0.y)); o.y = pk2(o0.z * rs * gn0.z * siluf_(z0.z), o0.w * rs * gn0.w * siluf_(z0.w));
            o.z = pk2(o1.x * rs * gn1.x * siluf_(z1.x), o1.y * rs * gn1.y * siluf_(z1.y)); o.w = pk2(o1.z * rs * gn1.z * siluf_(z1.z), o1.w * rs * gn1.w * siluf_(z1.w));
            *(u32x4*)(F_MIX + (size_t)row * DM + LW + h * HD + l8) = o; }
        const float rsl = rsqrtf(row16_sum(F_SSQ[(size_t)row * 16 + (lane & 15)]) * (1.0f / LW) + EPS);
        if (lane == 0) F_RSL[row] = rsl;
    }
}
__device__ __forceinline__ void unpk8(const u32x4 w, f32x4& lo, f32x4& hi) { lo = (f32x4){bflo(w.x), bfhi(w.x), bflo(w.y), bfhi(w.y)}; hi = (f32x4){bflo(w.z), bfhi(w.z), bflo(w.w), bfhi(w.w)}; }
__device__ __forceinline__ float sq4(const f32x4 v) { return (v.x * v.x + v.y * v.y) + (v.z * v.z + v.w * v.w); }
__device__ __forceinline__ void ph_x1(const Frame& F) {
    const int gw = F.vcu * 8 + F.wave, NGW = F.G * 8, lane = F.lane;
    for (int row = gw; row < ML; row += NGW) {
        const f32x4* __restrict__ md = (const f32x4*)(F_mod + (size_t)(row / TL) * NADA) + 2 * lane;
        const u32x4* __restrict__ yr = (const u32x4*)(F_Y1 + (size_t)row * DM) + lane; const f32x4* __restrict__ xr = (const f32x4*)(F.in[I_X] + (size_t)row * DM) + 2 * lane;
        f32x4 y[16]; float ss = 0.f;
#pragma unroll
        for (int j = 0; j < 8; ++j) { unpk8(yr[64 * j], y[2 * j], y[2 * j + 1]); ss += sq4(y[2 * j]) + sq4(y[2 * j + 1]); }
        const float rs = rsqrtf(wave_sum(ss) * (1.0f / DM) + EPS); float s2 = 0.f;
#pragma unroll
        for (int j = 0; j < 8; ++j) {
#pragma unroll
            for (int e = 0; e < 2; ++e) { const f32x4 x1 = xr[128 * j + e] + md[2 * (DM / 4) + 128 * j + e] * (y[2 * j + e] * rs); y[2 * j + e] = x1; s2 += sq4(x1); }
            if (j & 1) asm volatile("" ::: "memory"); }
        const float r2 = rsqrtf(wave_sum(s2) * (1.0f / DM) + EPS);
        u32x4* __restrict__ o = (u32x4*)(F_H2 + (size_t)row * DM) + lane; u32x4* __restrict__ ox = (u32x4*)(F_X1B + (size_t)row * DM) + lane;
#pragma unroll
        for (int j = 0; j < 8; ++j) { { u32x4 w; w.x = pk2(y[2 * j].x, y[2 * j].y); w.y = pk2(y[2 * j].z, y[2 * j].w); w.z = pk2(y[2 * j + 1].x, y[2 * j + 1].y); w.w = pk2(y[2 * j + 1].z, y[2 * j + 1].w); ox[64 * j] = w; }
            const f32x4 h0 = (y[2 * j] * r2) * md[3 * (DM / 4) + 128 * j] + md[4 * (DM / 4) + 128 * j], h1 = (y[2 * j + 1] * r2) * md[3 * (DM / 4) + 128 * j + 1] + md[4 * (DM / 4) + 128 * j + 1];
            u32x4 w; w.x = pk2(h0.x, h0.y); w.y = pk2(h0.z, h0.w); w.z = pk2(h1.x, h1.y); w.w = pk2(h1.z, h1.w); o[64 * j] = w;
            if (j & 1) asm volatile("" ::: "memory"); }
    }
}
__device__ __forceinline__ void ph_final(const Frame& F) {
    int tz = F.tid; asm volatile("" : "+v"(tz));
    const int gw = F.vcu * 8 + F.wave, NGW = F.G * 8, lane = tz & 63;
    for (int row = gw; row < ML; row += NGW) {
        const f32x4* __restrict__ md = (const f32x4*)(F_mod + (size_t)(row / TL) * NADA) + 5 * (DM / 4) + 2 * lane;
        const u32x4* __restrict__ x1r = (const u32x4*)(F_X1B + (size_t)row * DM) + lane; const u32x4* __restrict__ y2r = (const u32x4*)(F_Y2 + (size_t)row * DM) + lane;
        f32x4* __restrict__ outr = (f32x4*)(F.out + (size_t)row * DM) + 2 * lane;
        u32x4 p[8], xq[8]; float s2 = 0.f;
#pragma unroll
        for (int j = 0; j < 8; ++j) { p[j] = y2r[64 * j]; xq[j] = x1r[64 * j]; }
#pragma unroll
        for (int j = 0; j < 8; ++j) { f32x4 lo, hi; unpk8(p[j], lo, hi); s2 += sq4(lo) + sq4(hi); }
        const float r2 = rsqrtf(wave_sum(s2) * (1.0f / DM) + EPS);
#pragma unroll
        for (int j = 0; j < 8; ++j) { f32x4 a0, a1, c0, c1; unpk8(xq[j], a0, a1); unpk8(p[j], c0, c1);
            outr[128 * j] = a0 + md[128 * j] * (c0 * r2); outr[128 * j + 1] = a1 + md[128 * j + 1] * (c1 * r2); }
    }
}
__device__ __forceinline__ size_t gdn_item(int b, int h, int c, int d) { return ((size_t)((b * NH + h) * NCH + c)) * 2 + d; }
__device__ __forceinline__ void gdn_solve32(const LAS float* Lb, float (&x)[32]) {
#define LROW(r, c0) (*(const LAS f32x4*)(Lb + (r) * 64 + (c0)))
    constexpr int GS = 8;
    f32x4 lbuf[2][GS]; int gb = 0;
#pragma unroll
    for (int j = 0; j < GS; ++j) lbuf[0][j] = LROW(4 + j, 0);
#pragma unroll
    for (int k = 0; k < 8; ++k) { const int r0 = 4 * k, nrows = 28 - 4 * k, ng = (nrows + GS - 1) / GS;
        { const f32x4 l1 = LROW(r0 + 1, r0), l2 = LROW(r0 + 2, r0), l3 = LROW(r0 + 3, r0);
          x[r0 + 1] -= l1.x * x[r0];
          x[r0 + 2] -= l2.x * x[r0] + l2.y * x[r0 + 1];
          x[r0 + 3] -= l3.x * x[r0] + l3.y * x[r0 + 1] + l3.z * x[r0 + 2]; }
#pragma unroll
        for (int g = 0; g < ng; ++g) { const int cur_ = (gb + g) & 1, nxt = cur_ ^ 1, rg0 = r0 + 4 + GS * g;
            if (g + 1 < ng) {
#pragma unroll
                for (int j = 0; j < GS; ++j) if (rg0 + GS + j < 32) lbuf[nxt][j] = LROW(rg0 + GS + j, r0);
            } else if (k + 1 < 8) {
#pragma unroll
                for (int j = 0; j < GS; ++j) if (r0 + 8 + j < 32) lbuf[nxt][j] = LROW(r0 + 8 + j, r0 + 4);
            }
#pragma unroll
            for (int j = 0; j < GS; ++j) if (rg0 + j < 32) { const int r = rg0 + j; const f32x4 l = lbuf[cur_][j];
                x[r] = __builtin_fmaf(-l.w, x[r0 + 3], __builtin_fmaf(-l.z, x[r0 + 2], __builtin_fmaf(-l.y, x[r0 + 1], __builtin_fmaf(-l.x, x[r0], x[r])))); }
            asm volatile("" ::: "memory"); }
        gb += ng; }
#undef LROW
}
__device__ __forceinline__ void gdn_chunk_pre(const Frame& F, const int v0) {
    LAS bf16* RAW = (LAS bf16*)(F.lds);
    LAS float* L_ = (LAS float*)(F.lds);
    LAS bf16* IN_ = (LAS bf16*)(F.lds + 32768);
    LAS bf16* Kt_ = (LAS bf16*)(F.lds + 51456);
    LAS bf16* Qt_ = (LAS bf16*)(F.lds + 68864);
    LAS bf16* VT_ = (LAS bf16*)(F.lds + 86272);
    LAS bf16* KTr_ = (LAS bf16*)(F.lds + 104704);
    LAS float* GC_ = (LAS float*)(F.lds + 123136);
    LAS float* BE_ = GC_ + 128;
    LAS float* BEG_ = GC_ + 256;
    LAS float* RK_ = GC_ + 384;
    LAS float* RQ_ = GC_ + 448;
    LAS float* RKD_ = GC_ + 512;
    const float* cwp = F.in[I_GCW];
    u32x4 rw[3][3]; f32x2 cwv[3][4]; float gpb = 0.f, gpa = 0.f, galog = 0.f, gdtb = 0.f;
#define GDN_LOADRAW(itx) do { const int c_ = (itx) / (NBATCH * NH), bh_ = (itx) % (NBATCH * NH), h_ = bh_ % NH, b_ = bh_ / NH, s0_ = c_ * 64, slo_ = c_ < 4 ? 0 : TCX, shi_ = c_ < 4 ? TCX : SEQ_S; \
        _Pragma("unroll") for (int p_ = 0; p_ < 3; ++p_) _Pragma("unroll") for (int j_ = 0; j_ < 4; ++j_) cwv[p_][j_] = *(const f32x2*)(cwp + (size_t)j_ * 6144 + p_ * GDW + h_ * HD + 2 * ((int)threadIdx.x & 63)); \
        if ((int)threadIdx.x < 128) { const int d_ = (int)threadIdx.x >> 6, pp_ = (int)threadIdx.x & 63, i_ = d_ ? 63 - pp_ : pp_; const bf16* bar_ = F_BA + (size_t)gdn_row(b_, s0_ + i_) * 256; \
            gpb = bf2f(bar_[d_ * 16 + h_]); gpa = bf2f(bar_[32 + d_ * 16 + h_]); galog = F.in[I_GALOG][d_ * 16 + h_]; gdtb = F.in[I_GDT][d_ * 16 + h_]; } \
        _Pragma("unroll") for (int k_ = 0; k_ < 3; ++k_) { const int pc_ = (int)threadIdx.x + 512 * k_, rr_ = pc_ >> 4, piece_ = pc_ & 15, s_ = s0_ - 2 + rr_; \
            rw[k_][0] = (u32x4){0u, 0u, 0u, 0u}; rw[k_][1] = rw[k_][0]; rw[k_][2] = rw[k_][0]; \
            if (pc_ < 67 * 16 && s_ >= slo_ && s_ < shi_) { const bf16* src_ = F_QKV + (size_t)gdn_row(b_, s_) * 6144 + h_ * HD + piece_ * 8; rw[k_][0] = *(const u32x4*)src_; rw[k_][1] = *(const u32x4*)(src_ + GDW); rw[k_][2] = *(const u32x4*)(src_ + 2 * GDW); } } } while (0)
    if (v0 < NBATCH * NH * NCH) GDN_LOADRAW(v0);
    for (int jt = v0; jt < NBATCH * NH * NCH; jt += F.G) {
        int tz = F.tid; asm volatile("" : "+v"(tz));
        const int tid = tz, lane = tz & 63, w = __builtin_amdgcn_readfirstlane(tz >> 6), fr = lane & 15, fq = lane >> 4;
        const int c = jt / (NBATCH * NH), bh = jt % (NBATCH * NH), h = bh % NH, b = bh / NH, it = bh * NCH + c;
        const size_t item0 = gdn_item(b, h, c, 0);
        const int s0 = c * 64, slo = c < 4 ? 0 : TCX, shi = c < 4 ? TCX : SEQ_S;
        __syncthreads();
        PTA_BEGIN(0);
#pragma unroll
        for (int k = 0; k < 3; ++k) { const int pc = tid + 512 * k; if (pc < 67 * 16) { LAS bf16* dst = RAW + (pc >> 4) * 384 + (pc & 15) * 8; *(LAS u32x4*)dst = rw[k][0]; *(LAS u32x4*)(dst + 128) = rw[k][1]; *(LAS u32x4*)(dst + 256) = rw[k][2]; } }
        PTA_BEGIN(8);
        const float beta = sigmoidf_(gpb), g = -__expf(galog) * softplusf_(gpa + gdtb);
        f32x2 cw[3][4];
#pragma unroll
        for (int p_ = 0; p_ < 3; ++p_)
#pragma unroll
            for (int j_ = 0; j_ < 4; ++j_) cw[p_][j_] = cwv[p_][j_];
        if (jt + F.G < NBATCH * NH * NCH) GDN_LOADRAW(jt + F.G);
        if (tid < 128) { const int d = tid >> 6, p = tid & 63;
            float gc = g;
#pragma unroll
            for (int o = 1; o < 64; o <<= 1) { const float t = __shfl_up(gc, o); if (lane >= o) gc += t; }
            GC_[d * 64 + p] = gc; BE_[d * 64 + p] = beta; BEG_[d * 64 + p] = beta * __expf(gc); }
        PTA_END(8); PTA_BEGIN(9);
        __syncthreads();
        PTA_END(9);
        PTA_BEGIN(6);
        { const int cp = tid & 63, tg = tid >> 6;
#pragma unroll
          for (int part = 0; part < 3; ++part) { LAS bf16* T = (part == 0 ? Qt_ : Kt_) + tg * 8 * 136 + 2 * cp; const LAS bf16* R = RAW + tg * 8 * 384 + part * 128 + 2 * cp;
              const f32x2 c0 = cw[part][0], c1 = cw[part][1], c2 = cw[part][2], c3 = cw[part][3];
              unsigned w0 = *(const LAS unsigned*)R, w1 = *(const LAS unsigned*)(R + 384), w2 = *(const LAS unsigned*)(R + 768);
              f32x2 x0 = {bflo(w0), bfhi(w0)}, x1 = {bflo(w1), bfhi(w1)}, x2 = {bflo(w2), bfhi(w2)}; f32x2 ys[8];
#pragma unroll
              for (int i = 0; i < 8; ++i) { const unsigned w3 = *(const LAS unsigned*)(R + (i + 3) * 384); const f32x2 x3 = {bflo(w3), bfhi(w3)};
                  const f32x2 a = c0 * x0 + c1 * x1 + c2 * x2 + c3 * x3;
                  const f32x2 e = a * (-1.4426950408889634f); f32x2 dn; dn.x = __builtin_amdgcn_exp2f(e.x); dn.y = __builtin_amdgcn_exp2f(e.y); dn = dn + 1.0f;
                  f32x2 rc; rc.x = __builtin_amdgcn_rcpf(dn.x); rc.y = __builtin_amdgcn_rcpf(dn.y); ys[i] = a * rc;
                  if (part < 2) *(LAS unsigned*)(T + i * 136) = pk2(ys[i].x, ys[i].y);
                  x0 = x1; x1 = x2; x2 = x3; }
              if (part > 0) { LAS bf16* TT = (part == 1 ? KTr_ : VT_) + (2 * cp) * 72 + tg * 8;
                  u32x4 ta, tb; ta.x = pk2(ys[0].x, ys[1].x); ta.y = pk2(ys[2].x, ys[3].x); ta.z = pk2(ys[4].x, ys[5].x); ta.w = pk2(ys[6].x, ys[7].x);
                  tb.x = pk2(ys[0].y, ys[1].y); tb.y = pk2(ys[2].y, ys[3].y); tb.z = pk2(ys[4].y, ys[5].y); tb.w = pk2(ys[6].y, ys[7].y);
                  *(LAS u32x4*)TT = ta; *(LAS u32x4*)(TT + 72) = tb; }
              asm volatile("" ::: "memory"); } }
        PTA_END(6); PTA_BEGIN(7);
        __syncthreads();
        PTA_END(7);
        PTA_END(0); PTA_BEGIN(1);
        { const int mt = w >> 1;
          bf16x8 kA[4], qA[4];
#pragma unroll
          for (int ks = 0; ks < 4; ++ks) { kA[ks] = *(const LAS bf16x8*)(Kt_ + (16 * mt + fr) * 136 + 32 * ks + 8 * fq); qA[ks] = *(const LAS bf16x8*)(Qt_ + (16 * mt + fr) * 136 + 32 * ks + 8 * fq); }
          f32x4 aK[2], aQ[2];
#pragma unroll
          for (int t2 = 0; t2 < 2; ++t2) { const int nt = 2 * (w & 1) + t2; aK[t2] = (f32x4){0.f, 0.f, 0.f, 0.f}; aQ[t2] = aK[t2];
#pragma unroll
              for (int ks = 0; ks < 4; ++ks) { const bf16x8 kB = *(const LAS bf16x8*)(Kt_ + (16 * nt + fr) * 136 + 32 * ks + 8 * fq);
                  aK[t2] = __builtin_amdgcn_mfma_f32_16x16x32_bf16(kA[ks], kB, aK[t2], 0, 0, 0); aQ[t2] = __builtin_amdgcn_mfma_f32_16x16x32_bf16(qA[ks], kB, aQ[t2], 0, 0, 0); } }
          if ((w & 1) == (w >> 2)) {
              f32x4 aQQ = {0.f, 0.f, 0.f, 0.f};
#pragma unroll
              for (int ks = 0; ks < 4; ++ks) aQQ = __builtin_amdgcn_mfma_f32_16x16x32_bf16(qA[ks], qA[ks], aQQ, 0, 0, 0);
              const f32x4 dK = (mt & 1) ? aK[1] : aK[0]; const int rg = fr & 3;
              const float k2 = rg == 0 ? dK[0] : rg == 1 ? dK[1] : rg == 2 ? dK[2] : dK[3], q2 = rg == 0 ? aQQ[0] : rg == 1 ? aQQ[1] : rg == 2 ? aQQ[2] : aQQ[3];
              if ((fr >> 2) == fq) { RK_[16 * mt + fr] = rsqrtf(k2 + EPS); RQ_[16 * mt + fr] = rsqrtf(q2 + EPS); } }
          __syncthreads();
          if (tid < 128) { const int d = tid >> 6, p = tid & 63, i = d ? 63 - p : p; const float rk = RK_[i]; BEG_[d * 64 + p] *= rk; RKD_[d * 64 + p] = rk * __expf(GC_[d * 64 + 63] - GC_[d * 64 + p]); }
#pragma unroll
          for (int t2 = 0; t2 < 2; ++t2) { const int nt = 2 * (w & 1) + t2;
              const int j = 16 * nt + fr, q1 = 63 - j; const float g0j = GC_[j], g1q = GC_[64 + q1], rkj = RK_[j];
#pragma unroll
              for (int rg = 0; rg < 4; ++rg) { const int i = 16 * mt + 4 * fq + rg, p1 = 63 - i;
                  const float e0 = i >= j ? __expf(GC_[i] - g0j) : 0.f, e1 = i <= j ? __expf(GC_[64 + p1] - g1q) : 0.f;
                  const float kk = aK[t2][rg] * RK_[i] * rkj;
                  if (i > j) L_[i * 64 + j] = BE_[i] * kk * e0;
                  if (i < j) L_[4096 + p1 * 64 + q1] = BE_[64 + p1] * kk * e1;
                  const float y = aQ[t2][rg] * RQ_[i] * rkj * 0.08838834764831845f;
                  IN_[i * 72 + j] = (bf16)f2bf(y * e0); IN_[64 * 72 + p1 * 72 + q1] = (bf16)f2bf(y * e1); } }
        }
        __syncthreads();
        {
#pragma unroll
          for (int r = 0; r < 2; ++r) { const int pc = tid + 512 * r, d = pc >> 9, blk = (pc >> 6) & 7, l = pc & 63, row = 16 * (blk >> 1) + (l & 15), cc = 4 * (blk & 1) + (l >> 4);
              *(u32x4*)(F_INTRA + (item0 + d) * 4096 + (size_t)(pc & 511) * 8) = *(const LAS u32x4*)(IN_ + d * 64 * 72 + row * 72 + cc * 8); } }
        if (tid < 128) { const int d = tid >> 6, p = tid & 63, i = d ? 63 - p : p; const float eg = __expf(GC_[d * 64 + p]);
            F_GSC[(item0 + d) * 128 + p] = 0.08838834764831845f * eg * RQ_[i];
            if (p == 63) F_GSC[(item0 + d) * 128 + 64] = eg; }
        PTA_END(1); PTA_BEGIN(2);
        if (w < 2) {
            const int d = w, c = lane, hi = c >> 5, cl = c & 31; const LAS float* Ld = L_ + d * 4096;
            LAS bf16* SA = (LAS bf16*)(F.lds + 125696 + d * 7168);
            LAS float* SM = (LAS float*)(F.lds + 125696 + d * 7168 + 2560);
            float xa[32];
#pragma unroll
            for (int p = 0; p < 32; ++p) xa[p] = (p == cl) ? 1.0f : 0.0f;
            gdn_solve32(Ld + hi * (32 * 64 + 32), xa);
            if (!hi) {
#pragma unroll
                for (int p8 = 0; p8 < 4; ++p8) { u32x4 o; o.x = pk2(xa[8 * p8], xa[8 * p8 + 1]); o.y = pk2(xa[8 * p8 + 2], xa[8 * p8 + 3]); o.z = pk2(xa[8 * p8 + 4], xa[8 * p8 + 5]); o.w = pk2(xa[8 * p8 + 6], xa[8 * p8 + 7]);
                    *(LAS u32x4*)(SA + cl * 40 + 8 * p8) = o; } }
            WAVE_LDS_FENCE();
#pragma unroll
            for (int mt = 0; mt < 2; ++mt) {
                const f32x4 la = *(const LAS f32x4*)(Ld + (32 + 16 * mt + fr) * 64 + 8 * fq), lb = *(const LAS f32x4*)(Ld + (32 + 16 * mt + fr) * 64 + 8 * fq + 4);
                u32x4 aw; aw.x = pk2(la.x, la.y); aw.y = pk2(la.z, la.w); aw.z = pk2(lb.x, lb.y); aw.w = pk2(lb.z, lb.w); const bf16x8 af = __builtin_bit_cast(bf16x8, aw);
#pragma unroll
                for (int nt = 0; nt < 2; ++nt) { const bf16x8 bfm = *(const LAS bf16x8*)(SA + (16 * nt + fr) * 40 + 8 * fq);
                    const f32x4 m = __builtin_amdgcn_mfma_f32_16x16x32_bf16(af, bfm, (f32x4){0.f, 0.f, 0.f, 0.f}, 0, 0, 0);
                    *(LAS f32x4*)(SM + (16 * nt + fr) * 36 + 16 * mt + 4 * fq) = m; } }
            WAVE_LDS_FENCE();
            float xb[32];
#pragma unroll
            for (int p4 = 0; p4 < 8; ++p4) { const f32x4 m = *(const LAS f32x4*)(SM + cl * 36 + 4 * p4); xb[4 * p4] = hi ? 0.f : -m.x; xb[4 * p4 + 1] = hi ? 0.f : -m.y; xb[4 * p4 + 2] = hi ? 0.f : -m.z; xb[4 * p4 + 3] = hi ? 0.f : -m.w; }
            gdn_solve32(Ld + 32 * 64 + 32, xb);
            asm volatile("s_waitcnt lgkmcnt(0)" ::: "memory");
            { LAS bf16* TAu = (LAS bf16*)(F.lds + d * 16384); LAS bf16* TAw = TAu + 4096; const int ic = d ? 63 - c : c; const float bu = BE_[d * 64 + c], bw = BEG_[d * 64 + c];
#pragma unroll
              for (int p = 0; p < 32; ++p) { const float top = hi ? 0.f : xa[p], bot = hi ? xa[p] : xb[p];
                  TAu[p * 64 + ic] = (bf16)f2bf(top * bu); TAw[p * 64 + ic] = (bf16)f2bf(top * bw); TAu[(32 + p) * 64 + ic] = (bf16)f2bf(bot * bu); TAw[(32 + p) * 64 + ic] = (bf16)f2bf(bot * bw); } }
        } else {
            const int t2 = tid - 128;
#pragma unroll
            for (int k = 0; k < 6; ++k) { const int id = t2 + 384 * k;
                if (id < 2048) { const int d = id >> 10, blk = (id >> 6) & 15, l = id & 63, dk = 16 * (blk >> 1) + (l & 15), p0 = 32 * (blk & 1) + 8 * (l >> 4);
                    const u32x4 kv = *(const LAS u32x4*)(KTr_ + dk * 72 + (d ? 56 - p0 : p0));
                    const float k0 = bflo(kv.x), k1 = bfhi(kv.x), k2 = bflo(kv.y), k3 = bfhi(kv.y), k4 = bflo(kv.z), k5 = bfhi(kv.z), k6 = bflo(kv.w), k7 = bfhi(kv.w);
                    const LAS float* sc = RKD_ + d * 64 + p0; u32x4 o;
                    if (d == 0) { o.x = pk2(k0 * sc[0], k1 * sc[1]); o.y = pk2(k2 * sc[2], k3 * sc[3]); o.z = pk2(k4 * sc[4], k5 * sc[5]); o.w = pk2(k6 * sc[6], k7 * sc[7]); }
                    else        { o.x = pk2(k7 * sc[0], k6 * sc[1]); o.y = pk2(k5 * sc[2], k4 * sc[3]); o.z = pk2(k3 * sc[4], k2 * sc[5]); o.w = pk2(k1 * sc[6], k0 * sc[7]); }
                    *(u32x4*)(F_KT + (item0 + d) * 8192 + (size_t)(id & 1023) * 8) = o; } }
#pragma unroll
            for (int k = 0; k < 3; ++k) { const int id = t2 + 384 * k;
                if (id < 1024) { const int blk = id >> 6, l = id & 63, row = 16 * (blk >> 2) + (l & 15), c0 = 32 * (blk & 3) + 4 * (l >> 4);
                    const u32x2 lo = *(const LAS u32x2*)(Qt_ + row * 136 + c0), hi = *(const LAS u32x2*)(Qt_ + row * 136 + c0 + 16);
                    *(u32x4*)(F_QC + (size_t)it * 8192 + (size_t)id * 8) = (u32x4){lo.x, lo.y, hi.x, hi.y}; } }
        }
        PTA_END(2); PTA_BEGIN(3);
        __syncthreads();
        { const int d = w >> 2, pt = w & 3; const LAS bf16* TAu = (const LAS bf16*)(F.lds + d * 16384); const LAS bf16* TAw = TAu + 4096;
          bf16x8 au[2], bw[2];
#pragma unroll
          for (int kk = 0; kk < 2; ++kk) { au[kk] = *(const LAS bf16x8*)(TAu + (16 * pt + fr) * 64 + 32 * kk + 8 * fq); bw[kk] = *(const LAS bf16x8*)(TAw + (16 * pt + fr) * 64 + 32 * kk + 8 * fq); }
#pragma unroll
          for (int nt = 0; nt < 8; ++nt) { f32x4 acc = {0.f, 0.f, 0.f, 0.f};
#pragma unroll
              for (int kk = 0; kk < 2; ++kk) acc = __builtin_amdgcn_mfma_f32_16x16x32_bf16(au[kk], *(const LAS bf16x8*)(VT_ + (16 * nt + fr) * 72 + 32 * kk + 8 * fq), acc, 0, 0, 0);
              u32x2 o; o.x = pk2(acc[0], acc[1]); o.y = pk2(acc[2], acc[3]); *(u32x2*)(F_UT + (item0 + d) * 8192 + (size_t)((nt * 4 + pt) * 64 + lane) * 4) = o; }
#pragma unroll
          for (int ks = 0; ks < 4; ++ks) { f32x4 a0 = {0.f, 0.f, 0.f, 0.f}, a1 = a0;
#pragma unroll
              for (int kk = 0; kk < 2; ++kk) { a0 = __builtin_amdgcn_mfma_f32_16x16x32_bf16(*(const LAS bf16x8*)(KTr_ + (32 * ks + fr) * 72 + 32 * kk + 8 * fq), bw[kk], a0, 0, 0, 0);
                  a1 = __builtin_amdgcn_mfma_f32_16x16x32_bf16(*(const LAS bf16x8*)(KTr_ + (32 * ks + 16 + fr) * 72 + 32 * kk + 8 * fq), bw[kk], a1, 0, 0, 0); }
              u32x4 o; o.x = pk2(a0[0], a0[1]); o.y = pk2(a0[2], a0[3]); o.z = pk2(a1[0], a1[1]); o.w = pk2(a1[2], a1[3]);
              *(u32x4*)(F_W + (item0 + d) * 8192 + (size_t)((pt * 4 + ks) * 64 + lane) * 8) = o; } }
        PTA_END(3);
    }
#undef GDN_LOADRAW
}
template <int DVS>
__device__ __forceinline__ void gdn_seq_chunked(const Frame& F, int item, const int VARIANT) {
    constexpr int NT = DVS / 16, NTW = NT / 2, NSL = 128 / DVS;
    const int sl = item % NSL, d = (item / NSL) & 1, h = (item / (2 * NSL)) & 15, b = item / (32 * NSL);
    LAS bf16* St = (LAS bf16*)(F.lds);
    LAS bf16* Vt = (LAS bf16*)(F.lds + DVS * 272);
    int tz = F.tid; asm volatile("" : "+v"(tz));
    const int tid = tz, lane = tz & 63, w = F.wave, fr = lane & 15, fq = lane >> 4;
    const int mt = w & 3, nt0 = (w >> 2) * NTW;
    for (int e = tid; e < DVS * 136 / 2; e += 512) ((LAS unsigned*)St)[e] = 0u;
    f32x4 S[NT];
#pragma unroll
    for (int n = 0; n < NT; ++n) S[n] = (f32x4){0.f, 0.f, 0.f, 0.f};
    const bf16* Qb = F_QC + (size_t)(b * NH + h) * NCH * 8192;
    bf16* Ob = (bf16*)F_O + (size_t)(b * NH + h) * 128 * 2 * 8192 + (size_t)d * 8192 + sl * DVS + 16 * nt0 + 4 * fq;
    struct Stg { bf16x8 wf[4], qf[4], inf[2], ktf[2]; u32x2 utv[NTW]; float sq1; float gl; };
#define GDN_LOADC(G, step) do { const int c_ = d == 0 ? (step) : ((step) < 4 ? 3 - (step) : NCH - 1 - ((step) - 4)); const size_t it_ = gdn_item(b, h, c_, d); \
        const int qoff_ = d ? ((3 - mt) * 4 * 64 + fq * 16 + 15 - fr) * 8 : (mt * 4 * 64 + lane) * 8;     \
        _Pragma("unroll") for (int ks = 0; ks < 4; ++ks) { G.wf[ks] = *(const bf16x8*)(F_W + it_ * 8192 + ((mt * 4 + ks) * 64 + lane) * 8); G.qf[ks] = *(const bf16x8*)(Qb + (size_t)c_ * 8192 + qoff_ + ks * 512); } \
        _Pragma("unroll") for (int ks = 0; ks < 2; ++ks) { G.inf[ks] = *(const bf16x8*)(F_INTRA + it_ * 4096 + ((mt * 2 + ks) * 64 + lane) * 8); G.ktf[ks] = *(const bf16x8*)(F_KT + it_ * 8192 + ((w * 2 + ks) * 64 + lane) * 8); } \
        _Pragma("unroll") for (int n = 0; n < NTW; ++n) G.utv[n] = *(const u32x2*)(F_UT + it_ * 8192 + (((DVS / 16) * sl + nt0 + n) * 4 + mt) * 256 + lane * 4); \
        G.sq1 = F_GSC[it_ * 128 + 16 * mt + fr]; G.gl = F_GSC[it_ * 128 + 64]; } while (0)
#define GDN_STEP(G, step) do { const int c = d == 0 ? (step) : ((step) < 4 ? 3 - (step) : NCH - 1 - ((step) - 4)); \
        f32x4 o[NTW]; \
        _Pragma("unroll") for (int n = 0; n < NTW; ++n) { f32x4 aW = {0.f, 0.f, 0.f, 0.f}, aQ = aW; \
            _Pragma("unroll") for (int ks = 0; ks < 4; ++ks) { const bf16x8 bS = *(const LAS bf16x8*)(St + (16 * (nt0 + n) + fr) * 136 + 32 * ks + 8 * fq); \
                aW = __builtin_amdgcn_mfma_f32_16x16x32_bf16(G.wf[ks], bS, aW, 0, 0, 0); aQ = __builtin_amdgcn_mfma_f32_16x16x32_bf16(bS, G.qf[ks], aQ, 0, 0, 0); }     \
            const float v0 = bflo(G.utv[n].x) - aW[0], v1 = bfhi(G.utv[n].x) - aW[1], v2 = bflo(G.utv[n].y) - aW[2], v3 = bfhi(G.utv[n].y) - aW[3]; \
            u32x2 vn; vn.x = pk2(v0, v1); vn.y = pk2(v2, v3); *(LAS u32x2*)(Vt + (16 * (nt0 + n) + fr) * 72 + 16 * mt + 4 * fq) = vn; \
            o[n] = aQ * G.sq1; } \
        __syncthreads(); \
        _Pragma("unroll") for (int n = 0; n < NTW; ++n) { const bf16x8 b0 = *(const LAS bf16x8*)(Vt + (16 * (nt0 + n) + fr) * 72 + 8 * fq), b1 = *(const LAS bf16x8*)(Vt + (16 * (nt0 + n) + fr) * 72 + 32 + 8 * fq); \
            o[n] = __builtin_amdgcn_mfma_f32_16x16x32_bf16(b0, G.inf[0], o[n], 0, 0, 0); o[n] = __builtin_amdgcn_mfma_f32_16x16x32_bf16(b1, G.inf[1], o[n], 0, 0, 0); }     \
        _Pragma("unroll") for (int n = 0; n < NT; ++n) { const bf16x8 b0 = *(const LAS bf16x8*)(Vt + (16 * n + fr) * 72 + 8 * fq), b1 = *(const LAS bf16x8*)(Vt + (16 * n + fr) * 72 + 32 + 8 * fq); \
            S[n] = S[n] * G.gl; \
            S[n] = __builtin_amdgcn_mfma_f32_16x16x32_bf16(G.ktf[0], b0, S[n], 0, 0, 0); S[n] = __builtin_amdgcn_mfma_f32_16x16x32_bf16(G.ktf[1], b1, S[n], 0, 0, 0); \
            u32x2 s0; s0.x = pk2(S[n][0], S[n][1]); s0.y = pk2(S[n][2], S[n][3]); *(LAS u32x2*)(St + (16 * n + fr) * 136 + 32 * (w >> 1) + 8 * fq + 4 * (w & 1)) = s0; }     \
        if (c >= 4 && VARIANT == 0) { _Pragma("unroll") for (int n = 0; n < NTW; ++n) { u32x2 ow; ow.x = pk2(o[n][0], o[n][1]); ow.y = pk2(o[n][2], o[n][3]); *(u32x2*)(Ob + (size_t)(c - 4) * 16384 + (16 * mt + fr) * 128 + 16 * n) = ow; } } \
        _Pragma("unroll") for (int n = 0; n < NTW; ++n) asm volatile("" :: "v"(o[n])); \
        __syncthreads(); } while (0)
    if constexpr (DVS <= 64) {
        Stg A, B, C;
        GDN_LOADC(A, 0); GDN_LOADC(B, 1);
        __syncthreads();
        static_assert(NCH % 6 == 0, "register pipelines of 2 and 3 stages");
        for (int step = 0; step < NCH; step += 3) {
            if (VARIANT != 1 || step == 0) GDN_LOADC(C, step + 2); GDN_STEP(A, step);
            if (VARIANT != 1 && step + 3 < NCH) GDN_LOADC(A, step + 3); GDN_STEP(B, step + 1);
            if (VARIANT != 1 && step + 4 < NCH) GDN_LOADC(B, step + 4); GDN_STEP(C, step + 2);
        }
    } else {
        Stg A, B;
        GDN_LOADC(A, 0);
        __syncthreads();
        for (int step = 0; step < NCH; step += 2) {
            if (VARIANT != 1 || step == 0) GDN_LOADC(B, step + 1); GDN_STEP(A, step);
            if (VARIANT != 1 && step + 2 < NCH) GDN_LOADC(A, step + 2); GDN_STEP(B, step + 1);
        }
    }
#undef GDN_STEP
#undef GDN_LOADC
}
#ifndef MK_N_LAUNCHES
#define MK_N_LAUNCHES 1
#endif
constexpr int N_PHASES = 13;
#ifndef GEMM4_WGM
#define GEMM4_WGM 8
#endif
#ifndef GDN_DVS
#define GDN_DVS 64
#endif
#ifndef LATE_A1
#define LATE_A1 21000
#endif
__global__ void __launch_bounds__(512, 2) fwd(Args args) {
    extern __shared__ __attribute__((aligned(16))) unsigned char lds[];
    Frame F;
    F.lds = (LAS unsigned char*)lds;
    F.tid = threadIdx.x; F.lane = F.tid & 63; F.wave = __builtin_amdgcn_readfirstlane(F.tid >> 6);
    F.G = gridDim.x; { const int bx = blockIdx.x; F.vcu = (F.G % 8 == 0) ? (bx % 8) * (F.G / 8) + bx / 8 : bx; }
    F.in = args.in; F.out = args.out; F.ws = args.ws; F.pta = nullptr;
    unsigned char* ws = args.ws;
    volatile LAS unsigned* MISC = (volatile LAS unsigned*)(F.lds + MISC_OFF);
    if (F.tid < 64) MISC[F.tid] = 0u;
    __syncthreads();
    const int lo = args.ph_lo, hi = args.ph_hi;
    XcdBarrier bar; bar.bar = (unsigned*)(ws + WS_CTL) + CW_BAR; bar.x = 0; bar.st = nullptr;
    if (hi - lo > 1) bar = xcd_barrier_post((unsigned*)(ws + WS_CTL) + CW_BAR, MISC + 8);
#ifndef PH_MASK
#define PH_MASK 0x1fff
#endif
#define IN(k) (((PH_MASK >> (k)) & 1) && lo <= (k) && (k) < hi)
#define SEAM(k) do { if (IN(k) && IN((k) + 1)) xcd_barrier(bar); } while (0)
#ifdef PROBE_TIME_PHASE
    unsigned long long pt_t0 = 0, pt_dt = 0; F.pta = &pt_dt;
#define PT_BEGIN(k) do { if ((k) == PROBE_TIME_PHASE) pt_t0 = __builtin_amdgcn_s_memrealtime(); } while (0)
#define PT_END(k) do { if ((k) == PROBE_TIME_PHASE) pt_dt = __builtin_amdgcn_s_memrealtime() - pt_t0; } while (0)
#else
#define PT_BEGIN(k) do { } while (0)
#define PT_END(k) do { } while (0)
#endif
    constexpr int G1_REM = ((MT / 256) * (NINP / 256)) % 256, G3_REM = ((ML / 256) * (2 * DFF / 256)) % 256;
    const bool late = F.G == 256;
    if (IN(0)) { PT_BEGIN(0); ph0_prologue(F, late ? LATE_A1 : 0); if (!late) wprep_late<1>(F, 0, IT_D, F.vcu, F.G); PT_END(0); } SEAM(0);
    if (IN(1)) { PT_BEGIN(1); ph1_modreduce(F); PT_END(1); } SEAM(1);
    if (IN(2)) { PT_BEGIN(2); ph2_hrows(F); PT_END(2); } SEAM(2);
    if (IN(3)) { PT_BEGIN(3); pg8::Gemm g{F_H, F_Wt_in, MT, NINP, DM}; pg8::StaticOrder S; S.init(MT, NINP, F.G, (int)blockIdx.x);
        pg8::EpiProj E{F_LX, F_LG, F_QKV, F_Z, F_BA};
        pg8::gemm_phase<pg8::EpiProj, pg8::StaticOrder, true, true>(F.lds, g, S, E);
        if (late && (int)blockIdx.x >= G1_REM) wprep_late<0>(F, 0, LATE_A1, (int)blockIdx.x - G1_REM, 256 - G1_REM); PT_END(3); } SEAM(3);
    if (IN(4)) { PT_BEGIN(4); lru_pass<1>(F, F.vcu, F.G); gdn_chunk_pre(F, F.G - 1 - F.vcu); PT_END(4); } if (IN(4) && IN(6)) xcd_barrier(bar);
    constexpr int SEQ_STRIDE = GDN_DVS / 32;
    if (IN(6)) { PT_BEGIN(6);
        if (SEQ_STRIDE == 1 || F.G != 256) { for (int item = F.vcu; item < 8192 / GDN_DVS; item += F.G) gdn_seq_chunked<GDN_DVS>(F, item, 0); lru_chains_block(F, F.vcu & 15); lru_pass<2>(F, F.vcu, F.G); }
        else if ((F.vcu % SEQ_STRIDE) == 0) gdn_seq_chunked<GDN_DVS>(F, F.vcu / SEQ_STRIDE, 0);
        else { const int oi = (F.vcu / SEQ_STRIDE) * (SEQ_STRIDE - 1) + (F.vcu % SEQ_STRIDE) - 1; lru_chains_block(F, oi & 15); lru_pass<2>(F, oi, 256 - 256 / SEQ_STRIDE); }
        PT_END(6); } SEAM(6);
    if (IN(7)) { PT_BEGIN(7); mix_finish(F); PT_END(7); } SEAM(7);
    if (IN(8)) { PT_BEGIN(8); pg8::Gemm g{F_MIX, F_Wt_out, ML, DM, DM}; pg8::StaticOrder S; S.init(ML, DM, F.G, (int)blockIdx.x);
        pg8::EpiBf16 E{F_Y1, DM};
        pg8::gemm_phase<pg8::EpiBf16, pg8::StaticOrder, true, true, false, true>(F.lds, g, S, E, F_RSL); PT_END(8); } SEAM(8);
    if (IN(9)) { PT_BEGIN(9); ph_x1(F); PT_END(9); } SEAM(9);
    if (IN(10)) { PT_BEGIN(10); pg8::Gemm g{F_H2, F_Wt_gu, ML, 2 * DFF, DM}; pg8::StaticOrder S; S.init(ML, 2 * DFF, F.G, (int)blockIdx.x);
        pg8::EpiSwiGLU E{F_ACT, DFF};
        pg8::gemm_phase<pg8::EpiSwiGLU, pg8::StaticOrder, true, true>(F.lds, g, S, E);
        if (late && (int)blockIdx.x >= G3_REM) wprep_late<1>(F, 0, IT_D, (int)blockIdx.x - G3_REM, 256 - G3_REM); PT_END(10); } SEAM(10);
    if (IN(11)) { PT_BEGIN(11); pg8::Gemm g{F_ACT, F_Wt_dn, ML, DM, DFF}; pg8::StaticOrder S; S.init(ML, DM, F.G, (int)blockIdx.x, GEMM4_WGM);
        pg8::EpiBf16 E{F_Y2, DM};
        pg8::gemm_phase<pg8::EpiBf16, pg8::StaticOrder, true, true, true>(F.lds, g, S, E); PT_END(11); } SEAM(11);
    if (IN(12)) { PT_BEGIN(12); ph_final(F); PT_END(12); }
#ifdef PROBE_TIME_PHASE
#ifndef PROBE_BLOCK
#define PROBE_BLOCK 0
#endif
    if (blockIdx.x == PROBE_BLOCK) { const unsigned long long t1 = __builtin_amdgcn_s_memrealtime(); while (__builtin_amdgcn_s_memrealtime() - t1 < pt_dt * PROBE_TIME_MULT) __builtin_amdgcn_s_sleep(8); }
#endif
#undef IN
#undef SEAM
}

extern "C" void kernel_launch(void* const* d_in, const int* in_sizes, int n_in, void* d_out, int out_size, void* d_ws, size_t ws_size, hipStream_t stream) {
    static int grid = 0;
    if (grid == 0) {
        if (n_in != N_INPUTS || in_sizes[0] != ML * DM || out_size != ML * DM || ws_size < WS_END) { fprintf(stderr, "kernel_launch: unexpected problem shape (n_in %d, in0 %d, out %d, ws %zu): nothing launched\n", n_in, n_in > 0 ? in_sizes[0] : -1, out_size, ws_size); grid = -1; return; }
        int dev = 0, cus = 0;
        if (hipGetDevice(&dev) != hipSuccess || hipDeviceGetAttribute(&cus, hipDeviceAttributeMultiprocessorCount, dev) != hipSuccess) { grid = -1; return; }
        if (hipFuncSetAttribute((const void*)fwd, hipFuncAttributeMaxDynamicSharedMemorySize, LDS_BYTES) != hipSuccess) { fprintf(stderr, "kernel_launch: hipFuncSetAttribute failed\n"); grid = -1; return; }
        (void)hipGetLastError();
        grid = cus >= 256 ? 256 : (cus / 16) * 16;
        if (grid < 16) { grid = -1; return; }
    }
    if (grid < 0) return;
    (void)hipMemsetAsync((char*)d_ws + WS_CTL, 0, CTL_ZERO_BYTES, stream);
    Args a{};
    for (int i = 0; i < N_INPUTS; ++i) a.in[i] = (const float*)d_in[i];
    a.out = (float*)d_out; a.ws = (unsigned char*)d_ws;
#if MK_N_LAUNCHES == 1
    a.ph_lo = 0; a.ph_hi = N_PHASES;
    hipLaunchKernelGGL(fwd, dim3(grid), dim3(512), LDS_BYTES, stream, a);
#else
#ifndef PROBE_REPEAT_MASK
#define PROBE_REPEAT_MASK 0
#endif
    for (int p = 0; p < N_PHASES; ++p) { a.ph_lo = p; a.ph_hi = p + 1; hipLaunchKernelGGL(fwd, dim3(grid), dim3(512), LDS_BYTES, stream, a);
        if ((PROBE_REPEAT_MASK >> p) & 1) hipLaunchKernelGGL(fwd, dim3(grid), dim3(512), LDS_BYTES, stream, a); }
#endif
}
```
